# Optimizing an MI355X kernel written in HIP

```python
import jax
import jax.numpy as jnp
from jax import lax
import numpy as np


D_MODEL = 2048
BATCH = 1
SEQ = 16384
DEPTH = 2

HEAD_DIM = 128
ROT_DIM = HEAD_DIM // 4
ROPE_THETA = 500000.0
N_BRANCH = 4
NORM_EPS = 1e-6

GLA_HEADS = 4
GLA_DK = 64
GLA_DV = 128
GLA_RANK = 16
GLA_NORMALIZER = 16.0
GLA_CHUNK = 64

DIL_PAIRS = ((128, 1), (512, 4), (2048, 16))
DIL_HEADS_PER_GROUP = 2
DIL_HEADS = DIL_HEADS_PER_GROUP * len(DIL_PAIRS)

RWKV_HEAD_SIZE = 64
RWKV_HEADS = 8
RWKV_WIDTH = RWKV_HEADS * RWKV_HEAD_SIZE
RWKV_DECAY_LORA = 96
RWKV_AAA_LORA = 96
RWKV_MV_LORA = 64
RWKV_GATE_LORA = 256
RWKV_LNX_EPS = 64e-5

MOBA_HEADS = 4
MOBA_BLOCK = 256
MOBA_TOPK = 3
MOBA_QCHUNK = 128

FFN_HIDDEN = -(-8 * D_MODEL // (3 * 256)) * 256

GLA_SIZES = (GLA_HEADS * GLA_DK, GLA_HEADS * GLA_DK, GLA_HEADS * GLA_DV, GLA_HEADS * GLA_DV, GLA_RANK)
RWKV_SIZES = (RWKV_WIDTH, RWKV_WIDTH, RWKV_WIDTH, RWKV_DECAY_LORA, RWKV_AAA_LORA, RWKV_GATE_LORA)
GLA_IN = sum(GLA_SIZES)
DIL_IN = 3 * DIL_HEADS * HEAD_DIM
RWKV_IN = sum(RWKV_SIZES)
MOBA_IN = 3 * MOBA_HEADS * HEAD_DIM
IN_SIZES = (N_BRANCH * D_MODEL, GLA_IN, DIL_IN, RWKV_IN, MOBA_IN)
IN_TOTAL = sum(IN_SIZES)
GLA_OUT = GLA_HEADS * GLA_DV
DIL_OUT = DIL_HEADS_PER_GROUP * HEAD_DIM
RWKV_OUT = RWKV_WIDTH
MOBA_OUT = MOBA_HEADS * HEAD_DIM

kernel_name = 'hybrid_gated_parallel_mixers_adaln'


def split_sizes(t, sizes):
    offsets = [int(o) for o in np.cumsum(sizes)[:-1]]
    return jnp.split(t, offsets, axis=-1)


def rms_norm(x, gain):
    xf = x.astype(jnp.float32)
    y = xf * lax.rsqrt(jnp.mean(xf * xf, axis=-1, keepdims=True) + NORM_EPS)
    return (y * gain.astype(jnp.float32)).astype(x.dtype)


def to_heads(t, n_heads):
    B, S, _ = t.shape
    return t.reshape(B, S, n_heads, -1).transpose(0, 2, 1, 3)


def rope_tables(positions):
    inv_freq = ROPE_THETA ** (-jnp.arange(0, ROT_DIM, 2, dtype=jnp.float32) / ROT_DIM)
    ang = positions.astype(jnp.float32)[..., None] * inv_freq
    return jnp.cos(ang)[:, None], jnp.sin(ang)[:, None]


def apply_rope(x, cos, sin):
    x_rot, x_pass = x[..., :ROT_DIM], x[..., ROT_DIM:]
    x1, x2 = jnp.split(x_rot, 2, axis=-1)
    rotated = jnp.concatenate([x1 * cos - x2 * sin, x2 * cos + x1 * sin], axis=-1)
    return jnp.concatenate([rotated.astype(x.dtype), x_pass], axis=-1)


def gla_mixer(p, w_a2, b_a2, g_norm):
    dtype = p.dtype
    B, S, _ = p.shape
    q, k, v, g, a_low = split_sizes(p.astype(jnp.float32), GLA_SIZES)
    gk = jax.nn.log_sigmoid(a_low @ w_a2.astype(jnp.float32) + b_a2.astype(jnp.float32)) / GLA_NORMALIZER
    n = S // GLA_CHUNK

    def chunked(t):
        return t.reshape(B, n, GLA_CHUNK, GLA_HEADS, -1).transpose(1, 0, 3, 2, 4)

    causal = jnp.tril(jnp.ones((GLA_CHUNK, GLA_CHUNK), dtype=bool))[:, :, None]

    def step(state, inp):
        q_c, k_c, v_c, g_c = inp
        b = jnp.cumsum(g_c, axis=-2)
        b_last = b[:, :, -1:, :]
        rel = jnp.exp(jnp.where(causal, b[:, :, :, None, :] - b[:, :, None, :, :], -jnp.inf))
        scores = jnp.einsum('bhtd,bhsd,bhtsd->bhts', q_c, k_c, rel)
        out = (jnp.einsum('bhtd,bhde->bhte', q_c * jnp.exp(b), state)
               + jnp.einsum('bhts,bhse->bhte', scores, v_c))
        state = (jnp.exp(b_last)[:, :, 0, :, None] * state
                 + jnp.einsum('bhsd,bhse->bhde', k_c * jnp.exp(b_last - b), v_c))
        return state, out

    state0 = jnp.zeros((B, GLA_HEADS, GLA_DK, GLA_DV), jnp.float32)
    _, o = lax.scan(step, state0, (chunked(q * GLA_DK ** -0.5), chunked(k), chunked(v), chunked(gk)))
    o = o.transpose(1, 0, 3, 2, 4).reshape(B, S, GLA_HEADS, GLA_DV)
    o = o * lax.rsqrt(jnp.mean(o * o, axis=-1, keepdims=True) + NORM_EPS) * g_norm.astype(jnp.float32)
    return (o.reshape(B, S, GLA_OUT) * jax.nn.silu(g)).astype(dtype)


def banded_attention(q, k, v, window):
    N, L, dh = q.shape
    blk = window
    nb = -(-L // blk)
    pad = nb * blk - L

    def blocks(t):
        return jnp.pad(t, ((0, 0), (0, pad), (0, 0))).reshape(N, nb, blk, dh)

    def with_prev(t):
        return jnp.concatenate([jnp.pad(t[:, :-1], ((0, 0), (1, 0), (0, 0), (0, 0))), t], axis=2)

    qb = blocks(q)
    k2, v2 = with_prev(blocks(k)), with_prev(blocks(v))
    qi = jnp.arange(blk)[:, None]
    ki = jnp.arange(2 * blk)[None, :]
    dist = blk + qi - ki
    band = (dist >= 0) & (dist <= window)
    mask = band[None] & ((jnp.arange(nb)[:, None, None] > 0) | (ki >= blk)[None])
    s = jnp.einsum('nbqd,nbkd->nbqk', qb, k2).astype(jnp.float32) * dh ** -0.5
    s = jnp.where(mask, s, -jnp.inf)
    m = jnp.max(s, axis=-1, keepdims=True)
    pr = jnp.exp(s - m)
    den = jnp.sum(pr, axis=-1, keepdims=True)
    o = jnp.einsum('nbqk,nbkd->nbqd', pr, v2.astype(jnp.float32)) / den
    lse = (m + jnp.log(den))[..., 0]
    return o.reshape(N, nb * blk, dh)[:, :L], lse.reshape(N, nb * blk)[:, :L]


def fold_dilated(t, dil):
    B, h, S, d = t.shape
    return t.reshape(B, h, S // dil, dil, d).transpose(0, 1, 3, 2, 4).reshape(B * h * dil, S // dil, d)


def dilated_mixer(p, cos, sin):
    dtype = p.dtype
    B, S, _ = p.shape
    q, k, v = [to_heads(t, DIL_HEADS) for t in jnp.split(p.astype(jnp.float32), 3, axis=-1)]
    q, k = apply_rope(q, cos, sin), apply_rope(k, cos, sin)
    hp = DIL_HEADS_PER_GROUP
    outs, lses = [], []
    for g, (window, dil) in enumerate(DIL_PAIRS):
        hs = slice(g * hp, (g + 1) * hp)
        o, lse = banded_attention(fold_dilated(q[:, hs], dil), fold_dilated(k[:, hs], dil),
                                  fold_dilated(v[:, hs], dil), window // dil)
        outs.append(o.reshape(B, hp, dil, S // dil, HEAD_DIM).transpose(0, 1, 3, 2, 4).reshape(B, hp, S, HEAD_DIM))
        lses.append(lse.reshape(B, hp, dil, S // dil).transpose(0, 1, 3, 2).reshape(B, hp, S))
    alpha = jax.nn.softmax(jnp.stack(lses, axis=0), axis=0)
    o = jnp.sum(alpha[..., None] * jnp.stack(outs, axis=0), axis=0)
    return o.transpose(0, 2, 1, 3).reshape(B, S, DIL_OUT).astype(dtype)


def rwkv_heads(t):
    return t.reshape(t.shape[:-1] + (RWKV_HEADS, RWKV_HEAD_SIZE))


def rwkv7_mixer(p, mu, w0, w2, a0, a2, g2, k_k, k_a, r_k, lnx_w, lnx_b, v_first, v_mix):
    dtype = p.dtype
    B, S, _ = p.shape
    p = p.astype(jnp.float32)
    p_prev = jnp.pad(p[:, :-1], ((0, 0), (1, 0), (0, 0)))
    xs = p + (p_prev - p) * mu.astype(jnp.float32)
    r, k, v, w_low, a_low, g_low = split_sizes(xs, RWKV_SIZES)
    log_w = -jax.nn.softplus(-(w0 + jnp.tanh(w_low) @ w2)) - 0.5
    decay = jnp.exp(-jnp.exp(log_w))
    a = jax.nn.sigmoid(a0 + a_low @ a2)
    g = jax.nn.sigmoid(g_low) @ g2
    if v_mix is None:
        v_first = v
    else:
        v0, v1, v2 = v_mix
        v = v + (v_first - v) * jax.nn.sigmoid(v0 + (v @ v1) @ v2)
    kk = rwkv_heads(k * k_k)
    kk = kk / jnp.maximum(jnp.sqrt(jnp.sum(kk * kk, axis=-1, keepdims=True)), 1e-12)
    k = k * (1.0 + (a - 1.0) * k_a)
    rh, kh, vh, wh, ah = rwkv_heads(r), rwkv_heads(k), rwkv_heads(v), rwkv_heads(decay), rwkv_heads(a)

    def step(state, inp):
        r_t, w_t, k_t, v_t, a_t, b_t = inp
        sa = jnp.einsum('bhij,bhj->bhi', state, a_t)
        state = (state * w_t[..., None, :] + sa[..., :, None] * b_t[..., None, :]
                 + v_t[..., :, None] * k_t[..., None, :])
        return state, jnp.einsum('bhij,bhj->bhi', state, r_t)

    def seq_first(t):
        return t.transpose(1, 0, 2, 3)

    state0 = jnp.zeros((B, RWKV_HEADS, RWKV_HEAD_SIZE, RWKV_HEAD_SIZE), jnp.float32)
    _, y = lax.scan(step, state0, (seq_first(rh), seq_first(wh), seq_first(kh), seq_first(vh),
                                   seq_first(-kk), seq_first(kk * ah)))
    y = y.transpose(1, 0, 2, 3)
    mean = jnp.mean(y, axis=-1, keepdims=True)
    var = jnp.mean(jnp.square(y - mean), axis=-1, keepdims=True)
    y = ((y - mean) * lax.rsqrt(var + RWKV_LNX_EPS)).reshape(B, S, RWKV_WIDTH) * lnx_w + lnx_b
    bonus = jnp.sum(rh * kh * rwkv_heads(r_k), axis=-1, keepdims=True) * vh
    y = y + bonus.reshape(B, S, RWKV_WIDTH)
    return (y * g).astype(dtype), v_first


def moba_mixer(p, cos, sin):
    dtype = p.dtype
    B, S, _ = p.shape
    H, blk, qc_len = MOBA_HEADS, MOBA_BLOCK, MOBA_QCHUNK
    q, k, v = [to_heads(t, H) for t in jnp.split(p.astype(jnp.float32), 3, axis=-1)]
    q = apply_rope(q, cos, sin) * HEAD_DIM ** -0.5
    k = apply_rope(k, cos, sin)
    nb = -(-S // blk)
    pad = nb * blk - S
    kb = jnp.pad(k, ((0, 0), (0, 0), (0, pad), (0, 0))).reshape(B, H, nb, blk, HEAD_DIM)
    vb = jnp.pad(v, ((0, 0), (0, 0), (0, pad), (0, 0))).reshape(B, H, nb, blk, HEAD_DIM)
    k_mean = jnp.mean(kb, axis=3)
    top_k = min(MOBA_TOPK, nb)
    nq = S // qc_len
    q_chunks = q.reshape(B, H, nq, qc_len, HEAD_DIM).transpose(2, 0, 1, 3, 4)
    b_idx = jnp.arange(B)[:, None, None, None]
    h_idx = jnp.arange(H)[None, :, None, None]

    def chunk_attend(args):
        q_i, ci = args
        q_pos = ci * qc_len + jnp.arange(qc_len)
        cur = (ci * qc_len) // blk
        gate = jnp.einsum('bhqd,bhnd->bhqn', q_i, k_mean)
        gate = jnp.where(jnp.arange(nb) < cur, gate, -jnp.inf)
        sel_score, sel = lax.top_k(gate, top_k)
        sel_ok = jnp.isfinite(sel_score)
        k_sel = kb[b_idx, h_idx, sel]
        v_sel = vb[b_idx, h_idx, sel]
        s_sel = jnp.einsum('bhqd,bhqkld->bhqkl', q_i, k_sel)
        s_sel = jnp.where(sel_ok[..., None], s_sel, -jnp.inf).reshape(B, H, qc_len, top_k * blk)
        k_own = lax.dynamic_index_in_dim(kb, cur, axis=2, keepdims=False)
        v_own = lax.dynamic_index_in_dim(vb, cur, axis=2, keepdims=False)
        s_own = jnp.einsum('bhqd,bhld->bhql', q_i, k_own)
        own_pos = cur * blk + jnp.arange(blk)
        s_own = jnp.where(own_pos[None, :] <= q_pos[:, None], s_own, -jnp.inf)
        probs = jax.nn.softmax(jnp.concatenate([s_sel, s_own], axis=-1), axis=-1)
        p_sel = probs[..., :top_k * blk].reshape(B, H, qc_len, top_k, blk)
        p_own = probs[..., top_k * blk:]
        return (jnp.einsum('bhqkl,bhqkld->bhqd', p_sel, v_sel)
                + jnp.einsum('bhql,bhld->bhqd', p_own, v_own))

    o = lax.map(chunk_attend, (q_chunks, jnp.arange(nq)))
    return o.transpose(1, 0, 3, 2, 4).reshape(B, S, MOBA_OUT).astype(dtype)


def setup_inputs(seed: int = 0) -> dict:
    key = jax.random.key(seed)
    ks = iter(jax.random.split(key, 40))
    L = DEPTH
    W = RWKV_WIDTH

    def nrm(shape, scale):
        return jax.random.normal(next(ks), shape, jnp.float32) * scale

    return {
        'x': nrm((BATCH, SEQ, D_MODEL), 1.0),
        'c': nrm((BATCH, D_MODEL), 1.0),
        'positions': (jnp.arange(SEQ, dtype=jnp.int32)[None, :]
                      + jax.random.randint(next(ks), (BATCH, 1), 0, 1024, dtype=jnp.int32)),
        'w_ada': nrm((L, D_MODEL, 6 * D_MODEL), 0.5 * D_MODEL ** -0.5),
        'b_ada': nrm((L, 6 * D_MODEL), 0.02),
        'norm1': 1.0 + nrm((L, D_MODEL), 0.02),
        'w_in': nrm((L, D_MODEL, IN_TOTAL), D_MODEL ** -0.5),
        'gla_w_a2': nrm((L, GLA_RANK, GLA_HEADS * GLA_DK), GLA_RANK ** -0.5),
        'gla_b_a2': nrm((L, GLA_HEADS * GLA_DK), 0.1),
        'gla_gnorm': 1.0 + nrm((L, GLA_DV), 0.02),
        'rwkv_mu': jax.random.uniform(next(ks), (L, RWKV_IN), jnp.float32),
        'rwkv_w0': -1.0 + nrm((L, W), 0.5),
        'rwkv_w2': nrm((L, RWKV_DECAY_LORA, W), 0.5 * RWKV_DECAY_LORA ** -0.5),
        'rwkv_a0': nrm((L, W), 0.5),
        'rwkv_a2': nrm((L, RWKV_AAA_LORA, W), RWKV_AAA_LORA ** -0.5),
        'rwkv_g2': nrm((L, RWKV_GATE_LORA, W), RWKV_GATE_LORA ** -0.5),
        'rwkv_k_k': 0.85 + nrm((L, W), 0.05),
        'rwkv_k_a': 1.0 + nrm((L, W), 0.05),
        'rwkv_r_k': nrm((L, W), 0.1),
        'rwkv_lnx_w': 1.0 + nrm((L, W), 0.02),
        'rwkv_lnx_b': nrm((L, W), 0.02),
        'rwkv_v0': nrm((L - 1, W), 0.5),
        'rwkv_v1': nrm((L - 1, W, RWKV_MV_LORA), W ** -0.5),
        'rwkv_v2': nrm((L - 1, RWKV_MV_LORA, W), 0.5 * RWKV_MV_LORA ** -0.5),
        'w_branch_a': nrm((L, GLA_OUT, D_MODEL), GLA_OUT ** -0.5),
        'w_branch_b': nrm((L, DIL_OUT, D_MODEL), DIL_OUT ** -0.5),
        'w_branch_c': nrm((L, RWKV_OUT, D_MODEL), RWKV_OUT ** -0.5),
        'w_branch_d': nrm((L, MOBA_OUT, D_MODEL), MOBA_OUT ** -0.5),
        'w_out': nrm((L, D_MODEL, D_MODEL), D_MODEL ** -0.5),
        'norm2': 1.0 + nrm((L, D_MODEL), 0.02),
        'w_ffn_in': nrm((L, D_MODEL, 2 * FFN_HIDDEN), D_MODEL ** -0.5),
        'w_ffn_out': nrm((L, FFN_HIDDEN, D_MODEL), FFN_HIDDEN ** -0.5),
        'norm_f': 1.0 + nrm((D_MODEL,), 0.02),
    }


def reference(x, c, positions, w_ada, b_ada, norm1, w_in, gla_w_a2, gla_b_a2, gla_gnorm,
              rwkv_mu, rwkv_w0, rwkv_w2, rwkv_a0, rwkv_a2, rwkv_g2, rwkv_k_k, rwkv_k_a, rwkv_r_k,
              rwkv_lnx_w, rwkv_lnx_b, rwkv_v0, rwkv_v1, rwkv_v2,
              w_branch_a, w_branch_b, w_branch_c, w_branch_d, w_out, norm2, w_ffn_in, w_ffn_out, norm_f):
    B, S, _ = x.shape
    cos, sin = rope_tables(positions)
    c_act = jax.nn.silu(c)
    v_first = None
    for l in range(DEPTH):
        mod = c_act @ w_ada[l] + b_ada[l]
        shift1, scale1, gate1, shift2, scale2, gate2 = [m[:, None, :] for m in jnp.split(mod, 6, axis=-1)]

        h = rms_norm(x, norm1[l]) * (1.0 + scale1) + shift1
        proj = h @ w_in[l]
        p_gate, p_gla, p_dil, p_rwkv, p_moba = split_sizes(proj, IN_SIZES)
        gates = jax.nn.sigmoid(p_gate).reshape(B, S, N_BRANCH, D_MODEL)
        o_gla = gla_mixer(p_gla, gla_w_a2[l], gla_b_a2[l], gla_gnorm[l])
        o_dil = dilated_mixer(p_dil, cos, sin)
        v_mix = None if l == 0 else (rwkv_v0[l - 1], rwkv_v1[l - 1], rwkv_v2[l - 1])
        o_rwkv, v_first = rwkv7_mixer(p_rwkv, rwkv_mu[l], rwkv_w0[l], rwkv_w2[l], rwkv_a0[l], rwkv_a2[l],
                                      rwkv_g2[l], rwkv_k_k[l], rwkv_k_a[l], rwkv_r_k[l],
                                      rwkv_lnx_w[l], rwkv_lnx_b[l], v_first, v_mix)
        o_moba = moba_mixer(p_moba, cos, sin)
        merged = (gates[:, :, 0] * (o_gla @ w_branch_a[l])
                  + gates[:, :, 1] * (o_dil @ w_branch_b[l])
                  + gates[:, :, 2] * (o_rwkv @ w_branch_c[l])
                  + gates[:, :, 3] * (o_moba @ w_branch_d[l]))
        x = x + gate1 * (merged @ w_out[l])

        h2 = rms_norm(x, norm2[l]) * (1.0 + scale2) + shift2
        g_ffn, u_ffn = jnp.split(h2 @ w_ffn_in[l], 2, axis=-1)
        x = x + gate2 * ((jax.nn.silu(g_ffn) * u_ffn) @ w_ffn_out[l])
    return rms_norm(x, norm_f)
```

```cpp
#include <hip/hip_runtime.h>
#include <hip/hip_cooperative_groups.h>
#include <cstdio>
#include <cstdint>
namespace cg = cooperative_groups;

typedef unsigned short bf16_t;
typedef short bf16x8 __attribute__((ext_vector_type(8)));
typedef float f32x4 __attribute__((ext_vector_type(4)));
typedef float f32x2 __attribute__((ext_vector_type(2)));
typedef unsigned u32x4 __attribute__((ext_vector_type(4)));
typedef unsigned u32x2 __attribute__((ext_vector_type(2)));
#define LAS __attribute__((address_space(3)))
#define DEVI __device__ __forceinline__

constexpr int S = 16384, D = 2048, NL = 2;
constexpr int IN_TOTAL = 15568, IN_PAD = 15872;
constexpr int FFN_H = 5632;
constexpr int NT = 512;
constexpr int LDS_BYTES = 131072;

constexpr size_t SZ_HEADARR = (size_t)S * 128 * 2;
constexpr size_t OFF_WIN = 0;
constexpr size_t OFF_WBA = OFF_WIN + (size_t)IN_PAD * D * 2;
constexpr size_t OFF_WBB = OFF_WBA + (size_t)D * 512 * 2;
constexpr size_t OFF_WBC = OFF_WBB + (size_t)D * 256 * 2;
constexpr size_t OFF_WBD = OFF_WBC + (size_t)D * 512 * 2;
constexpr size_t OFF_WOUT = OFF_WBD + (size_t)D * 512 * 2;
constexpr size_t OFF_WF1 = OFF_WOUT + (size_t)D * D * 2;
constexpr size_t OFF_WF2 = OFF_WF1 + (size_t)2 * FFN_H * D * 2;
constexpr size_t WB_END = OFF_WF2 + (size_t)D * FFN_H * 2;
constexpr size_t OFF_VT = OFF_WIN;
constexpr size_t OFF_G = WB_END;
constexpr size_t OFF_P1G = OFF_G + (size_t)S * 8192 * 2;
constexpr size_t OFF_P1R = OFF_P1G + (size_t)S * 1792 * 2;
constexpr size_t OFF_P2 = OFF_P1R + (size_t)S * 2048 * 2;
constexpr size_t OFF_ACT = OFF_P1G;
constexpr size_t OFF_H = OFF_P2 + 30 * SZ_HEADARR;
constexpr size_t OFF_OGLA = OFF_H;
constexpr size_t OFF_ODIL = OFF_OGLA + (size_t)S * 512 * 2;
constexpr size_t OFF_ORWKV = OFF_ODIL + (size_t)S * 256 * 2;
constexpr size_t OFF_OMOBA = OFF_ORWKV + (size_t)S * 512 * 2;
constexpr size_t OFF_X = OFF_H + (size_t)S * D * 2;
constexpr size_t SZ_B512 = (size_t)S * 512 * 2;
constexpr size_t OFF_RWR = OFF_X;
constexpr size_t OFF_RWK = OFF_RWR + SZ_B512;
constexpr size_t OFF_RWV = OFF_RWK + SZ_B512;
constexpr size_t OFF_RWA = OFF_RWV + SZ_B512;
constexpr size_t OFF_RWB = OFF_RWA + SZ_B512;
constexpr size_t OFF_RWG = OFF_RWB + SZ_B512;
constexpr size_t OFF_RWW = OFF_RWG + SZ_B512;
constexpr size_t OFF_RWY = OFF_RWW + (size_t)S * 512 * 4;
constexpr size_t OFF_GLL = OFF_RWY + (size_t)S * 512 * 4;
constexpr size_t OFF_GLB = OFF_GLL + (size_t)256 * 4 * 64 * 128 * 4;
constexpr size_t OFF_GLD = OFF_GLB + (size_t)S * 256 * 4;
constexpr size_t OFF_MERGED = OFF_X;
constexpr size_t OFF_VF = OFF_GLD + (size_t)256 * 4 * 64 * 4;
constexpr size_t OFF_MOD = OFF_VF + SZ_B512;
constexpr size_t OFF_COS = OFF_MOD + (size_t)2 * 12288 * 4;
constexpr size_t OFF_SIN = OFF_COS + (size_t)S * 16 * 4;
constexpr size_t OFF_KM = OFF_SIN + (size_t)S * 16 * 4;
constexpr size_t OFF_SEL = OFF_KM + (size_t)4 * 64 * 128 * 4;
constexpr size_t OFF_LORA = OFF_SEL + (size_t)4 * S * 8;
constexpr size_t OFF_BAR = OFF_LORA + (size_t)512 * 448 * 2;
constexpr size_t WS_END = OFF_BAR + 4 * 256;

struct Params {
    const void* in[33];
    float* out;
    unsigned char* ws;
};

DEVI float bf2f(bf16_t b) { return __uint_as_float(((unsigned)b) << 16); }
DEVI bf16_t f2bf(float f) { unsigned u = __float_as_uint(f); u += 0x7FFFu + ((u >> 16) & 1u); return (bf16_t)(u >> 16); }
typedef __bf16 bf16x2_t __attribute__((ext_vector_type(2)));
DEVI unsigned cvt_pk_bf16(float lo, float hi) {
    const f32x2 v = {lo, hi}; const bf16x2_t r = __builtin_convertvector(v, bf16x2_t); return __builtin_bit_cast(unsigned, r);
}
DEVI float sigmoidf_(float x) { return 1.0f / (1.0f + __expf(-x)); }
DEVI float siluf_(float x) { return x / (1.0f + __expf(-x)); }
DEVI float wave_sum(float v) {
#pragma unroll
    for (int o = 32; o >= 1; o >>= 1) v += __shfl_xor(v, o);
    return v;
}
template <int CTRL> DEVI float dpp_f(float v) { return __int_as_float(__builtin_amdgcn_update_dpp(0, __float_as_int(v), CTRL, 0xF, 0xF, true)); }
DEVI float row16_sum(float v) {
    v += dpp_f<0xB1>(v);
    v += dpp_f<0x4E>(v);
    v += dpp_f<0x141>(v);
    v += dpp_f<0x140>(v);
    return v;
}

namespace pg8 {
constexpr int BM = 256, BK = 64, HALF = 128, HTB = HALF * BK * 2, STAGE_BYTES = 8 * HTB, NXCD = 8, WGM = 8;
DEVI int lds_byte(int r, int c) { const int st = (r >> 4) * 2 + (c >> 5), rr = r & 15, cc = c & 31, ob = rr * 64 + cc * 2; return st * 1024 + (ob ^ (((ob >> 9) & 1) << 5)); }
DEVI void stage_rc(int b, int& R, int& C) { const int st = b / 1024, sb = b % 1024, swz = sb ^ (((sb >> 9) & 1) << 5); R = (st >> 1) * 16 + swz / 64; C = (st & 1) * 32 + (swz % 64) / 2; }
DEVI int perm32(int rho) { const int n = rho >> 4, i = rho & 15; return 8 * (i >> 2) + 4 * n + (i & 3); }
struct Unit { int pm, pn; };
struct Gemm { const bf16_t* A; const bf16_t* Bt; int M, N, K; };
struct StaticOrder {
    int nM, nN, nwg, G, c;
    DEVI void init(int M, int N, int G_, int c_) { nM = M / BM; nN = N / BM; nwg = nM * nN; G = G_; c = c_; }
    DEVI bool next(int i, Unit& u) const {
        const long L = (long)i * G + c; if (L >= nwg) return false;
        int wgid = (int)L; { const int q = nwg / NXCD, r = nwg % NXCD, xcd = wgid % NXCD, off = wgid / NXCD; wgid = (xcd < r ? xcd * (q + 1) : r * (q + 1) + (xcd - r) * q) + off; }
        const int nig = WGM * nN, gid = wgid / nig, fm = gid * WGM, gsz = (nM - fm) < WGM ? (nM - fm) : WGM;
        u.pm = fm + ((wgid % nig) % gsz); u.pn = (wgid % nig) / gsz; return true;
    }
};
template <class Epi>
DEVI void gemm_phase(LAS unsigned char* lds, const Gemm g, const StaticOrder& S_, const Epi& E) {
    int tid_ = threadIdx.x; asm volatile("" : "+v"(tid_));
    int K_ = g.K; asm volatile("" : "+s"(K_));
    const int tid = tid_, wid = __builtin_amdgcn_readfirstlane(tid >> 6), lane = tid & 63, wr = wid >> 2, wc = wid & 3, fr = lane & 15, fq = lane >> 4;
    const int K = K_, nt = K / BK;
    unsigned voffA[2], voffB[2];
#pragma unroll
    for (int i = 0; i < 2; ++i) { int R, C; stage_rc(tid * 16 + i * 8192, R, C); const int Rb = (R & ~31) + perm32(R & 31);
        voffA[i] = (unsigned)(R * K + C) * 2u; voffB[i] = (unsigned)(Rb * K + C) * 2u; }
    const size_t kstep = (size_t)(BK * 2);
    const size_t hstep = (size_t)HALF * K * 2;
    const size_t tstep = 2 * hstep;
    const unsigned ldsw = (unsigned)wid * 1024u;
    const int aoff = lds_byte(wr * 64 + fr, fq * 8), boff = lds_byte(wc * 32 + fr, fq * 8);
#define PG8_SA(b, h) (((b) * 2 + (h)) * HTB)
#define PG8_SB(b, h) ((4 + (b) * 2 + (h)) * HTB)
#define PG8_STAGE(bufoff, gbase, voff) do { _Pragma("unroll") for (int _i = 0; _i < 2; ++_i) \
        __builtin_amdgcn_global_load_lds((const unsigned*)((const char*)(gbase) + (voff)[_i]), (LAS unsigned*)(lds + (bufoff) + ldsw + _i * 8192), 16, 0, 0); } while (0)
#define PG8_LDA(dst, b, h) do { _Pragma("unroll") for (int m = 0; m < 4; ++m) _Pragma("unroll") for (int k = 0; k < 2; ++k) dst[m][k] = *(const LAS bf16x8*)(lds + PG8_SA(b, h) + aoff + m * 2048 + k * 1024); } while (0)
#define PG8_LDB(dst, b, h) do { _Pragma("unroll") for (int n = 0; n < 2; ++n) _Pragma("unroll") for (int k = 0; k < 2; ++k) dst[n][k] = *(const LAS bf16x8*)(lds + PG8_SB(b, h) + boff + n * 2048 + k * 1024); } while (0)
#define PG8_MMA(ai, bj, At, Bt) do { __builtin_amdgcn_s_setprio(1); _Pragma("unroll") for (int m = 0; m < 4; ++m) _Pragma("unroll") for (int n = 0; n < 2; ++n) _Pragma("unroll") for (int k = 0; k < 2; ++k) \
        acc[ai][bj][m][n] = __builtin_amdgcn_mfma_f32_16x16x32_bf16(Bt[n][k], At[m][k], acc[ai][bj][m][n], 0, 0, 0); __builtin_amdgcn_s_setprio(0); } while (0)
#define PG8_WAIT_V(n) asm volatile("s_waitcnt vmcnt(" #n ")" ::: "memory")
#define PG8_WAIT_L(n) asm volatile("s_waitcnt lgkmcnt(" #n ")" ::: "memory")
#define PG8_BAR __builtin_amdgcn_s_barrier()
#define PG8_SCHED __builtin_amdgcn_sched_barrier(0)
    Unit cur, nxt; int ui = 0;
    if (!S_.next(0, cur)) return;
    f32x4 acc[2][2][4][2];
#pragma unroll
    for (int a = 0; a < 2; ++a)
#pragma unroll
        for (int b = 0; b < 2; ++b)
#pragma unroll
            for (int m = 0; m < 4; ++m)
#pragma unroll
                for (int n = 0; n < 2; ++n) acc[a][b][m][n] = (f32x4){0.f, 0.f, 0.f, 0.f};
    bf16x8 At[4][2], B0[2][2], B1[2][2];
    const char* cA = (const char*)g.A + (size_t)cur.pm * tstep; const char* cB = (const char*)g.Bt + (size_t)cur.pn * tstep;
    PG8_STAGE(PG8_SB(0, 0), cB, voffB); PG8_STAGE(PG8_SA(0, 0), cA, voffA); PG8_STAGE(PG8_SB(0, 1), cB + hstep, voffB); PG8_STAGE(PG8_SA(0, 1), cA + hstep, voffA);
    if (wr == 1) PG8_BAR;
    PG8_WAIT_V(4); PG8_BAR;
    PG8_STAGE(PG8_SB(1, 0), cB + kstep, voffB); PG8_STAGE(PG8_SA(1, 0), cA + kstep, voffA); PG8_STAGE(PG8_SB(1, 1), cB + hstep + kstep, voffB);
    PG8_WAIT_V(6); PG8_BAR;
    for (;;) {
        const bool has_next = S_.next(ui + 1, nxt);
        const char* nA = has_next ? (const char*)g.A + (size_t)nxt.pm * tstep : cA; const char* nB = has_next ? (const char*)g.Bt + (size_t)nxt.pn * tstep : cB;
        for (int t = 0; t < nt; t += 2) {
            const bool last = (t == nt - 2);
            const char* a1 = cA + (size_t)(t + 1) * kstep;
            const char* a2 = last ? nA : cA + (size_t)(t + 2) * kstep; const char* b2 = last ? nB : cB + (size_t)(t + 2) * kstep;
            const char* a3 = a2 + kstep; const char* b3 = b2 + kstep;
            PG8_LDB(B0, 0, 0); PG8_SCHED; PG8_LDA(At, 0, 0); PG8_STAGE(PG8_SA(1, 1), a1 + hstep, voffA);
            PG8_WAIT_L(8); PG8_BAR; PG8_WAIT_L(0); PG8_MMA(0, 0, At, B0); PG8_BAR; PG8_SCHED;
            PG8_LDB(B1, 0, 1); PG8_STAGE(PG8_SB(0, 0), b2, voffB);
            PG8_BAR; PG8_WAIT_L(0); PG8_MMA(0, 1, At, B1); PG8_BAR;
            PG8_LDA(At, 0, 1); PG8_STAGE(PG8_SA(0, 0), a2, voffA);
            PG8_BAR; PG8_WAIT_L(0); PG8_MMA(1, 0, At, B0); PG8_BAR; PG8_SCHED;
            PG8_STAGE(PG8_SB(0, 1), b2 + hstep, voffB);
            PG8_WAIT_V(6); PG8_BAR; PG8_MMA(1, 1, At, B1); PG8_BAR;
            PG8_LDB(B0, 1, 0); PG8_SCHED; PG8_LDA(At, 1, 0); PG8_STAGE(PG8_SA(0, 1), a2 + hstep, voffA);
            PG8_WAIT_L(8); PG8_BAR; PG8_WAIT_L(0); PG8_MMA(0, 0, At, B0); PG8_BAR; PG8_SCHED;
            PG8_LDB(B1, 1, 1); PG8_STAGE(PG8_SB(1, 0), b3, voffB);
            PG8_BAR; PG8_WAIT_L(0); PG8_MMA(0, 1, At, B1); PG8_BAR;
            PG8_LDA(At, 1, 1); PG8_STAGE(PG8_SA(1, 0), a3, voffA);
            PG8_BAR; PG8_WAIT_L(0); PG8_MMA(1, 0, At, B0); PG8_BAR; PG8_SCHED;
            PG8_STAGE(PG8_SB(1, 1), b3 + hstep, voffB);
            PG8_WAIT_V(6); PG8_BAR; PG8_MMA(1, 1, At, B1); PG8_BAR;
        }
        E(acc, cur, wr, wc, fr, fq);
        if (!has_next) break;
#pragma unroll
        for (int a = 0; a < 2; ++a)
#pragma unroll
            for (int b = 0; b < 2; ++b)
#pragma unroll
                for (int m = 0; m < 4; ++m)
#pragma unroll
                    for (int n = 0; n < 2; ++n) acc[a][b][m][n] = (f32x4){0.f, 0.f, 0.f, 0.f};
        cur = nxt; cA = nA; cB = nB; ++ui;
    }
    PG8_WAIT_V(0);
    if (wr == 0) PG8_BAR;
    PG8_BAR;
#undef PG8_SA
#undef PG8_SB
#undef PG8_STAGE
#undef PG8_LDA
#undef PG8_LDB
#undef PG8_MMA
#undef PG8_WAIT_V
#undef PG8_WAIT_L
#undef PG8_BAR
#undef PG8_SCHED
}
}
using pg8::Unit;

struct EpiInProj {
    bf16_t *G, *P1G, *P1R, *P2; const float *cosT, *sinT;
    DEVI void operator()(const f32x4 (&acc)[2][2][4][2], const Unit& u, int wr, int wc, int fr, int fq) const {
        const int pn = u.pn; const int row0 = u.pm * 256 + wr * 64 + fr; const int cl = wc * 32 + 8 * fq;
        const bool plain = (pn < 39) || (pn >= 48 && pn < 56);
        if (plain) {
            bf16_t* base; int ld, pnl; bool sg = false;
            if (pn < 32) { base = G; ld = 8192; pnl = pn; sg = true; }
            else if (pn < 39) { base = P1G; ld = 1792; pnl = pn - 32; }
            else { base = P1R; ld = 2048; pnl = pn - 48; }
#pragma unroll
            for (int ai = 0; ai < 2; ++ai)
#pragma unroll
                for (int m = 0; m < 4; ++m) {
                    bf16_t* rowp = base + (size_t)(row0 + ai * 128 + m * 16) * ld + pnl * 256 + cl;
#pragma unroll
                    for (int bj = 0; bj < 2; ++bj) {
                        f32x4 v0 = acc[ai][bj][m][0], v1 = acc[ai][bj][m][1];
                        if (sg) {
#pragma unroll
                            for (int j = 0; j < 4; ++j) { v0[j] = sigmoidf_(v0[j]); v1[j] = sigmoidf_(v1[j]); }
                        }
                        u32x4 w; w.x = cvt_pk_bf16(v0[0], v0[1]); w.y = cvt_pk_bf16(v0[2], v0[3]); w.z = cvt_pk_bf16(v1[0], v1[1]); w.w = cvt_pk_bf16(v1[2], v1[3]);
                        *(u32x4*)(rowp + bj * 128) = w;
                    }
                    __builtin_amdgcn_sched_barrier(0);
                }
        } else {
            int t, hbase, arr0;
            if (pn < 48) { const int pl = pn - 39; t = pl / 3; hbase = (pl % 3) * 2; arr0 = t * 6 + hbase; }
            else { const int pl = pn - 56; t = pl / 2; hbase = (pl % 2) * 2; arr0 = 18 + t * 4 + hbase; }
            const bool rope = (t < 2) && (wc == 0);
            const float sc = (t == 0) ? 0.08838834764831845f : 1.0f;
#pragma unroll
            for (int ai = 0; ai < 2; ++ai)
#pragma unroll
                for (int m = 0; m < 4; ++m) {
                    const int row = row0 + ai * 128 + m * 16;
#pragma unroll
                    for (int bj = 0; bj < 2; ++bj) {
                        f32x4 v0 = acc[ai][bj][m][0], v1 = acc[ai][bj][m][1];
                        if (rope) {
                            const f32x4 c0 = *(const f32x4*)(cosT + (size_t)row * 16 + 8 * (fq & 1)), c1 = *(const f32x4*)(cosT + (size_t)row * 16 + 8 * (fq & 1) + 4);
                            const f32x4 s0 = *(const f32x4*)(sinT + (size_t)row * 16 + 8 * (fq & 1)), s1 = *(const f32x4*)(sinT + (size_t)row * 16 + 8 * (fq & 1) + 4);
                            const float sgn = (fq < 2) ? -1.0f : 1.0f;
#pragma unroll
                            for (int j = 0; j < 4; ++j) {
                                const float p0 = __shfl_xor(v0[j], 32), p1 = __shfl_xor(v1[j], 32);
                                v0[j] = v0[j] * c0[j] + sgn * p0 * s0[j];
                                v1[j] = v1[j] * c1[j] + sgn * p1 * s1[j];
                            }
                        }
                        v0 *= sc; v1 *= sc;
                        bf16_t* dst = P2 + (size_t)(arr0 + bj) * ((size_t)S * 128) + (size_t)row * 128 + cl;
                        u32x4 w; w.x = cvt_pk_bf16(v0[0], v0[1]); w.y = cvt_pk_bf16(v0[2], v0[3]); w.z = cvt_pk_bf16(v1[0], v1[1]); w.w = cvt_pk_bf16(v1[2], v1[3]);
                        *(u32x4*)dst = w;
                    }
                    __builtin_amdgcn_sched_barrier(0);
                }
        }
    }
};

struct EpiBranch {
    const bf16_t* Gb; bf16_t* Mg; int first;
    DEVI void operator()(const f32x4 (&acc)[2][2][4][2], const Unit& u, int wr, int wc, int fr, int fq) const {
        const int row0 = u.pm * 256 + wr * 64 + fr; const int col0 = u.pn * 256 + wc * 32 + 8 * fq;
#pragma unroll
        for (int ai = 0; ai < 2; ++ai)
#pragma unroll
            for (int m = 0; m < 4; ++m) {
                const int row = row0 + ai * 128 + m * 16;
#pragma unroll
                for (int bj = 0; bj < 2; ++bj) {
                    const int col = col0 + bj * 128;
                    const u32x4 gw = *(const u32x4*)(Gb + (size_t)row * 8192 + col);
                    bf16_t* mp = Mg + (size_t)row * 2048 + col;
                    float o[8];
#pragma unroll
                    for (int j = 0; j < 4; ++j) { o[j] = acc[ai][bj][m][0][j]; o[4 + j] = acc[ai][bj][m][1][j]; }
#pragma unroll
                    for (int j = 0; j < 4; ++j) {
                        o[2 * j] *= __uint_as_float(gw[j] << 16);
                        o[2 * j + 1] *= __uint_as_float(gw[j] & 0xFFFF0000u);
                    }
                    if (!first) {
                        const u32x4 mw = *(const u32x4*)mp;
#pragma unroll
                        for (int j = 0; j < 4; ++j) { o[2 * j] += __uint_as_float(mw[j] << 16); o[2 * j + 1] += __uint_as_float(mw[j] & 0xFFFF0000u); }
                    }
                    u32x4 w; w.x = cvt_pk_bf16(o[0], o[1]); w.y = cvt_pk_bf16(o[2], o[3]); w.z = cvt_pk_bf16(o[4], o[5]); w.w = cvt_pk_bf16(o[6], o[7]);
                    *(u32x4*)mp = w;
                    __builtin_amdgcn_sched_barrier(0);
                }
            }
    }
};

struct EpiResid {
    const float* src; float* dst; const float* gate;
    DEVI void operator()(const f32x4 (&acc)[2][2][4][2], const Unit& u, int wr, int wc, int fr, int fq) const {
        const int row0 = u.pm * 256 + wr * 64 + fr; const int col0 = u.pn * 256 + wc * 32 + 8 * fq;
        f32x4 gv[2][2];
#pragma unroll
        for (int bj = 0; bj < 2; ++bj)
#pragma unroll
            for (int n = 0; n < 2; ++n) gv[bj][n] = *(const f32x4*)(gate + col0 + bj * 128 + 4 * n);
#pragma unroll
        for (int ai = 0; ai < 2; ++ai)
#pragma unroll
            for (int m = 0; m < 4; ++m) {
                const size_t ro = (size_t)(row0 + ai * 128 + m * 16) * 2048 + col0;
#pragma unroll
                for (int bj = 0; bj < 2; ++bj)
#pragma unroll
                    for (int n = 0; n < 2; ++n) {
                        const f32x4 xv = *(const f32x4*)(src + ro + bj * 128 + 4 * n);
                        *(f32x4*)(dst + ro + bj * 128 + 4 * n) = xv + gv[bj][n] * acc[ai][bj][m][n];
                    }
                __builtin_amdgcn_sched_barrier(0);
            }
    }
};

struct EpiSwiglu {
    bf16_t* act;
    DEVI void operator()(const f32x4 (&acc)[2][2][4][2], const Unit& u, int wr, int wc, int fr, int fq) const {
        const int row0 = u.pm * 256 + wr * 64 + fr; const int col0 = u.pn * 128 + wc * 32 + 8 * fq;
#pragma unroll
        for (int ai = 0; ai < 2; ++ai)
#pragma unroll
            for (int m = 0; m < 4; ++m) {
                float o[8];
#pragma unroll
                for (int j = 0; j < 4; ++j) { o[j] = siluf_(acc[ai][0][m][0][j]) * acc[ai][1][m][0][j]; o[4 + j] = siluf_(acc[ai][0][m][1][j]) * acc[ai][1][m][1][j]; }
                u32x4 w; w.x = cvt_pk_bf16(o[0], o[1]); w.y = cvt_pk_bf16(o[2], o[3]); w.z = cvt_pk_bf16(o[4], o[5]); w.w = cvt_pk_bf16(o[6], o[7]);
                *(u32x4*)(act + (size_t)(row0 + ai * 128 + m * 16) * FFN_H + col0) = w;
                __builtin_amdgcn_sched_barrier(0);
            }
    }
};

template <class Epi>
DEVI void run_gemm(unsigned char* smem, const bf16_t* A, const bf16_t* Bt, int N, int K, const Epi& E) {
    pg8::Gemm g; g.A = A; g.Bt = Bt; g.M = S; g.N = N; g.K = K;
    pg8::StaticOrder so; so.init(S, N, gridDim.x, blockIdx.x);
    pg8::gemm_phase<Epi>((LAS unsigned char*)smem, g, so, E);
}

DEVI int srccol_win(int n) {
    if (n < 8192) return n;
    if (n < 9984) { const int j = n - 8192; return j < 1552 ? 8192 + j : -1; }
    if (n < 12288) return 9744 + (n - 9984);
    if (n < 14336) { const int j = n - 12288; return j < 1984 ? 12048 + j : -1; }
    return 14032 + (n - 14336);
}
DEVI int srccol_ffn(int n) { return ((n >> 7) & 1) * FFN_H + (n >> 8) * 128 + (n & 127); }

DEVI void conv_tile(unsigned char* smem, const float* src, int ldsrc, int K, bf16_t* dst, int mode, int ntile, int ktile) {
    int tid_ = threadIdx.x; asm volatile("" : "+v"(tid_));
    float* tile = (float*)smem;
    const int tid = tid_, tx = tid & 63, ty = tid >> 6;
    const int n0 = ntile * 64, k0 = ktile * 64;
    const int n = n0 + tx;
    const int sc = mode == 0 ? srccol_win(n) : (mode == 1 ? srccol_ffn(n) : n);
#pragma unroll
    for (int i = 0; i < 8; ++i) {
        const int kk = ty + 8 * i;
        tile[kk * 65 + tx] = sc >= 0 ? src[(size_t)(k0 + kk) * ldsrc + sc] : 0.0f;
    }
    __syncthreads();
    const int nr = tid >> 3, ks = (tid & 7) * 8;
    float v[8];
#pragma unroll
    for (int j = 0; j < 8; ++j) v[j] = tile[(ks + j) * 65 + nr];
    u32x4 w; w.x = cvt_pk_bf16(v[0], v[1]); w.y = cvt_pk_bf16(v[2], v[3]); w.z = cvt_pk_bf16(v[4], v[5]); w.w = cvt_pk_bf16(v[6], v[7]);
    *(u32x4*)(dst + (size_t)(n0 + nr) * K + k0 + ks) = w;
    __syncthreads();
}

DEVI void phase_convert(const Params& p, int l, unsigned char* smem, int bid, int nb) {
    const int c0 = 248 * 32, c1 = c0 + 32 * 8, c2 = c1 + 32 * 4, c3 = c2 + 32 * 8, c4 = c3 + 32 * 8, c5 = c4 + 32 * 32, c6 = c5 + 176 * 32, c7 = c6 + 32 * 88;
    unsigned char* ws = p.ws;
    {
        int tl_ = threadIdx.x; asm volatile("" : "+v"(tl_)); int ll_ = l; asm volatile("" : "+s"(ll_));
        size_t wzz_ = 0; asm volatile("" : "+s"(wzz_));
        bf16_t* WT = (bf16_t*)(ws + wzz_ + OFF_LORA);
        const float* w2 = (const float*)p.in[12] + (size_t)ll_ * 96 * 512; const float* a2 = (const float*)p.in[14] + (size_t)ll_ * 96 * 512; const float* g2 = (const float*)p.in[15] + (size_t)ll_ * 256 * 512;
        for (int k = bid; k < 448; k += nb) {
            const int n = tl_;
            const float v = k < 96 ? w2[k * 512 + n] : (k < 192 ? a2[(k - 96) * 512 + n] : g2[(k - 192) * 512 + n]);
            WT[n * 448 + k] = f2bf(v);
        }
    }
    for (int it = bid; it < c7; it += nb) {
        if (it < c0) { conv_tile(smem, (const float*)p.in[6] + (size_t)l * D * IN_TOTAL, IN_TOTAL, D, (bf16_t*)(ws + OFF_WIN), 0, it / 32, it % 32); }
        else if (it < c1) { const int j = it - c0; conv_tile(smem, (const float*)p.in[24] + (size_t)l * 512 * D, D, 512, (bf16_t*)(ws + OFF_WBA), 2, j / 8, j % 8); }
        else if (it < c2) { const int j = it - c1; conv_tile(smem, (const float*)p.in[25] + (size_t)l * 256 * D, D, 256, (bf16_t*)(ws + OFF_WBB), 2, j / 4, j % 4); }
        else if (it < c3) { const int j = it - c2; conv_tile(smem, (const float*)p.in[26] + (size_t)l * 512 * D, D, 512, (bf16_t*)(ws + OFF_WBC), 2, j / 8, j % 8); }
        else if (it < c4) { const int j = it - c3; conv_tile(smem, (const float*)p.in[27] + (size_t)l * 512 * D, D, 512, (bf16_t*)(ws + OFF_WBD), 2, j / 8, j % 8); }
        else if (it < c5) { const int j = it - c4; conv_tile(smem, (const float*)p.in[28] + (size_t)l * D * D, D, D, (bf16_t*)(ws + OFF_WOUT), 2, j / 32, j % 32); }
        else if (it < c6) { const int j = it - c5; conv_tile(smem, (const float*)p.in[30] + (size_t)l * D * 2 * FFN_H, 2 * FFN_H, D, (bf16_t*)(ws + OFF_WF1), 1, j / 32, j % 32); }
        else { const int j = it - c6; conv_tile(smem, (const float*)p.in[31] + (size_t)l * FFN_H * D, D, FFN_H, (bf16_t*)(ws + OFF_WF2), 2, j / 88, j % 88); }
    }
}

DEVI void phase_mod_rope(const Params& p, unsigned char* smem, int bid, int nb) {
    int tid_ = threadIdx.x; asm volatile("" : "+v"(tid_)); size_t wz_ = 0; asm volatile("" : "+s"(wz_)); unsigned char* ws_ = p.ws + wz_;
    const int tid = tid_;
    float* sc = (float*)smem;
    float* red = sc + 2048;
    const float* c = (const float*)p.in[1];
    for (int i = tid; i < D; i += NT) sc[i] = siluf_(c[i]);
    __syncthreads();
    float* mod = (float*)(ws_ + OFF_MOD);
    for (int it = bid; it < 192; it += nb) {
        const int l = it / 96, cg0 = (it % 96) * 128;
        const float* W = (const float*)p.in[3] + (size_t)l * D * 12288;
        const int col = tid & 127, kq = tid >> 7;
        float a = 0.f;
        const float* wp = W + (size_t)(kq * 512) * 12288 + cg0 + col;
#pragma unroll 8
        for (int k = 0; k < 512; ++k) a += sc[kq * 512 + k] * wp[(size_t)k * 12288];
        red[kq * 128 + col] = a;
        __syncthreads();
        if (tid < 128) mod[l * 12288 + cg0 + tid] = red[tid] + red[128 + tid] + red[256 + tid] + red[384 + tid] + ((const float*)p.in[4])[l * 12288 + cg0 + tid];
        __syncthreads();
    }
    const float invf[16] = {1.000000000e+00f, 4.403665960e-01f, 1.939227432e-01f, 8.539710194e-02f, 3.760603070e-02f, 1.656043902e-02f, 7.292664610e-03f, 3.211445874e-03f,
                            1.414213562e-03f, 6.227723788e-04f, 2.742481884e-04f, 1.207697351e-04f, 5.318296098e-05f, 2.341999971e-05f, 1.031338616e-05f, 4.541670478e-06f};
    const int* pos = (const int*)p.in[2];
    float* cosT = (float*)(ws_ + OFF_COS); float* sinT = (float*)(ws_ + OFF_SIN);
    for (int e = bid * NT + tid; e < S * 16; e += nb * NT) {
        const int t = e >> 4, i = e & 15;
        float fi = invf[0];
#pragma unroll
        for (int j = 1; j < 16; ++j) fi = (i == j) ? invf[j] : fi;
        const float ang = (float)pos[t] * fi;
        const double a = (double)ang;
        const double kq = __builtin_rint(a * 0.15915494309189535);
        const double r = a - kq * 6.283185307179586;
        const double y = r * 0.25, y2 = y * y;
        double s = y * (1.0 - y2 / 6.0 * (1.0 - y2 / 20.0 * (1.0 - y2 / 42.0 * (1.0 - y2 / 72.0 * (1.0 - y2 / 110.0 * (1.0 - y2 / 156.0))))));
        double cc = 1.0 - y2 / 2.0 * (1.0 - y2 / 12.0 * (1.0 - y2 / 30.0 * (1.0 - y2 / 56.0 * (1.0 - y2 / 90.0 * (1.0 - y2 / 132.0 * (1.0 - y2 / 182.0))))));
        double s2 = 2.0 * s * cc, c2 = 1.0 - 2.0 * s * s;
        double s4 = 2.0 * s2 * c2, c4 = 1.0 - 2.0 * s2 * s2;
        cosT[e] = (float)c4; sinT[e] = (float)s4;
    }
}

DEVI void phase_norm(const float* x, const float* gain, const float* shift, const float* scale, bf16_t* h, int bid, int nb) {
    int tid_ = threadIdx.x; asm volatile("" : "+v"(tid_));
    const int wid = tid_ >> 6, lane = tid_ & 63;
    for (int row = bid * 8 + wid; row < S; row += nb * 8) {
        const f32x4* xr = (const f32x4*)(x + (size_t)row * D);
        f32x4 v[8]; float ss = 0.f;
#pragma unroll
        for (int i = 0; i < 8; ++i) { v[i] = xr[lane + 64 * i]; ss += v[i][0] * v[i][0] + v[i][1] * v[i][1] + v[i][2] * v[i][2] + v[i][3] * v[i][3]; }
        ss = wave_sum(ss);
        const float r = rsqrtf(ss * (1.0f / D) + 1e-6f);
#pragma unroll
        for (int i = 0; i < 8; ++i) {
            const int c4 = lane + 64 * i;
            const f32x4 g = ((const f32x4*)gain)[c4], sh = ((const f32x4*)shift)[c4], sc = ((const f32x4*)scale)[c4];
            f32x4 y = v[i] * r * g * (sc + 1.0f) + sh;
            u32x2 w; w.x = cvt_pk_bf16(y[0], y[1]); w.y = cvt_pk_bf16(y[2], y[3]);
            *(u32x2*)(h + (size_t)row * D + c4 * 4) = w;
        }
    }
}

DEVI void phase_final_norm(float* x, const float* gain, int bid, int nb) {
    int tid_ = threadIdx.x; asm volatile("" : "+v"(tid_));
    const int wid = tid_ >> 6, lane = tid_ & 63;
    for (int row = bid * 8 + wid; row < S; row += nb * 8) {
        f32x4* xr = (f32x4*)(x + (size_t)row * D);
        f32x4 v[8]; float ss = 0.f;
#pragma unroll
        for (int i = 0; i < 8; ++i) { v[i] = xr[lane + 64 * i]; ss += v[i][0] * v[i][0] + v[i][1] * v[i][1] + v[i][2] * v[i][2] + v[i][3] * v[i][3]; }
        ss = wave_sum(ss);
        const float r = rsqrtf(ss * (1.0f / D) + 1e-6f);
#pragma unroll
        for (int i = 0; i < 8; ++i) xr[lane + 64 * i] = v[i] * r * ((const f32x4*)gain)[lane + 64 * i];
    }
}

DEVI float logsigmoidf_(float x) { return fminf(x, 0.f) - log1pf(__expf(-fabsf(x))); }

DEVI void gla_pass1(const Params& p, int l, unsigned char* smem, int item) {
    int tid_ = threadIdx.x; asm volatile("" : "+v"(tid_)); size_t wz_ = 0; asm volatile("" : "+s"(wz_)); unsigned char* ws_ = p.ws + wz_;
    const int n = item >> 2, h = item & 3, tok0 = n * 64, tid = tid_;
    float* sB = (float*)smem;
    float* sK = sB + 4096;
    float* sV = sK + 4096;
    float* sA = sV + 8192;
    float* sW = sA + 1024;
    const bf16_t* P = (const bf16_t*)(ws_ + OFF_P1G);
    const float* wa2 = (const float*)p.in[7] + (size_t)l * 16 * 256;
    const float* ba2 = (const float*)p.in[8] + (size_t)l * 256;
    for (int e = tid; e < 1024; e += NT) { sA[e] = bf2f(P[(size_t)(tok0 + (e >> 4)) * 1792 + 1536 + (e & 15)]); sW[e] = wa2[(e >> 6) * 256 + h * 64 + (e & 63)]; }
    __syncthreads();
    for (int e = tid; e < 4096; e += NT) {
        const int t = e >> 6, d = e & 63;
        float x = ba2[h * 64 + d];
#pragma unroll
        for (int r = 0; r < 16; ++r) x += sA[t * 16 + r] * sW[r * 64 + d];
        sB[e] = logsigmoidf_(x) * (1.0f / 16.0f);
    }
    __syncthreads();
    if (tid < 64) { float a = 0.f; for (int t = 0; t < 64; ++t) { a += sB[t * 64 + tid]; sB[t * 64 + tid] = a; } }
    __syncthreads();
    float* Bbuf = (float*)(ws_ + OFF_GLB);
    for (int e = tid; e < 4096; e += NT) {
        const int s = e >> 6, d = e & 63;
        const float b = sB[e], bl = sB[63 * 64 + d];
        sK[e] = bf2f(P[(size_t)(tok0 + s) * 1792 + 256 + h * 64 + d]) * __expf(bl - b);
        Bbuf[(size_t)(tok0 + s) * 256 + h * 64 + d] = b;
    }
    for (int e = tid; e < 8192; e += NT) sV[e] = bf2f(P[(size_t)(tok0 + (e >> 7)) * 1792 + 512 + h * 128 + (e & 127)]);
    if (tid < 64) ((float*)(ws_ + OFF_GLD))[(size_t)item * 64 + tid] = __expf(sB[63 * 64 + tid]);
    __syncthreads();
    {
        const int d = tid >> 3, eg = (tid & 7) * 16;
        f32x4 a0 = {0, 0, 0, 0}, a1 = a0, a2 = a0, a3 = a0;
        for (int s = 0; s < 64; ++s) {
            const float kd = sK[s * 64 + d];
            const f32x4* vp = (const f32x4*)(sV + s * 128 + eg);
            a0 += kd * vp[0]; a1 += kd * vp[1]; a2 += kd * vp[2]; a3 += kd * vp[3];
        }
        f32x4* Lp = (f32x4*)((float*)(ws_ + OFF_GLL) + ((size_t)item * 64 + d) * 128 + eg);
        Lp[0] = a0; Lp[1] = a1; Lp[2] = a2; Lp[3] = a3;
    }
    __syncthreads();
}

DEVI void gla_pass2(const Params& p, int item) {
    int tid_ = threadIdx.x; asm volatile("" : "+v"(tid_)); size_t wz_ = 0; asm volatile("" : "+s"(wz_)); unsigned char* ws_ = p.ws + wz_;
    const int idx = item * NT + tid_;
    const int h = idx >> 13, de = idx & 8191, d = de >> 7;
    float* L = (float*)(ws_ + OFF_GLL); const float* Dc = (const float*)(ws_ + OFF_GLD);
    float st = 0.f;
    for (int n0 = 0; n0 < 256; n0 += 8) {
        float tmp[8], dc[8];
#pragma unroll
        for (int j = 0; j < 8; ++j) { tmp[j] = L[((size_t)((n0 + j) * 4 + h) * 64) * 128 + de]; dc[j] = Dc[((n0 + j) * 4 + h) * 64 + d]; }
#pragma unroll
        for (int j = 0; j < 8; ++j) { L[((size_t)((n0 + j) * 4 + h) * 64) * 128 + de] = st; st = dc[j] * st + tmp[j]; }
    }
}

DEVI void gla_pass3(const Params& p, int l, unsigned char* smem, int item) {
    int tid_ = threadIdx.x; asm volatile("" : "+v"(tid_)); size_t wz_ = 0; asm volatile("" : "+s"(wz_)); unsigned char* ws_ = p.ws + wz_;
    const int n = item >> 2, h = item & 3, tok0 = n * 64, tid = tid_;
    float* sQ = (float*)smem;
    float* sK = sQ + 4096;
    float* sV = sK + 4160;
    float* sS = sV + 8192;
    float* sSc = sS + 8192;
    const bf16_t* P = (const bf16_t*)(ws_ + OFF_P1G);
    const float* Bbuf = (const float*)(ws_ + OFF_GLB);
    for (int e = tid; e < 4096; e += NT) {
        const int t = e >> 6, d = e & 63;
        const float b = Bbuf[(size_t)(tok0 + t) * 256 + h * 64 + d];
        sQ[e] = bf2f(P[(size_t)(tok0 + t) * 1792 + h * 64 + d]) * 0.125f * __expf(b);
        sK[t * 65 + d] = bf2f(P[(size_t)(tok0 + t) * 1792 + 256 + h * 64 + d]) * __expf(-b);
    }
    const float* Lp = (const float*)(ws_ + OFF_GLL) + (size_t)item * 8192;
    for (int e = tid; e < 8192; e += NT) { sV[e] = bf2f(P[(size_t)(tok0 + (e >> 7)) * 1792 + 512 + h * 128 + (e & 127)]); sS[e] = Lp[e]; }
    __syncthreads();
    {
        const int t = tid >> 3, sg = (tid & 7) * 8;
        float a[8];
#pragma unroll
        for (int j = 0; j < 8; ++j) a[j] = 0.f;
        for (int d = 0; d < 64; ++d) {
            const float qv = sQ[t * 64 + d];
#pragma unroll
            for (int j = 0; j < 8; ++j) a[j] += qv * sK[(sg + j) * 65 + d];
        }
#pragma unroll
        for (int j = 0; j < 8; ++j) sSc[t * 64 + sg + j] = (sg + j <= t) ? a[j] : 0.f;
    }
    __syncthreads();
    {
        const int t = tid >> 3, eg = (tid & 7) * 16;
        f32x4 a0 = {0, 0, 0, 0}, a1 = a0, a2 = a0, a3 = a0;
        for (int d = 0; d < 64; ++d) {
            const float qv = sQ[t * 64 + d];
            const f32x4* sp = (const f32x4*)(sS + d * 128 + eg);
            a0 += qv * sp[0]; a1 += qv * sp[1]; a2 += qv * sp[2]; a3 += qv * sp[3];
        }
        for (int s = 0; s < 64; ++s) {
            const float sc = sSc[t * 64 + s];
            const f32x4* vp = (const f32x4*)(sV + s * 128 + eg);
            a0 += sc * vp[0]; a1 += sc * vp[1]; a2 += sc * vp[2]; a3 += sc * vp[3];
        }
        float ss = 0.f;
#pragma unroll
        for (int j = 0; j < 4; ++j) ss += a0[j] * a0[j] + a1[j] * a1[j] + a2[j] * a2[j] + a3[j] * a3[j];
        ss += __shfl_xor(ss, 1); ss += __shfl_xor(ss, 2); ss += __shfl_xor(ss, 4);
        const float r = rsqrtf(ss * (1.0f / 128.0f) + 1e-6f);
        const float* gn = (const float*)p.in[9] + (size_t)l * 128 + eg;
        const bf16_t* gp = P + (size_t)(tok0 + t) * 1792 + 1024 + h * 128 + eg;
        float o[16];
#pragma unroll
        for (int j = 0; j < 4; ++j) { o[j] = a0[j]; o[4 + j] = a1[j]; o[8 + j] = a2[j]; o[12 + j] = a3[j]; }
#pragma unroll
        for (int j = 0; j < 16; ++j) o[j] = o[j] * r * gn[j] * siluf_(bf2f(gp[j]));
        bf16_t* op = (bf16_t*)(ws_ + OFF_OGLA) + (size_t)(tok0 + t) * 512 + h * 128 + eg;
        u32x4 w0, w1;
        w0.x = cvt_pk_bf16(o[0], o[1]); w0.y = cvt_pk_bf16(o[2], o[3]); w0.z = cvt_pk_bf16(o[4], o[5]); w0.w = cvt_pk_bf16(o[6], o[7]);
        w1.x = cvt_pk_bf16(o[8], o[9]); w1.y = cvt_pk_bf16(o[10], o[11]); w1.z = cvt_pk_bf16(o[12], o[13]); w1.w = cvt_pk_bf16(o[14], o[15]);
        *(u32x4*)op = w0; *(u32x4*)(op + 8) = w1;
    }
    __syncthreads();
}

DEVI void rwkv_prep(const Params& p, int l, unsigned char* smem, int item) {
    int tid_ = threadIdx.x; asm volatile("" : "+v"(tid_)); size_t wz_ = 0; asm volatile("" : "+s"(wz_)); unsigned char* ws_ = p.ws + wz_;
    const int tok0 = item * 16, c = tid_, tid = tid_;
    bf16_t* sX = (bf16_t*)smem;
    float* sAcc = (float*)(smem + 16384);
    float* sVx = (float*)(smem + 16384);
    float* sMid = sVx + 512 * 16;
    const bf16_t* P = (const bf16_t*)(ws_ + OFF_P1R);
    const float* mu = (const float*)p.in[10] + (size_t)l * 1984;
    bf16_t lx[14], lxp[14];
#pragma unroll
    for (int i = 0; i < 14; ++i) {
        const int e = tid + i * NT, t = e / 448, j = e % 448, col = 1536 + j, tok = tok0 + t;
        lx[i] = P[(size_t)tok * 2048 + col]; lxp[i] = tok > 0 ? P[(size_t)(tok - 1) * 2048 + col] : (bf16_t)0;
    }
#pragma unroll
    for (int i = 0; i < 14; ++i) {
        const int e = tid + i * NT;
        const int t = e / 448, j = e % 448, col = 1536 + j;
        const float x = bf2f(lx[i]);
        const float xp = bf2f(lxp[i]);
        const float xs = x + (xp - x) * mu[col];
        float v;
        if (j < 96) { const float e2 = __expf(2.0f * xs); v = 1.0f - 2.0f / (e2 + 1.0f); }
        else if (j < 192) v = xs;
        else v = sigmoidf_(xs);
        sX[t * 456 + j] = f2bf(v);
    }
    const float mu_r = mu[c], mu_k = mu[512 + c], mu_v = mu[1024 + c];
    bf16_t xv[17];
    xv[0] = tok0 > 0 ? P[(size_t)(tok0 - 1) * 2048 + 1024 + c] : (bf16_t)0;
#pragma unroll
    for (int t = 0; t < 16; ++t) xv[t + 1] = P[(size_t)(tok0 + t) * 2048 + 1024 + c];
    __syncthreads();
    {
        const int wid = tid >> 6, lane = tid & 63, li = lane & 15, g = lane >> 4;
        const bf16_t* WT = (const bf16_t*)(ws_ + OFF_LORA);
#pragma unroll
        for (int lo = 0; lo < 3; ++lo) {
            const int kb = lo == 0 ? 0 : (lo == 1 ? 96 : 192), nks = lo == 2 ? 8 : 3;
            f32x4 acc[4];
#pragma unroll
            for (int q = 0; q < 4; ++q) acc[q] = (f32x4){0.f, 0.f, 0.f, 0.f};
            for (int ks = 0; ks < nks; ++ks) {
                const bf16x8 af = *(const bf16x8*)(sX + li * 456 + kb + ks * 32 + g * 8);
#pragma unroll
                for (int q = 0; q < 4; ++q) {
                    const bf16x8 bfr = *(const bf16x8*)(WT + (size_t)((wid * 4 + q) * 16 + li) * 448 + kb + ks * 32 + g * 8);
                    acc[q] = __builtin_amdgcn_mfma_f32_16x16x32_bf16(af, bfr, acc[q], 0, 0, 0);
                }
            }
#pragma unroll
            for (int q = 0; q < 4; ++q)
#pragma unroll
                for (int r = 0; r < 4; ++r) sAcc[(lo * 16 + 4 * g + r) * 512 + (wid * 4 + q) * 16 + li] = acc[q][r];
        }
    }
    __syncthreads();
    float wacc[16], aacc[16], gacc[16];
#pragma unroll
    for (int t = 0; t < 16; ++t) { wacc[t] = sAcc[t * 512 + c]; aacc[t] = sAcc[(16 + t) * 512 + c]; gacc[t] = sAcc[(32 + t) * 512 + c]; }
    __syncthreads();
#pragma unroll
    for (int t = 0; t < 16; ++t) { const float x = bf2f(xv[t + 1]), xp = bf2f(xv[t]); sVx[c * 16 + t] = x + (xp - x) * mu_v; }
    __syncthreads();
    float vacc[16];
#pragma unroll
    for (int t = 0; t < 16; ++t) vacc[t] = 0.f;
    if (l > 0) {
        const float* v1 = (const float*)p.in[22];
        const float* v2 = (const float*)p.in[23];
        {
            const int m = tid & 63, cp = tid >> 6;
            float ma[16];
#pragma unroll
            for (int t = 0; t < 16; ++t) ma[t] = 0.f;
#pragma unroll 8
            for (int cc = 0; cc < 64; ++cc) {
                const float w = v1[(cp * 64 + cc) * 64 + m]; const f32x4* lp = (const f32x4*)(sVx + (cp * 64 + cc) * 16);
#pragma unroll
                for (int q = 0; q < 4; ++q) { const f32x4 x = lp[q]; ma[4 * q] += x[0] * w; ma[4 * q + 1] += x[1] * w; ma[4 * q + 2] += x[2] * w; ma[4 * q + 3] += x[3] * w; }
            }
            float* sP = sMid + 64 * 16;
#pragma unroll
            for (int q = 0; q < 4; ++q) *(f32x4*)(sP + (cp * 64 + m) * 16 + 4 * q) = (f32x4){ma[4 * q], ma[4 * q + 1], ma[4 * q + 2], ma[4 * q + 3]};
            __syncthreads();
            for (int e = tid; e < 1024; e += NT) {
                float a = 0.f;
#pragma unroll
                for (int k = 0; k < 8; ++k) a += sP[k * 1024 + e];
                sMid[e] = a;
            }
        }
        __syncthreads();
#pragma unroll 8
        for (int m = 0; m < 64; ++m) {
            const float w = v2[m * 512 + c]; const f32x4* lp = (const f32x4*)(sMid + m * 16);
#pragma unroll
            for (int q = 0; q < 4; ++q) { const f32x4 x = lp[q]; vacc[4 * q] += x[0] * w; vacc[4 * q + 1] += x[1] * w; vacc[4 * q + 2] += x[2] * w; vacc[4 * q + 3] += x[3] * w; }
        }
    }
    const float w0 = ((const float*)p.in[11])[l * 512 + c], a0 = ((const float*)p.in[13])[l * 512 + c];
    const float k_k = ((const float*)p.in[16])[l * 512 + c], k_a = ((const float*)p.in[17])[l * 512 + c];
    const float v0 = l > 0 ? ((const float*)p.in[21])[c] : 0.f;
    bf16_t* R = (bf16_t*)(ws_ + OFF_RWR); bf16_t* Kb = (bf16_t*)(ws_ + OFF_RWK); bf16_t* Vb = (bf16_t*)(ws_ + OFF_RWV);
    bf16_t* Ab = (bf16_t*)(ws_ + OFF_RWA); bf16_t* Bb = (bf16_t*)(ws_ + OFF_RWB); bf16_t* Gb = (bf16_t*)(ws_ + OFF_RWG);
    float* Wb = (float*)(ws_ + OFF_RWW); bf16_t* VF = (bf16_t*)(ws_ + OFF_VF);
    bf16_t xrr[17], xkr[17], vfr[16];
    xrr[0] = tok0 > 0 ? P[(size_t)(tok0 - 1) * 2048 + c] : (bf16_t)0; xkr[0] = tok0 > 0 ? P[(size_t)(tok0 - 1) * 2048 + 512 + c] : (bf16_t)0;
#pragma unroll
    for (int t = 0; t < 16; ++t) { xrr[t + 1] = P[(size_t)(tok0 + t) * 2048 + c]; xkr[t + 1] = P[(size_t)(tok0 + t) * 2048 + 512 + c]; vfr[t] = l > 0 ? VF[(size_t)(tok0 + t) * 512 + c] : (bf16_t)0; }
#pragma unroll
    for (int t = 0; t < 16; ++t) {
        const size_t tok = tok0 + t;
        const float xr = bf2f(xrr[t + 1]), xk = bf2f(xkr[t + 1]), xpr = bf2f(xrr[t]), xpk = bf2f(xkr[t]);
        const float r = xr + (xpr - xr) * mu_r, k = xk + (xpk - xk) * mu_k;
        float v = sVx[c * 16 + t];
        const float z = -(w0 + wacc[t]);
        const float sp = fmaxf(z, 0.f) + __logf(1.0f + __expf(-fabsf(z)));
        const float decay = __expf(-__expf(-sp - 0.5f));
        const float a = sigmoidf_(a0 + aacc[t]);
        if (l == 0) VF[tok * 512 + c] = f2bf(v);
        else { const float vf = bf2f(vfr[t]); v = v + (vf - v) * sigmoidf_(v0 + vacc[t]); }
        float kk = k * k_k;
        const float ss = wave_sum(kk * kk);
        kk = kk * (1.0f / fmaxf(__builtin_sqrtf(ss), 1e-12f));
        const float km = k * (1.0f + (a - 1.0f) * k_a);
        R[tok * 512 + c] = f2bf(r); Kb[tok * 512 + c] = f2bf(km); Vb[tok * 512 + c] = f2bf(v);
        Ab[tok * 512 + c] = f2bf(-kk); Bb[tok * 512 + c] = f2bf(kk * a); Gb[tok * 512 + c] = f2bf(gacc[t]);
        Wb[tok * 512 + c] = decay;
    }
    __syncthreads();
}

#define SBM do { asm volatile("" ::: "memory"); __builtin_amdgcn_sched_barrier(0); } while (0)
#define RAW_BAR do { asm volatile("s_waitcnt lgkmcnt(0)" ::: "memory"); __builtin_amdgcn_s_barrier(); asm volatile("" ::: "memory"); } while (0)
DEVI void rwkv_scan(const Params& p, unsigned char* smem, int b) {
    int tid_ = threadIdx.x; asm volatile("" : "+v"(tid_)); size_t wz_ = 0; asm volatile("" : "+s"(wz_)); unsigned char* ws_ = p.ws + wz_;
    constexpr int CH = 16, NR = 8, NCH = S / CH;
    constexpr int VEC = NR * 9 * 64, SCL = NR * 4, VVN = NR * 64 * 2, BUF = VEC + SCL + VVN;
    const int head = b >> 2, quarter = b & 3, tid = tid_, wid = tid >> 6, lane = tid & 63;
    float* stg = (float*)smem;
    float* part = stg + 2 * BUF;
    int* sRole = (int*)(part + 2 * CH * 256);
    const bf16_t* R = (const bf16_t*)(ws_ + OFF_RWR); const bf16_t* Kb = (const bf16_t*)(ws_ + OFF_RWK); const bf16_t* Vb = (const bf16_t*)(ws_ + OFF_RWV);
    const bf16_t* Ab = (const bf16_t*)(ws_ + OFF_RWA); const bf16_t* Bb = (const bf16_t*)(ws_ + OFF_RWB);
    const float* Wb = (const float*)(ws_ + OFF_RWW); float* Y = (float*)(ws_ + OFF_RWY);
    if (lane == 0) sRole[wid] = (int)((__builtin_amdgcn_s_getreg(2308)) & 3);
    __syncthreads();
    int role = -1;
    {
        int simd[8];
#pragma unroll
        for (int w = 0; w < 8; ++w) simd[w] = sRole[w];
        unsigned used_simd = 0u, scan_mask = 0u; int nscan = 0;
#pragma unroll
        for (int w = 0; w < 8; ++w) { const unsigned bit = 1u << simd[w]; if (!(used_simd & bit) && nscan < 4) { used_simd |= bit; scan_mask |= 1u << w; ++nscan; } }
#pragma unroll
        for (int w = 0; w < 8; ++w) { if (!((scan_mask >> w) & 1u) && nscan < 4) { scan_mask |= 1u << w; ++nscan; } }
        const int below = __builtin_popcount(scan_mask & ((1u << wid) - 1u));
        role = ((scan_mask >> wid) & 1u) ? below : 4 + (wid - below);
    }
    role = __builtin_amdgcn_readfirstlane(role);
    __syncthreads();
    const bool helper = role >= 4;
    const int lt = (role - 4) * 64 + lane;
    const bool hvec = lt < 128;
    const int hr = (lt >> 4) & 7, hc = lt & 15;
    struct Pre { u32x2 r1, k1, a1, b1, r2, k2, a2, b2; f32x4 w1, w2; };
    auto issue = [&](int chunk, Pre& q) {
        const size_t o1 = (size_t)(chunk * CH + 2 * hr) * 512 + head * 64 + 4 * hc, o2 = o1 + 512;
        if (hvec) {
            q.r1 = *(const u32x2*)(R + o1); q.k1 = *(const u32x2*)(Kb + o1); q.a1 = *(const u32x2*)(Ab + o1); q.b1 = *(const u32x2*)(Bb + o1); q.w1 = *(const f32x4*)(Wb + o1);
            q.r2 = *(const u32x2*)(R + o2); q.k2 = *(const u32x2*)(Kb + o2); q.a2 = *(const u32x2*)(Ab + o2); q.b2 = *(const u32x2*)(Bb + o2); q.w2 = *(const f32x4*)(Wb + o2);
        } else { q.r1 = *(const u32x2*)(Vb + o1); q.r2 = *(const u32x2*)(Vb + o2); }
    };
    auto cv4 = [&](const u32x2& w) { f32x4 f; f[0] = __uint_as_float(w.x << 16); f[1] = __uint_as_float(w.x & 0xFFFF0000u); f[2] = __uint_as_float(w.y << 16); f[3] = __uint_as_float(w.y & 0xFFFF0000u); return f; };
    auto sum4 = [&](const f32x4& x) { return (x[0] + x[1]) + (x[2] + x[3]); };
    auto commit = [&](int bi, const Pre& q) {
        float* base = stg + bi * BUF;
        if (hvec) {
            const f32x4 r1 = cv4(q.r1), k1 = cv4(q.k1), a1 = cv4(q.a1), b1 = cv4(q.b1), r2 = cv4(q.r2), k2 = cv4(q.k2), a2 = cv4(q.a2), b2 = cv4(q.b2), w1 = q.w1, w2 = q.w2;
            float* vp = base + hr * (9 * 64) + 4 * hc;
            *(f32x4*)(vp + 0 * 64) = a1;
            *(f32x4*)(vp + 1 * 64) = w1 * a2;
            *(f32x4*)(vp + 2 * 64) = w1 * r1;
            *(f32x4*)(vp + 3 * 64) = w1 * w2;
            *(f32x4*)(vp + 4 * 64) = b1 * w2;
            *(f32x4*)(vp + 5 * 64) = k1 * w2;
            *(f32x4*)(vp + 6 * 64) = b2;
            *(f32x4*)(vp + 7 * 64) = k2;
            *(f32x4*)(vp + 8 * 64) = r2;
            const float be = row16_sum(sum4(b1 * a2)), ka = row16_sum(sum4(k1 * a2)), rb = row16_sum(sum4(b1 * r1)), rk = row16_sum(sum4(k1 * r1));
            if (hc == 0) *(f32x4*)(base + VEC + hr * 4) = (f32x4){be, ka, rb * (1.0f / 16.0f), rk * (1.0f / 16.0f)};
        } else {
            const f32x4 v1 = cv4(q.r1), v2 = cv4(q.r2);
            float* vv = base + VEC + SCL + (hr * 64 + 4 * hc) * 2;
            *(f32x4*)vv = (f32x4){v1[0], v2[0], v1[1], v2[1]}; *(f32x4*)(vv + 4) = (f32x4){v1[2], v2[2], v1[3], v2[3]};
        }
    };
    auto reduce_store = [&](int chunk) {
        const int t = lt >> 4, k = (lt >> 2) & 3, rr = lt & 3;
        const f32x4* pp = (const f32x4*)(part + ((chunk & 1) * CH + t) * 256 + k * 64 + rr * 16);
        const f32x4 s4 = pp[0] + pp[1] + pp[2] + pp[3];
        Y[(size_t)(chunk * CH + t) * 512 + head * 64 + quarter * 16 + k * 4 + rr] = (s4[0] + s4[1]) + (s4[2] + s4[3]);
    };
    Pre pr0, pr1, pr2, pr3;
    if (helper) { issue(0, pr0); commit(0, pr0); issue(1, pr1); issue(2, pr2); issue(3, pr3); }
    __syncthreads();
    const int row = quarter * 16 + role * 4 + (lane >> 4), cgp = (lane & 15) * 4;
    f32x2 s01 = {0.f, 0.f}, s23 = {0.f, 0.f};
    if (helper) {
        for (int c0 = 0; c0 < NCH; c0 += 4) {
#define RW_HELP(u, PNEXT, PCUR) { const int c = c0 + (u); if (c + 1 < NCH) commit((c + 1) & 1, PNEXT); if (c + 4 < NCH) issue(c + 4, PCUR); if (c > 0) reduce_store(c - 1); RAW_BAR; }
            RW_HELP(0, pr1, pr0) RW_HELP(1, pr2, pr1) RW_HELP(2, pr3, pr2) RW_HELP(3, pr0, pr3)
#undef RW_HELP
        }
    } else for (int chunk = 0; chunk < NCH; ++chunk) {
        {
            const float* bb = stg + (chunk & 1) * BUF;
            float* pw = part + (chunk & 1) * (CH * 256) + role * 64 + lane;
            f32x4 A1, A2, R1, WW, BW, KW, B2, K2, R2, SC; f32x2 VV;
            f32x4 A1n, A2n, R1n, WWn, BWn, KWn, B2n, K2n, R2n, SCn; f32x2 VVn;
            {
                const float* vp = bb + cgp;
                A1n = *(const f32x4*)(vp); A2n = *(const f32x4*)(vp + 64); R1n = *(const f32x4*)(vp + 128); WWn = *(const f32x4*)(vp + 192); BWn = *(const f32x4*)(vp + 256);
                KWn = *(const f32x4*)(vp + 320); B2n = *(const f32x4*)(vp + 384); K2n = *(const f32x4*)(vp + 448); R2n = *(const f32x4*)(vp + 512);
                SCn = *(const f32x4*)(bb + VEC); VVn = *(const f32x2*)(bb + VEC + SCL + row * 2);
            }
#pragma unroll
            for (int rd = 0; rd < NR; ++rd) {
                A1 = A1n; A2 = A2n; R1 = R1n; WW = WWn; BW = BWn; KW = KWn; B2 = B2n; K2 = K2n; R2 = R2n; SC = SCn; VV = VVn;
                const bool pf = (rd + 1 < NR);
                const float* vp = bb + (rd + 1) * (9 * 64) + cgp;
                const float v1 = VV[0], v2 = VV[1];
                const f32x2 p1 = s01 * (f32x2){A1[0], A1[1]} + s23 * (f32x2){A1[2], A1[3]};
                const f32x2 p2 = s01 * (f32x2){A2[0], A2[1]} + s23 * (f32x2){A2[2], A2[3]};
                const f32x2 p3 = s01 * (f32x2){R1[0], R1[1]} + s23 * (f32x2){R1[2], R1[3]};
                float sa1 = p1[0] + p1[1], u2 = p2[0] + p2[1];
                SBM;
                if (pf) { A1n = *(const f32x4*)(vp); A2n = *(const f32x4*)(vp + 64); }
                SBM;
                sa1 += dpp_f<0xB1>(sa1); u2 += dpp_f<0xB1>(u2);
                SBM;
                if (pf) { R1n = *(const f32x4*)(vp + 128); WWn = *(const f32x4*)(vp + 192); }
                f32x2 t01 = s01 * (f32x2){WW[0], WW[1]} + v1 * (f32x2){KW[0], KW[1]};
                SBM;
                sa1 += dpp_f<0x4E>(sa1); u2 += dpp_f<0x4E>(u2);
                SBM;
                if (pf) { BWn = *(const f32x4*)(vp + 256); KWn = *(const f32x4*)(vp + 320); }
                f32x2 t23 = s23 * (f32x2){WW[2], WW[3]} + v1 * (f32x2){KW[2], KW[3]};
                SBM;
                sa1 += dpp_f<0x141>(sa1); u2 += dpp_f<0x141>(u2);
                SBM;
                if (pf) { B2n = *(const f32x4*)(vp + 384); K2n = *(const f32x4*)(vp + 448); }
                t01 += v2 * (f32x2){K2[0], K2[1]}; t23 += v2 * (f32x2){K2[2], K2[3]};
                SBM;
                sa1 += dpp_f<0x140>(sa1); u2 += dpp_f<0x140>(u2);
                SBM;
                if (pf) { R2n = *(const f32x4*)(vp + 512); SCn = *(const f32x4*)(bb + VEC + (rd + 1) * 4); VVn = *(const f32x2*)(bb + VEC + SCL + ((rd + 1) * 64 + row) * 2); }
                const float sa2 = __builtin_fmaf(sa1, SC[0], __builtin_fmaf(v1, SC[1], u2));
                t01 += sa1 * (f32x2){BW[0], BW[1]}; t23 += sa1 * (f32x2){BW[2], BW[3]};
                pw[(2 * rd) * 256] = __builtin_fmaf(sa1, SC[2], __builtin_fmaf(v1, SC[3], p3[0] + p3[1]));
                s01 = t01 + sa2 * (f32x2){B2[0], B2[1]}; s23 = t23 + sa2 * (f32x2){B2[2], B2[3]};
                const f32x2 p4 = s01 * (f32x2){R2[0], R2[1]} + s23 * (f32x2){R2[2], R2[3]};
                pw[(2 * rd + 1) * 256] = p4[0] + p4[1];
            }
        }
        RAW_BAR;
    }
    if (helper) reduce_store(NCH - 1);
    __threadfence();
    __syncthreads();
}
#undef SBM
#undef RAW_BAR

DEVI void rwkv_post(const Params& p, int l, int bid, int nb) {
    int tid_ = threadIdx.x; asm volatile("" : "+v"(tid_)); size_t wz_ = 0; asm volatile("" : "+s"(wz_)); unsigned char* ws_ = p.ws + wz_;
    const int wid = tid_ >> 6, lane = tid_ & 63, c = wid * 64 + lane;
    const bf16_t* R = (const bf16_t*)(ws_ + OFF_RWR); const bf16_t* Kb = (const bf16_t*)(ws_ + OFF_RWK); const bf16_t* Vb = (const bf16_t*)(ws_ + OFF_RWV);
    const bf16_t* Gb = (const bf16_t*)(ws_ + OFF_RWG); const float* Y = (const float*)(ws_ + OFF_RWY);
    bf16_t* O = (bf16_t*)(ws_ + OFF_ORWKV);
    const float rk = ((const float*)p.in[18])[l * 512 + c], lw = ((const float*)p.in[19])[l * 512 + c], lb = ((const float*)p.in[20])[l * 512 + c];
    for (int tok = bid; tok < S; tok += nb) {
        const size_t o = (size_t)tok * 512 + c;
        const float y = Y[o], r = bf2f(R[o]), k = bf2f(Kb[o]), v = bf2f(Vb[o]), g = bf2f(Gb[o]);
        const float mean = wave_sum(y) * (1.0f / 64.0f);
        const float dv = y - mean;
        const float var = wave_sum(dv * dv) * (1.0f / 64.0f);
        const float yn = dv * rsqrtf(var + 64e-5f) * lw + lb;
        const float bonus = wave_sum(r * k * rk) * v;
        O[o] = f2bf((yn + bonus) * g);
    }
}

template <int NQ>
DEVI void attn_compute(const bf16x8 (&kf0)[4], const bf16x8 (&kf1)[4], const bf16x8 (&vf)[8],
                       const bf16x8 (&qf)[NQ][4], const unsigned (&vmask)[NQ], f32x4 (&o)[NQ][8], float (&m)[NQ], float (&l)[NQ]) {
#pragma unroll
    for (int q = 0; q < NQ; ++q) {
        f32x4 s0 = {0.f, 0.f, 0.f, 0.f}, s1 = {0.f, 0.f, 0.f, 0.f};
#pragma unroll
        for (int ks = 0; ks < 4; ++ks) {
            s0 = __builtin_amdgcn_mfma_f32_16x16x32_bf16(kf0[ks], qf[q][ks], s0, 0, 0, 0);
            s1 = __builtin_amdgcn_mfma_f32_16x16x32_bf16(kf1[ks], qf[q][ks], s1, 0, 0, 0);
        }
        float sv[8];
#pragma unroll
        for (int j = 0; j < 4; ++j) { sv[j] = ((vmask[q] >> j) & 1u) ? s0[j] : -1e30f; sv[4 + j] = ((vmask[q] >> (4 + j)) & 1u) ? s1[j] : -1e30f; }
        float cm = sv[0];
#pragma unroll
        for (int j = 1; j < 8; ++j) cm = fmaxf(cm, sv[j]);
        cm = fmaxf(cm, __shfl_xor(cm, 16)); cm = fmaxf(cm, __shfl_xor(cm, 32));
        const float mn = fmaxf(m[q], cm);
        const bool grow = (NQ == 1) ? true : (__ballot(mn > m[q]) != 0ull);
        if (grow) {
            const float alpha = __expf(m[q] - mn);
            l[q] *= alpha;
#pragma unroll
            for (int dt = 0; dt < 8; ++dt) o[q][dt] *= alpha;
            m[q] = mn;
        }
        float pr[8]; float ps = 0.f;
#pragma unroll
        for (int j = 0; j < 8; ++j) { pr[j] = __expf(sv[j] - mn); ps += pr[j]; }
        l[q] += ps;
        union { u32x4 u; bf16x8 h; } pb;
        pb.u.x = cvt_pk_bf16(pr[0], pr[1]); pb.u.y = cvt_pk_bf16(pr[2], pr[3]); pb.u.z = cvt_pk_bf16(pr[4], pr[5]); pb.u.w = cvt_pk_bf16(pr[6], pr[7]);
#pragma unroll
        for (int dt = 0; dt < 8; ++dt) o[q][dt] = __builtin_amdgcn_mfma_f32_16x16x32_bf16(vf[dt], pb.h, o[q][dt], 0, 0, 0);
    }
}
template <int NQ>
DEVI void attn_chunk(const bf16_t* k0p, const bf16_t* k1p, const bf16_t* vtp, size_t vt_stride16,
                     const bf16x8 (&qf)[NQ][4], const unsigned (&vmask)[NQ], f32x4 (&o)[NQ][8], float (&m)[NQ], float (&l)[NQ]) {
    bf16x8 kf0[4], kf1[4], vf[8];
#pragma unroll
    for (int ks = 0; ks < 4; ++ks) { kf0[ks] = *(const bf16x8*)(k0p + ks * 32); kf1[ks] = *(const bf16x8*)(k1p + ks * 32); }
#pragma unroll
    for (int dt = 0; dt < 8; ++dt) vf[dt] = *(const bf16x8*)(vtp + (size_t)dt * vt_stride16);
    attn_compute<NQ>(kf0, kf1, vf, qf, vmask, o, m, l);
}

DEVI void vtrans_tile(const Params& p, unsigned char* smem, int a, int ptile) {
    int tid_ = threadIdx.x; asm volatile("" : "+v"(tid_)); size_t wz_ = 0; asm volatile("" : "+s"(wz_)); unsigned char* ws_ = p.ws + wz_;
    const int dil = a < 2 ? 1 : (a < 4 ? 4 : (a < 6 ? 16 : 1));
    const int arr = a < 6 ? 12 + a : 26 + (a - 6);
    const bf16_t* V = (const bf16_t*)(ws_ + OFF_P2) + (size_t)arr * ((size_t)S * 128);
    bf16_t* VT = (bf16_t*)(ws_ + OFF_VT) + (size_t)a * ((size_t)S * 128);
    bf16_t* sT = (bf16_t*)smem;
    const int tid = tid_, p0 = ptile * 64, per = S / dil;
    {
        const int r = tid >> 3, seg = (tid & 7) * 16;
        const int pos = p0 + r, rho = pos / per, mm = pos % per, tok = mm * dil + rho;
        const u32x4 w0 = *(const u32x4*)(V + (size_t)tok * 128 + seg), w1 = *(const u32x4*)(V + (size_t)tok * 128 + seg + 8);
        unsigned* d = (unsigned*)(sT + r * 130 + seg);
        d[0] = w0.x; d[1] = w0.y; d[2] = w0.z; d[3] = w0.w; d[4] = w1.x; d[5] = w1.y; d[6] = w1.z; d[7] = w1.w;
    }
    __syncthreads();
    {
        const int dim = tid >> 2, part = (tid & 3) * 16;
        unsigned w[8];
#pragma unroll
        for (int i = 0; i < 8; ++i) w[i] = (unsigned)sT[(part + 2 * i) * 130 + dim] | ((unsigned)sT[(part + 2 * i + 1) * 130 + dim] << 16);
        u32x4 o0 = {w[0], w[1], w[2], w[3]}, o1 = {w[4], w[5], w[6], w[7]};
        bf16_t* dp = VT + (size_t)dim * S + p0 + part;
        *(u32x4*)dp = o0; *(u32x4*)(dp + 8) = o1;
    }
    __syncthreads();
}

DEVI void moba_kmean(const Params& p, unsigned char* smem, int item) {
    int tid_ = threadIdx.x; asm volatile("" : "+v"(tid_)); size_t wz_ = 0; asm volatile("" : "+s"(wz_)); unsigned char* ws_ = p.ws + wz_;
    const int head = item >> 6, nbk = item & 63, tid = tid_, d = tid & 127, tq = tid >> 7;
    const bf16_t* K = (const bf16_t*)(ws_ + OFF_P2) + (size_t)(22 + head) * ((size_t)S * 128);
    float* red = (float*)smem;
    float a = 0.f;
    for (int i = 0; i < 64; ++i) a += bf2f(K[(size_t)(nbk * 256 + tq * 64 + i) * 128 + d]);
    red[tq * 128 + d] = a;
    __syncthreads();
    if (tid < 128) ((float*)(ws_ + OFF_KM))[(size_t)item * 128 + tid] = (red[tid] + red[128 + tid] + red[256 + tid] + red[384 + tid]) * (1.0f / 256.0f);
    __syncthreads();
}

#define TOP3_INSERT(v, i, v1, v2, v3, i1, i2, i3) do { const float _v = (v); const int _i = (i); \
    const bool _g1 = _v > v1, _g2 = _v > v2, _g3 = _v > v3; \
    const float _n3 = _g2 ? v2 : (_g3 ? _v : v3); const int _m3 = _g2 ? i2 : (_g3 ? _i : i3); \
    const float _n2 = _g1 ? v1 : (_g2 ? _v : v2); const int _m2 = _g1 ? i1 : (_g2 ? _i : i2); \
    const float _n1 = _g1 ? _v : v1; const int _m1 = _g1 ? _i : i1; \
    v1 = _n1; v2 = _n2; v3 = _n3; i1 = _m1; i2 = _m2; i3 = _m3; } while (0)

DEVI void moba_gate(const Params& p, unsigned char* smem, int item) {
    int tid_ = threadIdx.x; asm volatile("" : "+v"(tid_)); size_t wz_ = 0; asm volatile("" : "+s"(wz_)); unsigned char* ws_ = p.ws + wz_;
    const int head = item >> 6, qb = item & 63, cur = qb, tid = tid_;
    unsigned long long* sel = (unsigned long long*)(ws_ + OFF_SEL) + (size_t)head * S + qb * 256;
    unsigned* sQ = (unsigned*)smem;
    float* sKm = (float*)(smem + 256 * 65 * 4);
    const bf16_t* Q = (const bf16_t*)(ws_ + OFF_P2) + (size_t)(18 + head) * ((size_t)S * 128) + (size_t)qb * 256 * 128;
    for (int e = tid; e < 256 * 64; e += NT) sQ[(e >> 6) * 65 + (e & 63)] = ((const unsigned*)Q)[e];
    const float* KM = (const float*)(ws_ + OFF_KM) + (size_t)head * 64 * 128;
    for (int e = tid; e < cur * 128; e += NT) sKm[e] = KM[e];
    __syncthreads();
    const int q = tid >> 1, part = tid & 1;
    float v1 = -INFINITY, v2 = -INFINITY, v3 = -INFINITY; int i1 = -1, i2 = -1, i3 = -1;
    for (int n = part; n < cur; n += 2) {
        float dot = 0.f;
#pragma unroll 4
        for (int w = 0; w < 64; ++w) {
            const unsigned qq = sQ[q * 65 + w];
            dot += __uint_as_float(qq << 16) * sKm[n * 128 + 2 * w] + __uint_as_float(qq & 0xFFFF0000u) * sKm[n * 128 + 2 * w + 1];
        }
        TOP3_INSERT(dot, n, v1, v2, v3, i1, i2, i3);
    }
    const float pv1 = __shfl_xor(v1, 1), pv2 = __shfl_xor(v2, 1), pv3 = __shfl_xor(v3, 1);
    const int pi1 = __shfl_xor(i1, 1), pi2 = __shfl_xor(i2, 1), pi3 = __shfl_xor(i3, 1);
    TOP3_INSERT(pv1, pi1, v1, v2, v3, i1, i2, i3);
    TOP3_INSERT(pv2, pi2, v1, v2, v3, i1, i2, i3);
    TOP3_INSERT(pv3, pi3, v1, v2, v3, i1, i2, i3);
    unsigned long long mk = 0ull;
    if (i1 >= 0) mk |= 1ull << i1;
    if (i2 >= 0) mk |= 1ull << i2;
    if (i3 >= 0) mk |= 1ull << i3;
    if (part == 0) sel[q] = mk;
    __syncthreads();
}

constexpr int MB_KROW = 272, MB_VROW = 144, MB_KBYTES = 64 * MB_KROW, MB_BUF = MB_KBYTES + 128 * MB_VROW;
DEVI void moba_attn(const Params& p, unsigned char* smem, int item) {
    int tid_ = threadIdx.x; asm volatile("" : "+v"(tid_)); size_t wz_ = 0; asm volatile("" : "+s"(wz_)); unsigned char* ws_ = p.ws + wz_;
    const int head = item & 3, qb = 63 - (item >> 2);
    const int tid = tid_, wid = tid >> 6, lane = tid & 63, li = lane & 15, g = lane >> 4;
    LAS unsigned char* lds = (LAS unsigned char*)smem;
    const bf16_t* Q = (const bf16_t*)(ws_ + OFF_P2) + (size_t)(18 + head) * ((size_t)S * 128);
    const bf16_t* K = (const bf16_t*)(ws_ + OFF_P2) + (size_t)(22 + head) * ((size_t)S * 128);
    const bf16_t* VT = (const bf16_t*)(ws_ + OFF_VT) + (size_t)(6 + head) * ((size_t)S * 128);
    const unsigned long long* sel = (const unsigned long long*)(ws_ + OFF_SEL) + (size_t)head * S;
    const int qbase = qb * 256 + wid * 32;
    bf16x8 qf[2][4]; f32x4 o[2][8]; float m[2], l[2];
    LAS unsigned long long* sSm = (LAS unsigned long long*)(lds + 2 * MB_BUF) + (wid * 64 + lane) * 2;
#pragma unroll
    for (int qt = 0; qt < 2; ++qt) {
        const int qi = qbase + qt * 16 + li;
#pragma unroll
        for (int ks = 0; ks < 4; ++ks) qf[qt][ks] = *(const bf16x8*)(Q + (size_t)qi * 128 + ks * 32 + g * 8);
        sSm[qt] = sel[qi]; m[qt] = -1e30f; l[qt] = 0.f;
#pragma unroll
        for (int dt = 0; dt < 8; ++dt) o[qt][dt] = (f32x4){0.f, 0.f, 0.f, 0.f};
    }
    const int krow_s = tid >> 3, kseg = (tid & 7) * 16;
    const int vdim_s = tid >> 2, vpart = (tid & 3) * 16;
    u32x4 rk0, rk1, rv0, rv1;
    auto issue = [&](int st) {
        const bf16_t* kp = K + (size_t)(st * 64 + krow_s) * 128 + kseg;
        rk0 = *(const u32x4*)kp; rk1 = *(const u32x4*)(kp + 8);
        const bf16_t* vp = VT + (size_t)vdim_s * S + st * 64 + vpart;
        rv0 = *(const u32x4*)vp; rv1 = *(const u32x4*)(vp + 8);
    };
    auto commit = [&](int bi) {
        LAS unsigned char* kb = lds + bi * MB_BUF + krow_s * MB_KROW + kseg * 2;
        *(LAS u32x4*)kb = rk0; *(LAS u32x4*)(kb + 16) = rk1;
        LAS unsigned char* vb = lds + bi * MB_BUF + MB_KBYTES + vdim_s * MB_VROW + vpart * 2;
        *(LAS u32x4*)vb = rv0; *(LAS u32x4*)(vb + 16) = rv1;
    };
    const int nst = (qb + 1) * 4;
    issue(0); commit(0);
    __syncthreads();
    const int krow = 8 * (li >> 2) + (li & 3);
    for (int st = 0; st < nst; ++st) {
        if (st + 1 < nst) issue(st + 1);
        const int n = st >> 2;
        LAS unsigned char* kb = lds + (st & 1) * MB_BUF;
        LAS unsigned char* vb = kb + MB_KBYTES;
#pragma unroll
        for (int c = 0; c < 2; ++c) {
            const int c0 = st * 64 + c * 32;
            unsigned vm[2];
            if (n < qb) { vm[0] = ((sSm[0] >> n) & 1ull) ? 0xFFu : 0u; vm[1] = ((sSm[1] >> n) & 1ull) ? 0xFFu : 0u; }
            else {
#pragma unroll
                for (int qt = 0; qt < 2; ++qt) {
                    const int qpos = qbase + qt * 16 + li; unsigned mk = 0u;
#pragma unroll
                    for (int j = 0; j < 8; ++j) { const int key = c0 + 8 * g + (j & 3) + 4 * (j >> 2); mk |= (key <= qpos) ? (1u << j) : 0u; }
                    vm[qt] = mk;
                }
            }
            if (__ballot((vm[0] | vm[1]) != 0u) != 0ull) {
                bf16x8 kf0[4], kf1[4], vf[8];
#pragma unroll
                for (int ks = 0; ks < 4; ++ks) {
                    kf0[ks] = *(const LAS bf16x8*)(kb + (c * 32 + krow) * MB_KROW + (ks * 32 + g * 8) * 2);
                    kf1[ks] = *(const LAS bf16x8*)(kb + (c * 32 + krow + 4) * MB_KROW + (ks * 32 + g * 8) * 2);
                }
#pragma unroll
                for (int dt = 0; dt < 8; ++dt) vf[dt] = *(const LAS bf16x8*)(vb + (16 * dt + li) * MB_VROW + (c * 32 + 8 * g) * 2);
                attn_compute<2>(kf0, kf1, vf, qf, vm, o, m, l);
            }
        }
        if (st + 1 < nst) commit((st + 1) & 1);
        __syncthreads();
    }
    bf16_t* O = (bf16_t*)(ws_ + OFF_OMOBA);
#pragma unroll
    for (int qt = 0; qt < 2; ++qt) {
        float lt = l[qt]; lt += __shfl_xor(lt, 16); lt += __shfl_xor(lt, 32);
        const float inv = 1.0f / lt;
        const int qi = qbase + qt * 16 + li;
#pragma unroll
        for (int dt = 0; dt < 8; ++dt) {
            const f32x4 v = o[qt][dt] * inv;
            u32x2 w; w.x = cvt_pk_bf16(v[0], v[1]); w.y = cvt_pk_bf16(v[2], v[3]);
            *(u32x2*)(O + (size_t)qi * 512 + head * 128 + dt * 16 + 4 * g) = w;
        }
    }
}

DEVI void dil_attn(const Params& p, int item) {
    int tid_ = threadIdx.x; asm volatile("" : "+v"(tid_)); size_t wz_ = 0; asm volatile("" : "+s"(wz_)); unsigned char* ws_ = p.ws + wz_;
    const int hp = item & 1, T0 = (item >> 1) * 256;
    const int tid = tid_, wid = tid >> 6, lane = tid & 63, li = lane & 15, g = lane >> 4;
    const int krow = 8 * (li >> 2) + (li & 3);
    bf16_t* O = (bf16_t*)(ws_ + OFF_ODIL);
    for (int rr = 0; rr < 2; ++rr) {
        const int rho16 = 2 * wid + rr;
        const int tq = T0 + rho16 + 16 * li;
        f32x4 o[1][8]; float m[1], l[1];
        m[0] = -1e30f; l[0] = 0.f;
#pragma unroll
        for (int dt = 0; dt < 8; ++dt) o[0][dt] = (f32x4){0.f, 0.f, 0.f, 0.f};
        for (int gi = 0; gi < 3; ++gi) {
            const int dil = gi == 0 ? 1 : (gi == 1 ? 4 : 16);
            const int head = 2 * gi + hp, per = S / dil;
            const bf16_t* Q = (const bf16_t*)(ws_ + OFF_P2) + (size_t)(head) * ((size_t)S * 128);
            const bf16_t* K = (const bf16_t*)(ws_ + OFF_P2) + (size_t)(6 + head) * ((size_t)S * 128);
            const bf16_t* VT = (const bf16_t*)(ws_ + OFF_VT) + (size_t)head * ((size_t)S * 128);
            bf16x8 qf[1][4];
#pragma unroll
            for (int ks = 0; ks < 4; ++ks) qf[0][ks] = *(const bf16x8*)(Q + (size_t)tq * 128 + ks * 32 + g * 8);
            const int rho = rho16 % dil;
            const int qm = tq / dil;
            const int qm0 = (T0 + rho16) / dil, qm15 = (T0 + rho16 + 240) / dil;
            const int lo = qm0 - 128;
            int c0 = (lo >> 5) << 5;
            if (c0 < 0) c0 = (c0 < -32) ? 0 : c0;
            if (lo < 0 && c0 < 0 && c0 + 31 < 0) c0 = 0;
            for (; c0 <= qm15; c0 += 32) {
                unsigned vm[1]; unsigned mk = 0u;
#pragma unroll
                for (int j = 0; j < 8; ++j) { const int kap = c0 + 8 * g + (j & 3) + 4 * (j >> 2); mk |= (kap >= 0 && kap <= qm && qm - kap <= 128) ? (1u << j) : 0u; }
                vm[0] = mk;
                int ka0 = c0 + krow, ka1 = ka0 + 4;
                ka0 = ka0 < 0 ? 0 : (ka0 > per - 1 ? per - 1 : ka0); ka1 = ka1 < 0 ? 0 : (ka1 > per - 1 ? per - 1 : ka1);
                int sg = c0 + 8 * g; sg = sg < 0 ? 0 : (sg > per - 8 ? per - 8 : sg);
                const bf16_t* k0p = K + (size_t)(ka0 * dil + rho) * 128 + g * 8;
                const bf16_t* k1p = K + (size_t)(ka1 * dil + rho) * 128 + g * 8;
                attn_chunk<1>(k0p, k1p, VT + (size_t)li * S + (size_t)rho * per + sg, (size_t)16 * S, qf, vm, o, m, l);
            }
        }
        float lt = l[0]; lt += __shfl_xor(lt, 16); lt += __shfl_xor(lt, 32);
        const float inv = 1.0f / lt;
#pragma unroll
        for (int dt = 0; dt < 8; ++dt) {
            const f32x4 v = o[0][dt] * inv;
            u32x2 w; w.x = cvt_pk_bf16(v[0], v[1]); w.y = cvt_pk_bf16(v[2], v[3]);
            *(u32x2*)(O + (size_t)tq * 256 + hp * 128 + dt * 16 + 4 * g) = w;
        }
    }
}

DEVI void sub_barrier(unsigned* ctr, unsigned target) {
    __threadfence();
    __syncthreads();
    if (threadIdx.x == 0) {
        __threadfence();
        __hip_atomic_fetch_add(ctr, 1u, __ATOMIC_RELEASE, __HIP_MEMORY_SCOPE_AGENT);
        while (__hip_atomic_load(ctr, __ATOMIC_ACQUIRE, __HIP_MEMORY_SCOPE_AGENT) < target) __builtin_amdgcn_s_sleep(8);
        __threadfence();
    }
    __syncthreads();
}
#ifndef PHASE_MASK
#define PHASE_MASK 0xFFFFFFFFu
#endif
#define PH(k) ((PHASE_MASK >> (k)) & 1u)
#ifndef PROBE_MASK
#define PROBE_MASK 0u
#endif
#define REPS(k) (1 + (int)((PROBE_MASK >> (k)) & 1u))
__global__ void __launch_bounds__(512, 2) fwd_megakernel(Params p) {
    extern __shared__ __attribute__((aligned(16))) unsigned char smem[];
    cg::grid_group grid = cg::this_grid();
    const int bid = blockIdx.x, nb = gridDim.x;
    unsigned char* ws = p.ws;
    const float* mod = (const float*)(ws + OFF_MOD);

    if (bid == 0 && threadIdx.x < 4) ((unsigned*)(ws + OFF_BAR))[threadIdx.x * 64] = 0u;
    if (PH(0)) phase_mod_rope(p, smem, bid, nb);
    __syncthreads();
    for (int rep = 0; rep < REPS(5); ++rep) if (PH(1)) phase_convert(p, 0, smem, bid, nb);
    grid.sync();

    for (int l = 0; l < NL; ++l) {
        size_t wzl = 0; asm volatile("" : "+s"(wzl)); unsigned char* const ws = p.ws + wzl;
        const float* mod = (const float*)(ws + OFF_MOD);
        const float* ml = mod + l * 12288;
        const float* xin = (l == 0) ? (const float*)p.in[0] : p.out;
        for (int rep = 0; rep < REPS(4); ++rep) if (PH(2)) phase_norm(xin, (const float*)p.in[5] + l * D, ml, ml + 2048, (bf16_t*)(ws + OFF_H), bid, nb);
        for (int rep = 0; rep < REPS(5); ++rep) if (PH(1) && l > 0) phase_convert(p, l, smem, bid, nb);
        grid.sync();
        {
            EpiInProj E; E.G = (bf16_t*)(ws + OFF_G); E.P1G = (bf16_t*)(ws + OFF_P1G); E.P1R = (bf16_t*)(ws + OFF_P1R); E.P2 = (bf16_t*)(ws + OFF_P2);
            E.cosT = (const float*)(ws + OFF_COS); E.sinT = (const float*)(ws + OFF_SIN);
            for (int rep = 0; rep < REPS(0); ++rep) if (PH(3)) run_gemm(smem, (const bf16_t*)(ws + OFF_H), (const bf16_t*)(ws + OFF_WIN), IN_PAD, D, E);
        }
        grid.sync();
        for (int it = bid; it < 1024; it += nb) rwkv_prep(p, l, smem, it);
        grid.sync();
        if (bid < 32) rwkv_scan(p, smem, bid);
        else {
            const int b2 = bid - 32, nb2 = nb - 32;
            unsigned* ctr = (unsigned*)(ws + OFF_BAR) + l * 128;
            for (int it = b2; it < 1024 + 256 + 2560; it += nb2) {
                if (it < 1024) gla_pass1(p, l, smem, it);
                else if (it < 1280) moba_kmean(p, smem, it - 1024);
                else { const int j = it - 1280; vtrans_tile(p, smem, j >> 8, j & 255); }
            }
            sub_barrier(ctr, (unsigned)nb2);
            for (int it = b2; it < 64 + 256; it += nb2) {
                if (it < 64) gla_pass2(p, it);
                else moba_gate(p, smem, it - 64);
            }
            sub_barrier(ctr + 64, (unsigned)nb2);
            for (int it = b2; it < 256 + 128 + 1024; it += nb2) {
                if (it < 256) moba_attn(p, smem, it);
                else if (it < 384) dil_attn(p, it - 256);
                else gla_pass3(p, l, smem, it - 384);
            }
        }
        grid.sync();
        if (PH(14)) rwkv_post(p, l, bid, nb);
        grid.sync();
        {
            EpiBranch E; E.Mg = (bf16_t*)(ws + OFF_MERGED);
            E.Gb = (const bf16_t*)(ws + OFF_G); E.first = 1;
            if (PH(15)) run_gemm(smem, (const bf16_t*)(ws + OFF_OGLA), (const bf16_t*)(ws + OFF_WBA), D, 512, E);
            E.Gb = (const bf16_t*)(ws + OFF_G) + 2048; E.first = 0;
            if (PH(15)) run_gemm(smem, (const bf16_t*)(ws + OFF_ODIL), (const bf16_t*)(ws + OFF_WBB), D, 256, E);
            E.Gb = (const bf16_t*)(ws + OFF_G) + 4096;
            if (PH(15)) run_gemm(smem, (const bf16_t*)(ws + OFF_ORWKV), (const bf16_t*)(ws + OFF_WBC), D, 512, E);
            E.Gb = (const bf16_t*)(ws + OFF_G) + 6144;
            if (PH(15)) run_gemm(smem, (const bf16_t*)(ws + OFF_OMOBA), (const bf16_t*)(ws + OFF_WBD), D, 512, E);
        }
        grid.sync();
        {
            EpiResid E; E.src = xin; E.dst = p.out; E.gate = ml + 4096;
            if (PH(16)) run_gemm(smem, (const bf16_t*)(ws + OFF_MERGED), (const bf16_t*)(ws + OFF_WOUT), D, D, E);
        }
        grid.sync();
        for (int rep = 0; rep < REPS(4); ++rep) if (PH(2)) phase_norm(p.out, (const float*)p.in[29] + l * D, ml + 6144, ml + 8192, (bf16_t*)(ws + OFF_H), bid, nb);
        grid.sync();
        {
            EpiSwiglu E; E.act = (bf16_t*)(ws + OFF_ACT);
            for (int rep = 0; rep < REPS(1); ++rep) if (PH(17)) run_gemm(smem, (const bf16_t*)(ws + OFF_H), (const bf16_t*)(ws + OFF_WF1), 2 * FFN_H, D, E);
        }
        grid.sync();
        {
            EpiResid E; E.src = p.out; E.dst = p.out; E.gate = ml + 10240;
            if (PH(16)) run_gemm(smem, (const bf16_t*)(ws + OFF_ACT), (const bf16_t*)(ws + OFF_WF2), D, FFN_H, E);
        }
        grid.sync();
    }
    if (PH(18)) phase_final_norm(p.out, (const float*)p.in[32], bid, nb);
}

extern "C" void kernel_launch(void* const* d_in, const int* in_sizes, int n_in, void* d_out, int out_size, void* d_ws, size_t ws_size, hipStream_t stream) {
    static int grid_blocks = 0;
    if (grid_blocks == 0) {
        if (n_in != 33 || ws_size < WS_END) { fprintf(stderr, "kernel_launch: unexpected n_in %d or ws_size %zu (< %zu)\n", n_in, ws_size, (size_t)WS_END); grid_blocks = -1; return; }
        int dev = 0, cus = 0, per_cu = 0;
        hipGetDevice(&dev);
        hipDeviceGetAttribute(&cus, hipDeviceAttributeMultiprocessorCount, dev);
        if (hipFuncSetAttribute((const void*)fwd_megakernel, hipFuncAttributeMaxDynamicSharedMemorySize, LDS_BYTES) != hipSuccess) { fprintf(stderr, "kernel_launch: hipFuncSetAttribute failed\n"); grid_blocks = -1; return; }
        hipOccupancyMaxActiveBlocksPerMultiprocessor(&per_cu, (const void*)fwd_megakernel, NT, LDS_BYTES);
        if (per_cu < 1) { fprintf(stderr, "kernel_launch: occupancy query says 0 blocks per CU\n"); per_cu = 1; }
        grid_blocks = cus * 1;
        (void)hipGetLastError();
    }
    if (grid_blocks < 0) return;
    Params p{};
    for (int i = 0; i < 33; ++i) p.in[i] = d_in[i];
    p.out = (float*)d_out; p.ws = (unsigned char*)d_ws;
    void* args[] = {&p};
    hipError_t e = hipLaunchCooperativeKernel((const void*)fwd_megakernel, dim3(grid_blocks), dim3(NT), args, LDS_BYTES, stream);
    if (e != hipSuccess) fprintf(stderr, "cooperative launch failed: %s (grid %d)\n", hipGetErrorString(e), grid_blocks);
}
```

```cpp
#include <hip/hip_runtime.h>
#include <hip/hip_cooperative_groups.h>
#include <cstdio>
#include <cstdint>
namespace cg = cooperative_groups;

typedef unsigned short bf16_t;
typedef short bf16x8 __attribute__((ext_vector_type(8)));
typedef float f32x4 __attribute__((ext_vector_type(4)));
typedef float f32x2 __attribute__((ext_vector_type(2)));
typedef unsigned u32x4 __attribute__((ext_vector_type(4)));
typedef unsigned u32x2 __attribute__((ext_vector_type(2)));
#define LAS __attribute__((address_space(3)))
#define DEVI __device__ __forceinline__

constexpr int S = 16384, D = 2048, NL = 2;
constexpr int IN_TOTAL = 15568, IN_PAD = 15872;
constexpr int FFN_H = 5632;
constexpr int NT = 512;
constexpr int LDS_BYTES = 131072;

constexpr size_t SZ_HEADARR = (size_t)S * 128 * 2;
constexpr size_t OFF_WIN = 0;
constexpr size_t OFF_WBA = OFF_WIN + (size_t)IN_PAD * D * 2;
constexpr size_t OFF_WBB = OFF_WBA + (size_t)D * 512 * 2;
constexpr size_t OFF_WBC = OFF_WBB + (size_t)D * 256 * 2;
constexpr size_t OFF_WBD = OFF_WBC + (size_t)D * 512 * 2;
constexpr size_t OFF_WOUT = OFF_WBD + (size_t)D * 512 * 2;
constexpr size_t OFF_WF1 = OFF_WOUT + (size_t)D * D * 2;
constexpr size_t OFF_WF2 = OFF_WF1 + (size_t)2 * FFN_H * D * 2;
constexpr size_t WB_END = OFF_WF2 + (size_t)D * FFN_H * 2;
constexpr size_t OFF_VT = OFF_WIN;
constexpr size_t OFF_G = WB_END;
constexpr size_t OFF_P1G = OFF_G + (size_t)S * 8192 * 2;
constexpr size_t OFF_P1R = OFF_P1G + (size_t)S * 1792 * 2;
constexpr size_t OFF_P2 = OFF_P1R + (size_t)S * 2048 * 2;
constexpr size_t OFF_ACT = OFF_P1G;
constexpr size_t OFF_H = OFF_P2 + 30 * SZ_HEADARR;
constexpr size_t OFF_OGLA = OFF_H;
constexpr size_t OFF_ODIL = OFF_OGLA + (size_t)S * 512 * 2;
constexpr size_t OFF_ORWKV = OFF_ODIL + (size_t)S * 256 * 2;
constexpr size_t OFF_OMOBA = OFF_ORWKV + (size_t)S * 512 * 2;
constexpr size_t OFF_X = OFF_H + (size_t)S * D * 2;
constexpr size_t SZ_B512 = (size_t)S * 512 * 2;
constexpr size_t OFF_RWR = OFF_X;
constexpr size_t OFF_RWK = OFF_RWR + SZ_B512;
constexpr size_t OFF_RWV = OFF_RWK + SZ_B512;
constexpr size_t OFF_RWA = OFF_RWV + SZ_B512;
constexpr size_t OFF_RWB = OFF_RWA + SZ_B512;
constexpr size_t OFF_RWG = OFF_RWB + SZ_B512;
constexpr size_t OFF_RWW = OFF_RWG + SZ_B512;
constexpr size_t OFF_RWY = OFF_RWW + (size_t)S * 512 * 4;
constexpr size_t OFF_GLL = OFF_RWY + (size_t)S * 512 * 4;
constexpr size_t OFF_GLB = OFF_GLL + (size_t)256 * 4 * 64 * 128 * 4;
constexpr size_t OFF_GLD = OFF_GLB + (size_t)S * 256 * 4;
constexpr size_t OFF_MERGED = OFF_X;
constexpr size_t OFF_VF = OFF_GLD + (size_t)256 * 4 * 64 * 4;
constexpr size_t OFF_MOD = OFF_VF + SZ_B512;
constexpr size_t OFF_COS = OFF_MOD + (size_t)2 * 12288 * 4;
constexpr size_t OFF_SIN = OFF_COS + (size_t)S * 16 * 4;
constexpr size_t OFF_KM = OFF_SIN + (size_t)S * 16 * 4;
constexpr size_t OFF_SEL = OFF_KM + (size_t)4 * 64 * 128 * 4;
constexpr size_t OFF_LORA = OFF_SEL + (size_t)4 * S * 8;
constexpr size_t OFF_BAR = OFF_LORA + (size_t)512 * 448 * 2;
constexpr size_t WS_END = OFF_BAR + 4 * 256;

struct Params {
    const void* in[33];
    float* out;
    unsigned char* ws;
};

DEVI float bf2f(bf16_t b) { return __uint_as_float(((unsigned)b) << 16); }
DEVI bf16_t f2bf(float f) { unsigned u = __float_as_uint(f); u += 0x7FFFu + ((u >> 16) & 1u); return (bf16_t)(u >> 16); }
typedef __bf16 bf16x2_t __attribute__((ext_vector_type(2)));
DEVI unsigned cvt_pk_bf16(float lo, float hi) {
    const f32x2 v = {lo, hi}; const bf16x2_t r = __builtin_convertvector(v, bf16x2_t); return __builtin_bit_cast(unsigned, r);
}
DEVI float sigmoidf_(float x) { return __builtin_amdgcn_rcpf(1.0f + __expf(-x)); }
DEVI float siluf_(float x) { return x * __builtin_amdgcn_rcpf(1.0f + __expf(-x)); }
DEVI float wave_sum(float v) {
#pragma unroll
    for (int o = 32; o >= 1; o >>= 1) v += __shfl_xor(v, o);
    return v;
}
template <int CTRL> DEVI float dpp_f(float v) { return __int_as_float(__builtin_amdgcn_update_dpp(0, __float_as_int(v), CTRL, 0xF, 0xF, true)); }
DEVI float row16_sum(float v) {
    v += dpp_f<0xB1>(v);
    v += dpp_f<0x4E>(v);
    v += dpp_f<0x141>(v);
    v += dpp_f<0x140>(v);
    return v;
}

namespace pg8 {
constexpr int BM = 256, BK = 64, HALF = 128, HTB = HALF * BK * 2, STAGE_BYTES = 8 * HTB, NXCD = 8, WGM = 8;
DEVI int lds_byte(int r, int c) { const int st = (r >> 4) * 2 + (c >> 5), rr = r & 15, cc = c & 31, ob = rr * 64 + cc * 2; return st * 1024 + (ob ^ (((ob >> 9) & 1) << 5)); }
DEVI void stage_rc(int b, int& R, int& C) { const int st = b / 1024, sb = b % 1024, swz = sb ^ (((sb >> 9) & 1) << 5); R = (st >> 1) * 16 + swz / 64; C = (st & 1) * 32 + (swz % 64) / 2; }
DEVI int perm32(int rho) { const int n = rho >> 4, i = rho & 15; return 8 * (i >> 2) + 4 * n + (i & 3); }
struct Unit { int pm, pn; };
struct Gemm { const bf16_t* A; const bf16_t* Bt; int M, N, K; };
struct StaticOrder {
    int nM, nN, nwg, G, c;
    DEVI void init(int M, int N, int G_, int c_) { nM = M / BM; nN = N / BM; nwg = nM * nN; G = G_; c = c_; }
    DEVI bool next(int i, Unit& u) const {
        const long L = (long)i * G + c; if (L >= nwg) return false;
        int wgid = (int)L; { const int q = nwg / NXCD, r = nwg % NXCD, xcd = wgid % NXCD, off = wgid / NXCD; wgid = (xcd < r ? xcd * (q + 1) : r * (q + 1) + (xcd - r) * q) + off; }
        const int nig = WGM * nN, gid = wgid / nig, fm = gid * WGM, gsz = (nM - fm) < WGM ? (nM - fm) : WGM;
        u.pm = fm + ((wgid % nig) % gsz); u.pn = (wgid % nig) / gsz; return true;
    }
};
template <class Epi>
DEVI void gemm_phase(LAS unsigned char* lds, const Gemm g, const StaticOrder& S_, const Epi& E) {
    int tid_ = threadIdx.x; asm volatile("" : "+v"(tid_));
    int K_ = g.K; asm volatile("" : "+s"(K_));
    const int tid = tid_, wid = __builtin_amdgcn_readfirstlane(tid >> 6), lane = tid & 63, wr = wid >> 2, wc = wid & 3, fr = lane & 15, fq = lane >> 4;
    const int K = K_, nt = K / BK;
    unsigned voffA[2], voffB[2];
#pragma unroll
    for (int i = 0; i < 2; ++i) { int R, C; stage_rc(tid * 16 + i * 8192, R, C); const int Rb = (R & ~31) + perm32(R & 31);
        voffA[i] = (unsigned)(R * K + C) * 2u; voffB[i] = (unsigned)(Rb * K + C) * 2u; }
    const size_t kstep = (size_t)(BK * 2);
    const size_t hstep = (size_t)HALF * K * 2;
    const size_t tstep = 2 * hstep;
    const unsigned ldsw = (unsigned)wid * 1024u;
    const int aoff = lds_byte(wr * 64 + fr, fq * 8), boff = lds_byte(wc * 32 + fr, fq * 8);
#define PG8_SA(b, h) (((b) * 2 + (h)) * HTB)
#define PG8_SB(b, h) ((4 + (b) * 2 + (h)) * HTB)
#define PG8_STAGE(bufoff, gbase, voff) do { _Pragma("unroll") for (int _i = 0; _i < 2; ++_i) \
        __builtin_amdgcn_global_load_lds((const unsigned*)((const char*)(gbase) + (voff)[_i]), (LAS unsigned*)(lds + (bufoff) + ldsw + _i * 8192), 16, 0, 0); } while (0)
#define PG8_LDA(dst, b, h) do { _Pragma("unroll") for (int m = 0; m < 4; ++m) _Pragma("unroll") for (int k = 0; k < 2; ++k) dst[m][k] = *(const LAS bf16x8*)(lds + PG8_SA(b, h) + aoff + m * 2048 + k * 1024); } while (0)
#define PG8_LDB(dst, b, h) do { _Pragma("unroll") for (int n = 0; n < 2; ++n) _Pragma("unroll") for (int k = 0; k < 2; ++k) dst[n][k] = *(const LAS bf16x8*)(lds + PG8_SB(b, h) + boff + n * 2048 + k * 1024); } while (0)
#define PG8_MMA(ai, bj, At, Bt) do { __builtin_amdgcn_s_setprio(1); _Pragma("unroll") for (int m = 0; m < 4; ++m) _Pragma("unroll") for (int n = 0; n < 2; ++n) _Pragma("unroll") for (int k = 0; k < 2; ++k) \
        acc[ai][bj][m][n] = __builtin_amdgcn_mfma_f32_16x16x32_bf16(Bt[n][k], At[m][k], acc[ai][bj][m][n], 0, 0, 0); __builtin_amdgcn_s_setprio(0); } while (0)
#define PG8_WAIT_V(n) asm volatile("s_waitcnt vmcnt(" #n ")" ::: "memory")
#define PG8_WAIT_L(n) asm volatile("s_waitcnt lgkmcnt(" #n ")" ::: "memory")
#define PG8_BAR __builtin_amdgcn_s_barrier()
#define PG8_SCHED __builtin_amdgcn_sched_barrier(0)
    Unit cur, nxt; int ui = 0;
    if (!S_.next(0, cur)) return;
    f32x4 acc[2][2][4][2];
#pragma unroll
    for (int a = 0; a < 2; ++a)
#pragma unroll
        for (int b = 0; b < 2; ++b)
#pragma unroll
            for (int m = 0; m < 4; ++m)
#pragma unroll
                for (int n = 0; n < 2; ++n) acc[a][b][m][n] = (f32x4){0.f, 0.f, 0.f, 0.f};
    bf16x8 At[4][2], B0[2][2], B1[2][2];
    const char* cA = (const char*)g.A + (size_t)cur.pm * tstep; const char* cB = (const char*)g.Bt + (size_t)cur.pn * tstep;
    PG8_STAGE(PG8_SB(0, 0), cB, voffB); PG8_STAGE(PG8_SA(0, 0), cA, voffA); PG8_STAGE(PG8_SB(0, 1), cB + hstep, voffB); PG8_STAGE(PG8_SA(0, 1), cA + hstep, voffA);
    if (wr == 1) PG8_BAR;
    PG8_WAIT_V(4); PG8_BAR;
    PG8_STAGE(PG8_SB(1, 0), cB + kstep, voffB); PG8_STAGE(PG8_SA(1, 0), cA + kstep, voffA); PG8_STAGE(PG8_SB(1, 1), cB + hstep + kstep, voffB);
    PG8_WAIT_V(6); PG8_BAR;
    for (;;) {
        const bool has_next = S_.next(ui + 1, nxt);
        const char* nA = has_next ? (const char*)g.A + (size_t)nxt.pm * tstep : cA; const char* nB = has_next ? (const char*)g.Bt + (size_t)nxt.pn * tstep : cB;
        for (int t = 0; t < nt; t += 2) {
            const bool last = (t == nt - 2);
            const char* a1 = cA + (size_t)(t + 1) * kstep;
            const char* a2 = last ? nA : cA + (size_t)(t + 2) * kstep; const char* b2 = last ? nB : cB + (size_t)(t + 2) * kstep;
            const char* a3 = a2 + kstep; const char* b3 = b2 + kstep;
            PG8_LDB(B0, 0, 0); PG8_SCHED; PG8_LDA(At, 0, 0); PG8_STAGE(PG8_SA(1, 1), a1 + hstep, voffA);
            PG8_WAIT_L(8); PG8_BAR; PG8_WAIT_L(0); PG8_MMA(0, 0, At, B0); PG8_BAR; PG8_SCHED;
            PG8_LDB(B1, 0, 1); PG8_STAGE(PG8_SB(0, 0), b2, voffB);
            PG8_BAR; PG8_WAIT_L(0); PG8_MMA(0, 1, At, B1); PG8_BAR;
            PG8_LDA(At, 0, 1); PG8_STAGE(PG8_SA(0, 0), a2, voffA);
            PG8_BAR; PG8_WAIT_L(0); PG8_MMA(1, 0, At, B0); PG8_BAR; PG8_SCHED;
            PG8_STAGE(PG8_SB(0, 1), b2 + hstep, voffB);
            PG8_WAIT_V(6); PG8_BAR; PG8_MMA(1, 1, At, B1); PG8_BAR;
            PG8_LDB(B0, 1, 0); PG8_SCHED; PG8_LDA(At, 1, 0); PG8_STAGE(PG8_SA(0, 1), a2 + hstep, voffA);
            PG8_WAIT_L(8); PG8_BAR; PG8_WAIT_L(0); PG8_MMA(0, 0, At, B0); PG8_BAR; PG8_SCHED;
            PG8_LDB(B1, 1, 1); PG8_STAGE(PG8_SB(1, 0), b3, voffB);
            PG8_BAR; PG8_WAIT_L(0); PG8_MMA(0, 1, At, B1); PG8_BAR;
            PG8_LDA(At, 1, 1); PG8_STAGE(PG8_SA(1, 0), a3, voffA);
            PG8_BAR; PG8_WAIT_L(0); PG8_MMA(1, 0, At, B0); PG8_BAR; PG8_SCHED;
            PG8_STAGE(PG8_SB(1, 1), b3 + hstep, voffB);
            PG8_WAIT_V(6); PG8_BAR; PG8_MMA(1, 1, At, B1); PG8_BAR;
        }
        E(acc, cur, wr, wc, fr, fq);
        if (!has_next) break;
#pragma unroll
        for (int a = 0; a < 2; ++a)
#pragma unroll
            for (int b = 0; b < 2; ++b)
#pragma unroll
                for (int m = 0; m < 4; ++m)
#pragma unroll
                    for (int n = 0; n < 2; ++n) acc[a][b][m][n] = (f32x4){0.f, 0.f, 0.f, 0.f};
        cur = nxt; cA = nA; cB = nB; ++ui;
    }
    PG8_WAIT_V(0);
    if (wr == 0) PG8_BAR;
    PG8_BAR;
#undef PG8_SA
#undef PG8_SB
#undef PG8_STAGE
#undef PG8_LDA
#undef PG8_LDB
#undef PG8_MMA
#undef PG8_WAIT_V
#undef PG8_WAIT_L
#undef PG8_BAR
#undef PG8_SCHED
}
}
using pg8::Unit;

struct EpiInProj {
    bf16_t *G, *P1G, *P1R, *P2; const float *cosT, *sinT;
    DEVI void operator()(const f32x4 (&acc)[2][2][4][2], const Unit& u, int wr, int wc, int fr, int fq) const {
        const int pn = u.pn; const int row0 = u.pm * 256 + wr * 64 + fr; const int cl = wc * 32 + 8 * fq;
        const bool plain = (pn < 39) || (pn >= 48 && pn < 56);
        if (plain) {
            bf16_t* base; int ld, pnl; bool sg = false;
            if (pn < 32) { base = G; ld = 8192; pnl = pn; sg = true; }
            else if (pn < 39) { base = P1G; ld = 1792; pnl = pn - 32; }
            else { base = P1R; ld = 2048; pnl = pn - 48; }
#pragma unroll
            for (int ai = 0; ai < 2; ++ai)
#pragma unroll
                for (int m = 0; m < 4; ++m) {
                    bf16_t* rowp = base + (size_t)(row0 + ai * 128 + m * 16) * ld + pnl * 256 + cl;
#pragma unroll
                    for (int bj = 0; bj < 2; ++bj) {
                        f32x4 v0 = acc[ai][bj][m][0], v1 = acc[ai][bj][m][1];
                        if (sg) {
#pragma unroll
                            for (int j = 0; j < 4; ++j) { v0[j] = sigmoidf_(v0[j]); v1[j] = sigmoidf_(v1[j]); }
                        }
                        u32x4 w; w.x = cvt_pk_bf16(v0[0], v0[1]); w.y = cvt_pk_bf16(v0[2], v0[3]); w.z = cvt_pk_bf16(v1[0], v1[1]); w.w = cvt_pk_bf16(v1[2], v1[3]);
                        *(u32x4*)(rowp + bj * 128) = w;
                    }
                    __builtin_amdgcn_sched_barrier(0);
                }
        } else {
            int t, hbase, arr0;
            if (pn < 48) { const int pl = pn - 39; t = pl / 3; hbase = (pl % 3) * 2; arr0 = t * 6 + hbase; }
            else { const int pl = pn - 56; t = pl / 2; hbase = (pl % 2) * 2; arr0 = 18 + t * 4 + hbase; }
            const bool rope = (t < 2) && (wc == 0);
            const float sc = (t == 0) ? 0.08838834764831845f : 1.0f;
#pragma unroll
            for (int ai = 0; ai < 2; ++ai)
#pragma unroll
                for (int m = 0; m < 4; ++m) {
                    const int row = row0 + ai * 128 + m * 16;
#pragma unroll
                    for (int bj = 0; bj < 2; ++bj) {
                        f32x4 v0 = acc[ai][bj][m][0], v1 = acc[ai][bj][m][1];
                        if (rope) {
                            const f32x4 c0 = *(const f32x4*)(cosT + (size_t)row * 16 + 8 * (fq & 1)), c1 = *(const f32x4*)(cosT + (size_t)row * 16 + 8 * (fq & 1) + 4);
                            const f32x4 s0 = *(const f32x4*)(sinT + (size_t)row * 16 + 8 * (fq & 1)), s1 = *(const f32x4*)(sinT + (size_t)row * 16 + 8 * (fq & 1) + 4);
                            const float sgn = (fq < 2) ? -1.0f : 1.0f;
#pragma unroll
                            for (int j = 0; j < 4; ++j) {
                                const float p0 = __shfl_xor(v0[j], 32), p1 = __shfl_xor(v1[j], 32);
                                v0[j] = v0[j] * c0[j] + sgn * p0 * s0[j];
                                v1[j] = v1[j] * c1[j] + sgn * p1 * s1[j];
                            }
                        }
                        v0 *= sc; v1 *= sc;
                        bf16_t* dst = P2 + (size_t)(arr0 + bj) * ((size_t)S * 128) + (size_t)row * 128 + cl;
                        u32x4 w; w.x = cvt_pk_bf16(v0[0], v0[1]); w.y = cvt_pk_bf16(v0[2], v0[3]); w.z = cvt_pk_bf16(v1[0], v1[1]); w.w = cvt_pk_bf16(v1[2], v1[3]);
                        *(u32x4*)dst = w;
                    }
                    __builtin_amdgcn_sched_barrier(0);
                }
        }
    }
};

struct EpiBranch {
    const bf16_t* Gb; bf16_t* Mg; int first;
    DEVI void operator()(const f32x4 (&acc)[2][2][4][2], const Unit& u, int wr, int wc, int fr, int fq) const {
        const int row0 = u.pm * 256 + wr * 64 + fr; const int col0 = u.pn * 256 + wc * 32 + 8 * fq;
#pragma unroll
        for (int ai = 0; ai < 2; ++ai)
#pragma unroll
            for (int m = 0; m < 4; ++m) {
                const int row = row0 + ai * 128 + m * 16;
#pragma unroll
                for (int bj = 0; bj < 2; ++bj) {
                    const int col = col0 + bj * 128;
                    const u32x4 gw = *(const u32x4*)(Gb + (size_t)row * 8192 + col);
                    bf16_t* mp = Mg + (size_t)row * 2048 + col;
                    float o[8];
#pragma unroll
                    for (int j = 0; j < 4; ++j) { o[j] = acc[ai][bj][m][0][j]; o[4 + j] = acc[ai][bj][m][1][j]; }
#pragma unroll
                    for (int j = 0; j < 4; ++j) {
                        o[2 * j] *= __uint_as_float(gw[j] << 16);
                        o[2 * j + 1] *= __uint_as_float(gw[j] & 0xFFFF0000u);
                    }
                    if (!first) {
                        const u32x4 mw = *(const u32x4*)mp;
#pragma unroll
                        for (int j = 0; j < 4; ++j) { o[2 * j] += __uint_as_float(mw[j] << 16); o[2 * j + 1] += __uint_as_float(mw[j] & 0xFFFF0000u); }
                    }
                    u32x4 w; w.x = cvt_pk_bf16(o[0], o[1]); w.y = cvt_pk_bf16(o[2], o[3]); w.z = cvt_pk_bf16(o[4], o[5]); w.w = cvt_pk_bf16(o[6], o[7]);
                    *(u32x4*)mp = w;
                    __builtin_amdgcn_sched_barrier(0);
                }
            }
    }
};

struct EpiResid {
    const float* src; float* dst; const float* gate;
    DEVI void operator()(const f32x4 (&acc)[2][2][4][2], const Unit& u, int wr, int wc, int fr, int fq) const {
        const int row0 = u.pm * 256 + wr * 64 + fr; const int col0 = u.pn * 256 + wc * 32 + 8 * fq;
        f32x4 gv[2][2];
#pragma unroll
        for (int bj = 0; bj < 2; ++bj)
#pragma unroll
            for (int n = 0; n < 2; ++n) gv[bj][n] = *(const f32x4*)(gate + col0 + bj * 128 + 4 * n);
#pragma unroll
        for (int ai = 0; ai < 2; ++ai)
#pragma unroll
            for (int m = 0; m < 4; ++m) {
                const size_t ro = (size_t)(row0 + ai * 128 + m * 16) * 2048 + col0;
#pragma unroll
                for (int bj = 0; bj < 2; ++bj)
#pragma unroll
                    for (int n = 0; n < 2; ++n) {
                        const f32x4 xv = *(const f32x4*)(src + ro + bj * 128 + 4 * n);
                        *(f32x4*)(dst + ro + bj * 128 + 4 * n) = xv + gv[bj][n] * acc[ai][bj][m][n];
                    }
                __builtin_amdgcn_sched_barrier(0);
            }
    }
};

struct EpiSwiglu {
    bf16_t* act;
    DEVI void operator()(const f32x4 (&acc)[2][2][4][2], const Unit& u, int wr, int wc, int fr, int fq) const {
        const int row0 = u.pm * 256 + wr * 64 + fr; const int col0 = u.pn * 128 + wc * 32 + 8 * fq;
#pragma unroll
        for (int ai = 0; ai < 2; ++ai)
#pragma unroll
            for (int m = 0; m < 4; ++m) {
                float o[8];
#pragma unroll
                for (int j = 0; j < 4; ++j) { o[j] = siluf_(acc[ai][0][m][0][j]) * acc[ai][1][m][0][j]; o[4 + j] = siluf_(acc[ai][0][m][1][j]) * acc[ai][1][m][1][j]; }
                u32x4 w; w.x = cvt_pk_bf16(o[0], o[1]); w.y = cvt_pk_bf16(o[2], o[3]); w.z = cvt_pk_bf16(o[4], o[5]); w.w = cvt_pk_bf16(o[6], o[7]);
                *(u32x4*)(act + (size_t)(row0 + ai * 128 + m * 16) * FFN_H + col0) = w;
                __builtin_amdgcn_sched_barrier(0);
            }
    }
};

template <class Epi>
DEVI void run_gemm(unsigned char* smem, const bf16_t* A, const bf16_t* Bt, int N, int K, const Epi& E) {
    pg8::Gemm g; g.A = A; g.Bt = Bt; g.M = S; g.N = N; g.K = K;
    pg8::StaticOrder so; so.init(S, N, gridDim.x, blockIdx.x);
    pg8::gemm_phase<Epi>((LAS unsigned char*)smem, g, so, E);
}

DEVI int srccol_win(int n) {
    if (n < 8192) return n;
    if (n < 9984) { const int j = n - 8192; return j < 1552 ? 8192 + j : -1; }
    if (n < 12288) return 9744 + (n - 9984);
    if (n < 14336) { const int j = n - 12288; return j < 1984 ? 12048 + j : -1; }
    return 14032 + (n - 14336);
}
DEVI int srccol_ffn(int n) { return ((n >> 7) & 1) * FFN_H + (n >> 8) * 128 + (n & 127); }

DEVI void conv_tile(unsigned char* smem, const float* src, int ldsrc, int K, bf16_t* dst, int mode, int ntile, int ktile) {
    int tid_ = threadIdx.x; asm volatile("" : "+v"(tid_));
    float* tile = (float*)smem;
    const int tid = tid_, tx = tid & 63, ty = tid >> 6;
    const int n0 = ntile * 64, k0 = ktile * 64;
    const int n = n0 + tx;
    const int sc = mode == 0 ? srccol_win(n) : (mode == 1 ? srccol_ffn(n) : n);
#pragma unroll
    for (int i = 0; i < 8; ++i) {
        const int kk = ty + 8 * i;
        tile[kk * 65 + tx] = sc >= 0 ? src[(size_t)(k0 + kk) * ldsrc + sc] : 0.0f;
    }
    __syncthreads();
    const int nr = tid >> 3, ks = (tid & 7) * 8;
    float v[8];
#pragma unroll
    for (int j = 0; j < 8; ++j) v[j] = tile[(ks + j) * 65 + nr];
    u32x4 w; w.x = cvt_pk_bf16(v[0], v[1]); w.y = cvt_pk_bf16(v[2], v[3]); w.z = cvt_pk_bf16(v[4], v[5]); w.w = cvt_pk_bf16(v[6], v[7]);
    *(u32x4*)(dst + (size_t)(n0 + nr) * K + k0 + ks) = w;
    __syncthreads();
}

DEVI void phase_convert(const Params& p, int l, unsigned char* smem, int bid, int nb) {
    const int c0 = 248 * 32, c1 = c0 + 32 * 8, c2 = c1 + 32 * 4, c3 = c2 + 32 * 8, c4 = c3 + 32 * 8, c5 = c4 + 32 * 32, c6 = c5 + 176 * 32, c7 = c6 + 32 * 88;
    unsigned char* ws = p.ws;
    {
        int tl_ = threadIdx.x; asm volatile("" : "+v"(tl_)); int ll_ = l; asm volatile("" : "+s"(ll_));
        size_t wzz_ = 0; asm volatile("" : "+s"(wzz_));
        bf16_t* WT = (bf16_t*)(ws + wzz_ + OFF_LORA);
        const float* w2 = (const float*)p.in[12] + (size_t)ll_ * 96 * 512; const float* a2 = (const float*)p.in[14] + (size_t)ll_ * 96 * 512; const float* g2 = (const float*)p.in[15] + (size_t)ll_ * 256 * 512;
        for (int k = bid; k < 448; k += nb) {
            const int n = tl_;
            const float v = k < 96 ? w2[k * 512 + n] : (k < 192 ? a2[(k - 96) * 512 + n] : g2[(k - 192) * 512 + n]);
            WT[n * 448 + k] = f2bf(v);
        }
    }
    for (int it = bid; it < c7; it += nb) {
        if (it < c0) { conv_tile(smem, (const float*)p.in[6] + (size_t)l * D * IN_TOTAL, IN_TOTAL, D, (bf16_t*)(ws + OFF_WIN), 0, it / 32, it % 32); }
        else if (it < c1) { const int j = it - c0; conv_tile(smem, (const float*)p.in[24] + (size_t)l * 512 * D, D, 512, (bf16_t*)(ws + OFF_WBA), 2, j / 8, j % 8); }
        else if (it < c2) { const int j = it - c1; conv_tile(smem, (const float*)p.in[25] + (size_t)l * 256 * D, D, 256, (bf16_t*)(ws + OFF_WBB), 2, j / 4, j % 4); }
        else if (it < c3) { const int j = it - c2; conv_tile(smem, (const float*)p.in[26] + (size_t)l * 512 * D, D, 512, (bf16_t*)(ws + OFF_WBC), 2, j / 8, j % 8); }
        else if (it < c4) { const int j = it - c3; conv_tile(smem, (const float*)p.in[27] + (size_t)l * 512 * D, D, 512, (bf16_t*)(ws + OFF_WBD), 2, j / 8, j % 8); }
        else if (it < c5) { const int j = it - c4; conv_tile(smem, (const float*)p.in[28] + (size_t)l * D * D, D, D, (bf16_t*)(ws + OFF_WOUT), 2, j / 32, j % 32); }
        else if (it < c6) { const int j = it - c5; conv_tile(smem, (const float*)p.in[30] + (size_t)l * D * 2 * FFN_H, 2 * FFN_H, D, (bf16_t*)(ws + OFF_WF1), 1, j / 32, j % 32); }
        else { const int j = it - c6; conv_tile(smem, (const float*)p.in[31] + (size_t)l * FFN_H * D, D, FFN_H, (bf16_t*)(ws + OFF_WF2), 2, j / 88, j % 88); }
    }
}

DEVI void phase_mod_rope(const Params& p, unsigned char* smem, int bid, int nb) {
    int tid_ = threadIdx.x; asm volatile("" : "+v"(tid_)); size_t wz_ = 0; asm volatile("" : "+s"(wz_)); unsigned char* ws_ = p.ws + wz_;
    const int tid = tid_;
    float* sc = (float*)smem;
    float* red = sc + 2048;
    const float* c = (const float*)p.in[1];
    for (int i = tid; i < D; i += NT) sc[i] = siluf_(c[i]);
    __syncthreads();
    float* mod = (float*)(ws_ + OFF_MOD);
    for (int it = bid; it < 192; it += nb) {
        const int l = it / 96, cg0 = (it % 96) * 128;
        const float* W = (const float*)p.in[3] + (size_t)l * D * 12288;
        const int col = tid & 127, kq = tid >> 7;
        float a = 0.f;
        const float* wp = W + (size_t)(kq * 512) * 12288 + cg0 + col;
#pragma unroll 8
        for (int k = 0; k < 512; ++k) a += sc[kq * 512 + k] * wp[(size_t)k * 12288];
        red[kq * 128 + col] = a;
        __syncthreads();
        if (tid < 128) mod[l * 12288 + cg0 + tid] = red[tid] + red[128 + tid] + red[256 + tid] + red[384 + tid] + ((const float*)p.in[4])[l * 12288 + cg0 + tid];
        __syncthreads();
    }
    const float invf[16] = {1.000000000e+00f, 4.403665960e-01f, 1.939227432e-01f, 8.539710194e-02f, 3.760603070e-02f, 1.656043902e-02f, 7.292664610e-03f, 3.211445874e-03f,
                            1.414213562e-03f, 6.227723788e-04f, 2.742481884e-04f, 1.207697351e-04f, 5.318296098e-05f, 2.341999971e-05f, 1.031338616e-05f, 4.541670478e-06f};
    const int* pos = (const int*)p.in[2];
    float* cosT = (float*)(ws_ + OFF_COS); float* sinT = (float*)(ws_ + OFF_SIN);
    for (int e = bid * NT + tid; e < S * 16; e += nb * NT) {
        const int t = e >> 4, i = e & 15;
        float fi = invf[0];
#pragma unroll
        for (int j = 1; j < 16; ++j) fi = (i == j) ? invf[j] : fi;
        const float ang = (float)pos[t] * fi;
        const double a = (double)ang;
        const double kq = __builtin_rint(a * 0.15915494309189535);
        const double r = a - kq * 6.283185307179586;
        const double y = r * 0.25, y2 = y * y;
        double s = y * (1.0 - y2 / 6.0 * (1.0 - y2 / 20.0 * (1.0 - y2 / 42.0 * (1.0 - y2 / 72.0 * (1.0 - y2 / 110.0 * (1.0 - y2 / 156.0))))));
        double cc = 1.0 - y2 / 2.0 * (1.0 - y2 / 12.0 * (1.0 - y2 / 30.0 * (1.0 - y2 / 56.0 * (1.0 - y2 / 90.0 * (1.0 - y2 / 132.0 * (1.0 - y2 / 182.0))))));
        double s2 = 2.0 * s * cc, c2 = 1.0 - 2.0 * s * s;
        double s4 = 2.0 * s2 * c2, c4 = 1.0 - 2.0 * s2 * s2;
        cosT[e] = (float)c4; sinT[e] = (float)s4;
    }
}

DEVI void phase_norm(const float* x, const float* gain, const float* shift, const float* scale, bf16_t* h, int bid, int nb) {
    int tid_ = threadIdx.x; asm volatile("" : "+v"(tid_));
    const int wid = tid_ >> 6, lane = tid_ & 63;
    for (int row = bid * 8 + wid; row < S; row += nb * 8) {
        const f32x4* xr = (const f32x4*)(x + (size_t)row * D);
        f32x4 v[8]; float ss = 0.f;
#pragma unroll
        for (int i = 0; i < 8; ++i) { v[i] = xr[lane + 64 * i]; ss += v[i][0] * v[i][0] + v[i][1] * v[i][1] + v[i][2] * v[i][2] + v[i][3] * v[i][3]; }
        ss = wave_sum(ss);
        const float r = rsqrtf(ss * (1.0f / D) + 1e-6f);
#pragma unroll
        for (int i = 0; i < 8; ++i) {
            const int c4 = lane + 64 * i;
            const f32x4 g = ((const f32x4*)gain)[c4], sh = ((const f32x4*)shift)[c4], sc = ((const f32x4*)scale)[c4];
            f32x4 y = v[i] * r * g * (sc + 1.0f) + sh;
            u32x2 w; w.x = cvt_pk_bf16(y[0], y[1]); w.y = cvt_pk_bf16(y[2], y[3]);
            *(u32x2*)(h + (size_t)row * D + c4 * 4) = w;
        }
    }
}

DEVI void phase_final_norm(float* x, const float* gain, int bid, int nb) {
    int tid_ = threadIdx.x; asm volatile("" : "+v"(tid_));
    const int wid = tid_ >> 6, lane = tid_ & 63;
    for (int row = bid * 8 + wid; row < S; row += nb * 8) {
        f32x4* xr = (f32x4*)(x + (size_t)row * D);
        f32x4 v[8]; float ss = 0.f;
#pragma unroll
        for (int i = 0; i < 8; ++i) { v[i] = xr[lane + 64 * i]; ss += v[i][0] * v[i][0] + v[i][1] * v[i][1] + v[i][2] * v[i][2] + v[i][3] * v[i][3]; }
        ss = wave_sum(ss);
        const float r = rsqrtf(ss * (1.0f / D) + 1e-6f);
#pragma unroll
        for (int i = 0; i < 8; ++i) xr[lane + 64 * i] = v[i] * r * ((const f32x4*)gain)[lane + 64 * i];
    }
}

DEVI float logsigmoidf_(float x) { return fminf(x, 0.f) - log1pf(__expf(-fabsf(x))); }

DEVI void gla_pass1(const Params& p, int l, unsigned char* smem, int item) {
    int tid_ = threadIdx.x; asm volatile("" : "+v"(tid_)); size_t wz_ = 0; asm volatile("" : "+s"(wz_)); unsigned char* ws_ = p.ws + wz_;
    const int n = item >> 2, h = item & 3, tok0 = n * 64, tid = tid_;
    float* sB = (float*)smem;
    float* sK = sB + 4096;
    float* sV = sK + 4096;
    float* sA = sV + 8192;
    float* sW = sA + 1024;
    const bf16_t* P = (const bf16_t*)(ws_ + OFF_P1G);
    const float* wa2 = (const float*)p.in[7] + (size_t)l * 16 * 256;
    const float* ba2 = (const float*)p.in[8] + (size_t)l * 256;
    for (int e = tid; e < 1024; e += NT) { sA[e] = bf2f(P[(size_t)(tok0 + (e >> 4)) * 1792 + 1536 + (e & 15)]); sW[e] = wa2[(e >> 6) * 256 + h * 64 + (e & 63)]; }
    __syncthreads();
    for (int e = tid; e < 4096; e += NT) {
        const int t = e >> 6, d = e & 63;
        float x = ba2[h * 64 + d];
#pragma unroll
        for (int r = 0; r < 16; ++r) x += sA[t * 16 + r] * sW[r * 64 + d];
        sB[e] = logsigmoidf_(x) * (1.0f / 16.0f);
    }
    __syncthreads();
    if (tid < 64) { float a = 0.f; for (int t = 0; t < 64; ++t) { a += sB[t * 64 + tid]; sB[t * 64 + tid] = a; } }
    __syncthreads();
    float* Bbuf = (float*)(ws_ + OFF_GLB);
    for (int e = tid; e < 4096; e += NT) {
        const int s = e >> 6, d = e & 63;
        const float b = sB[e], bl = sB[63 * 64 + d];
        sK[e] = bf2f(P[(size_t)(tok0 + s) * 1792 + 256 + h * 64 + d]) * __expf(bl - b);
        Bbuf[(size_t)(tok0 + s) * 256 + h * 64 + d] = b;
    }
    for (int e = tid; e < 8192; e += NT) sV[e] = bf2f(P[(size_t)(tok0 + (e >> 7)) * 1792 + 512 + h * 128 + (e & 127)]);
    if (tid < 64) ((float*)(ws_ + OFF_GLD))[(size_t)item * 64 + tid] = __expf(sB[63 * 64 + tid]);
    __syncthreads();
    {
        const int d = tid >> 3, eg = (tid & 7) * 16;
        f32x4 a0 = {0, 0, 0, 0}, a1 = a0, a2 = a0, a3 = a0;
        for (int s = 0; s < 64; ++s) {
            const float kd = sK[s * 64 + d];
            const f32x4* vp = (const f32x4*)(sV + s * 128 + eg);
            a0 += kd * vp[0]; a1 += kd * vp[1]; a2 += kd * vp[2]; a3 += kd * vp[3];
        }
        f32x4* Lp = (f32x4*)((float*)(ws_ + OFF_GLL) + ((size_t)item * 64 + d) * 128 + eg);
        Lp[0] = a0; Lp[1] = a1; Lp[2] = a2; Lp[3] = a3;
    }
    __syncthreads();
}

DEVI void gla_pass2(const Params& p, int item) {
    int tid_ = threadIdx.x; asm volatile("" : "+v"(tid_)); size_t wz_ = 0; asm volatile("" : "+s"(wz_)); unsigned char* ws_ = p.ws + wz_;
    const int idx = item * NT + tid_;
    const int h = idx >> 13, de = idx & 8191, d = de >> 7;
    float* L = (float*)(ws_ + OFF_GLL); const float* Dc = (const float*)(ws_ + OFF_GLD);
    float st = 0.f;
    for (int n0 = 0; n0 < 256; n0 += 8) {
        float tmp[8], dc[8];
#pragma unroll
        for (int j = 0; j < 8; ++j) { tmp[j] = L[((size_t)((n0 + j) * 4 + h) * 64) * 128 + de]; dc[j] = Dc[((n0 + j) * 4 + h) * 64 + d]; }
#pragma unroll
        for (int j = 0; j < 8; ++j) { L[((size_t)((n0 + j) * 4 + h) * 64) * 128 + de] = st; st = dc[j] * st + tmp[j]; }
    }
}

DEVI void gla_pass3(const Params& p, int l, unsigned char* smem, int item) {
    int tid_ = threadIdx.x; asm volatile("" : "+v"(tid_)); size_t wz_ = 0; asm volatile("" : "+s"(wz_)); unsigned char* ws_ = p.ws + wz_;
    const int n = item >> 2, h = item & 3, tok0 = n * 64, tid = tid_;
    float* sQ = (float*)smem;
    float* sK = sQ + 4096;
    float* sV = sK + 4160;
    float* sS = sV + 8192;
    float* sSc = sS + 8192;
    const bf16_t* P = (const bf16_t*)(ws_ + OFF_P1G);
    const float* Bbuf = (const float*)(ws_ + OFF_GLB);
    for (int e = tid; e < 4096; e += NT) {
        const int t = e >> 6, d = e & 63;
        const float b = Bbuf[(size_t)(tok0 + t) * 256 + h * 64 + d];
        sQ[e] = bf2f(P[(size_t)(tok0 + t) * 1792 + h * 64 + d]) * 0.125f * __expf(b);
        sK[t * 65 + d] = bf2f(P[(size_t)(tok0 + t) * 1792 + 256 + h * 64 + d]) * __expf(-b);
    }
    const float* Lp = (const float*)(ws_ + OFF_GLL) + (size_t)item * 8192;
    for (int e = tid; e < 8192; e += NT) { sV[e] = bf2f(P[(size_t)(tok0 + (e >> 7)) * 1792 + 512 + h * 128 + (e & 127)]); sS[e] = Lp[e]; }
    __syncthreads();
    {
        const int t = tid >> 3, sg = (tid & 7) * 8;
        float a[8];
#pragma unroll
        for (int j = 0; j < 8; ++j) a[j] = 0.f;
        for (int d = 0; d < 64; ++d) {
            const float qv = sQ[t * 64 + d];
#pragma unroll
            for (int j = 0; j < 8; ++j) a[j] += qv * sK[(sg + j) * 65 + d];
        }
#pragma unroll
        for (int j = 0; j < 8; ++j) sSc[t * 64 + sg + j] = (sg + j <= t) ? a[j] : 0.f;
    }
    __syncthreads();
    {
        const int t = tid >> 3, eg = (tid & 7) * 16;
        f32x4 a0 = {0, 0, 0, 0}, a1 = a0, a2 = a0, a3 = a0;
        for (int d = 0; d < 64; ++d) {
            const float qv = sQ[t * 64 + d];
            const f32x4* sp = (const f32x4*)(sS + d * 128 + eg);
            a0 += qv * sp[0]; a1 += qv * sp[1]; a2 += qv * sp[2]; a3 += qv * sp[3];
        }
        for (int s = 0; s < 64; ++s) {
            const float sc = sSc[t * 64 + s];
            const f32x4* vp = (const f32x4*)(sV + s * 128 + eg);
            a0 += sc * vp[0]; a1 += sc * vp[1]; a2 += sc * vp[2]; a3 += sc * vp[3];
        }
        float ss = 0.f;
#pragma unroll
        for (int j = 0; j < 4; ++j) ss += a0[j] * a0[j] + a1[j] * a1[j] + a2[j] * a2[j] + a3[j] * a3[j];
        ss += __shfl_xor(ss, 1); ss += __shfl_xor(ss, 2); ss += __shfl_xor(ss, 4);
        const float r = rsqrtf(ss * (1.0f / 128.0f) + 1e-6f);
        const float* gn = (const float*)p.in[9] + (size_t)l * 128 + eg;
        const bf16_t* gp = P + (size_t)(tok0 + t) * 1792 + 1024 + h * 128 + eg;
        float o[16];
#pragma unroll
        for (int j = 0; j < 4; ++j) { o[j] = a0[j]; o[4 + j] = a1[j]; o[8 + j] = a2[j]; o[12 + j] = a3[j]; }
#pragma unroll
        for (int j = 0; j < 16; ++j) o[j] = o[j] * r * gn[j] * siluf_(bf2f(gp[j]));
        bf16_t* op = (bf16_t*)(ws_ + OFF_OGLA) + (size_t)(tok0 + t) * 512 + h * 128 + eg;
        u32x4 w0, w1;
        w0.x = cvt_pk_bf16(o[0], o[1]); w0.y = cvt_pk_bf16(o[2], o[3]); w0.z = cvt_pk_bf16(o[4], o[5]); w0.w = cvt_pk_bf16(o[6], o[7]);
        w1.x = cvt_pk_bf16(o[8], o[9]); w1.y = cvt_pk_bf16(o[10], o[11]); w1.z = cvt_pk_bf16(o[12], o[13]); w1.w = cvt_pk_bf16(o[14], o[15]);
        *(u32x4*)op = w0; *(u32x4*)(op + 8) = w1;
    }
    __syncthreads();
}

DEVI void rwkv_prep(const Params& p, int l, unsigned char* smem, int item) {
    int tid_ = threadIdx.x; asm volatile("" : "+v"(tid_)); size_t wz_ = 0; asm volatile("" : "+s"(wz_)); unsigned char* ws_ = p.ws + wz_;
    const int tok0 = item * 16, c = tid_, tid = tid_;
    bf16_t* sX = (bf16_t*)smem;
    float* sAcc = (float*)(smem + 16384);
    float* sVx = (float*)(smem + 16384);
    float* sMid = sVx + 512 * 16;
    const bf16_t* P = (const bf16_t*)(ws_ + OFF_P1R);
    const float* mu = (const float*)p.in[10] + (size_t)l * 1984;
    bf16_t lx[14], lxp[14];
#pragma unroll
    for (int i = 0; i < 14; ++i) {
        const int e = tid + i * NT, t = e / 448, j = e % 448, col = 1536 + j, tok = tok0 + t;
        lx[i] = P[(size_t)tok * 2048 + col]; lxp[i] = tok > 0 ? P[(size_t)(tok - 1) * 2048 + col] : (bf16_t)0;
    }
#pragma unroll
    for (int i = 0; i < 14; ++i) {
        const int e = tid + i * NT;
        const int t = e / 448, j = e % 448, col = 1536 + j;
        const float x = bf2f(lx[i]);
        const float xp = bf2f(lxp[i]);
        const float xs = x + (xp - x) * mu[col];
        float v;
        if (j < 96) { const float e2 = __expf(2.0f * xs); v = 1.0f - 2.0f / (e2 + 1.0f); }
        else if (j < 192) v = xs;
        else v = sigmoidf_(xs);
        sX[t * 456 + j] = f2bf(v);
    }
    const float mu_r = mu[c], mu_k = mu[512 + c], mu_v = mu[1024 + c];
    bf16_t xv[17];
    xv[0] = tok0 > 0 ? P[(size_t)(tok0 - 1) * 2048 + 1024 + c] : (bf16_t)0;
#pragma unroll
    for (int t = 0; t < 16; ++t) xv[t + 1] = P[(size_t)(tok0 + t) * 2048 + 1024 + c];
    __syncthreads();
    {
        const int wid = tid >> 6, lane = tid & 63, li = lane & 15, g = lane >> 4;
        const bf16_t* WT = (const bf16_t*)(ws_ + OFF_LORA);
#pragma unroll
        for (int lo = 0; lo < 3; ++lo) {
            const int kb = lo == 0 ? 0 : (lo == 1 ? 96 : 192), nks = lo == 2 ? 8 : 3;
            f32x4 acc[4];
#pragma unroll
            for (int q = 0; q < 4; ++q) acc[q] = (f32x4){0.f, 0.f, 0.f, 0.f};
            for (int ks = 0; ks < nks; ++ks) {
                const bf16x8 af = *(const bf16x8*)(sX + li * 456 + kb + ks * 32 + g * 8);
#pragma unroll
                for (int q = 0; q < 4; ++q) {
                    const bf16x8 bfr = *(const bf16x8*)(WT + (size_t)((wid * 4 + q) * 16 + li) * 448 + kb + ks * 32 + g * 8);
                    acc[q] = __builtin_amdgcn_mfma_f32_16x16x32_bf16(af, bfr, acc[q], 0, 0, 0);
                }
            }
#pragma unroll
            for (int q = 0; q < 4; ++q)
#pragma unroll
                for (int r = 0; r < 4; ++r) sAcc[(lo * 16 + 4 * g + r) * 512 + (wid * 4 + q) * 16 + li] = acc[q][r];
        }
    }
    __syncthreads();
    float wacc[16], aacc[16], gacc[16];
#pragma unroll
    for (int t = 0; t < 16; ++t) { wacc[t] = sAcc[t * 512 + c]; aacc[t] = sAcc[(16 + t) * 512 + c]; gacc[t] = sAcc[(32 + t) * 512 + c]; }
    __syncthreads();
#pragma unroll
    for (int t = 0; t < 16; ++t) { const float x = bf2f(xv[t + 1]), xp = bf2f(xv[t]); sVx[c * 16 + t] = x + (xp - x) * mu_v; }
    __syncthreads();
    float vacc[16];
#pragma unroll
    for (int t = 0; t < 16; ++t) vacc[t] = 0.f;
    if (l > 0) {
        const float* v1 = (const float*)p.in[22];
        const float* v2 = (const float*)p.in[23];
        {
            const int m = tid & 63, cp = tid >> 6;
            float ma[16];
#pragma unroll
            for (int t = 0; t < 16; ++t) ma[t] = 0.f;
#pragma unroll 8
            for (int cc = 0; cc < 64; ++cc) {
                const float w = v1[(cp * 64 + cc) * 64 + m]; const f32x4* lp = (const f32x4*)(sVx + (cp * 64 + cc) * 16);
#pragma unroll
                for (int q = 0; q < 4; ++q) { const f32x4 x = lp[q]; ma[4 * q] += x[0] * w; ma[4 * q + 1] += x[1] * w; ma[4 * q + 2] += x[2] * w; ma[4 * q + 3] += x[3] * w; }
            }
            float* sP = sMid + 64 * 16;
#pragma unroll
            for (int q = 0; q < 4; ++q) *(f32x4*)(sP + (cp * 64 + m) * 16 + 4 * q) = (f32x4){ma[4 * q], ma[4 * q + 1], ma[4 * q + 2], ma[4 * q + 3]};
            __syncthreads();
            for (int e = tid; e < 1024; e += NT) {
                float a = 0.f;
#pragma unroll
                for (int k = 0; k < 8; ++k) a += sP[k * 1024 + e];
                sMid[e] = a;
            }
        }
        __syncthreads();
#pragma unroll 8
        for (int m = 0; m < 64; ++m) {
            const float w = v2[m * 512 + c]; const f32x4* lp = (const f32x4*)(sMid + m * 16);
#pragma unroll
            for (int q = 0; q < 4; ++q) { const f32x4 x = lp[q]; vacc[4 * q] += x[0] * w; vacc[4 * q + 1] += x[1] * w; vacc[4 * q + 2] += x[2] * w; vacc[4 * q + 3] += x[3] * w; }
        }
    }
    const float w0 = ((const float*)p.in[11])[l * 512 + c], a0 = ((const float*)p.in[13])[l * 512 + c];
    const float k_k = ((const float*)p.in[16])[l * 512 + c], k_a = ((const float*)p.in[17])[l * 512 + c];
    const float v0 = l > 0 ? ((const float*)p.in[21])[c] : 0.f;
    bf16_t* R = (bf16_t*)(ws_ + OFF_RWR); bf16_t* Kb = (bf16_t*)(ws_ + OFF_RWK); bf16_t* Vb = (bf16_t*)(ws_ + OFF_RWV);
    bf16_t* Ab = (bf16_t*)(ws_ + OFF_RWA); bf16_t* Bb = (bf16_t*)(ws_ + OFF_RWB); bf16_t* Gb = (bf16_t*)(ws_ + OFF_RWG);
    float* Wb = (float*)(ws_ + OFF_RWW); bf16_t* VF = (bf16_t*)(ws_ + OFF_VF);
    bf16_t xrr[17], xkr[17], vfr[16];
    xrr[0] = tok0 > 0 ? P[(size_t)(tok0 - 1) * 2048 + c] : (bf16_t)0; xkr[0] = tok0 > 0 ? P[(size_t)(tok0 - 1) * 2048 + 512 + c] : (bf16_t)0;
#pragma unroll
    for (int t = 0; t < 16; ++t) { xrr[t + 1] = P[(size_t)(tok0 + t) * 2048 + c]; xkr[t + 1] = P[(size_t)(tok0 + t) * 2048 + 512 + c]; vfr[t] = l > 0 ? VF[(size_t)(tok0 + t) * 512 + c] : (bf16_t)0; }
#pragma unroll
    for (int t = 0; t < 16; ++t) {
        const size_t tok = tok0 + t;
        const float xr = bf2f(xrr[t + 1]), xk = bf2f(xkr[t + 1]), xpr = bf2f(xrr[t]), xpk = bf2f(xkr[t]);
        const float r = xr + (xpr - xr) * mu_r, k = xk + (xpk - xk) * mu_k;
        float v = sVx[c * 16 + t];
        const float z = -(w0 + wacc[t]);
        const float sp = fmaxf(z, 0.f) + __logf(1.0f + __expf(-fabsf(z)));
        const float decay = __expf(-__expf(-sp - 0.5f));
        const float a = sigmoidf_(a0 + aacc[t]);
        if (l == 0) VF[tok * 512 + c] = f2bf(v);
        else { const float vf = bf2f(vfr[t]); v = v + (vf - v) * sigmoidf_(v0 + vacc[t]); }
        float kk = k * k_k;
        const float ss = wave_sum(kk * kk);
        kk = kk * (1.0f / fmaxf(__builtin_sqrtf(ss), 1e-12f));
        const float km = k * (1.0f + (a - 1.0f) * k_a);
        R[tok * 512 + c] = f2bf(r); Kb[tok * 512 + c] = f2bf(km); Vb[tok * 512 + c] = f2bf(v);
        Ab[tok * 512 + c] = f2bf(-kk); Bb[tok * 512 + c] = f2bf(kk * a); Gb[tok * 512 + c] = f2bf(gacc[t]);
        Wb[tok * 512 + c] = decay;
    }
    __syncthreads();
}

#define SBM do { asm volatile("" ::: "memory"); __builtin_amdgcn_sched_barrier(0); } while (0)
#define RAW_BAR do { asm volatile("s_waitcnt lgkmcnt(0)" ::: "memory"); __builtin_amdgcn_s_barrier(); asm volatile("" ::: "memory"); } while (0)
DEVI void rwkv_scan(const Params& p, unsigned char* smem, int b) {
    int tid_ = threadIdx.x; asm volatile("" : "+v"(tid_)); size_t wz_ = 0; asm volatile("" : "+s"(wz_)); unsigned char* ws_ = p.ws + wz_;
    constexpr int CH = 16, NR = 8, NCH = S / CH;
    constexpr int VEC = NR * 9 * 64, SCL = NR * 4, VVN = NR * 64 * 2, BUF = VEC + SCL + VVN;
    const int head = b >> 2, quarter = b & 3, tid = tid_, wid = tid >> 6, lane = tid & 63;
    float* stg = (float*)smem;
    float* part = stg + 2 * BUF;
    int* sRole = (int*)(part + 2 * CH * 256);
    const bf16_t* R = (const bf16_t*)(ws_ + OFF_RWR); const bf16_t* Kb = (const bf16_t*)(ws_ + OFF_RWK); const bf16_t* Vb = (const bf16_t*)(ws_ + OFF_RWV);
    const bf16_t* Ab = (const bf16_t*)(ws_ + OFF_RWA); const bf16_t* Bb = (const bf16_t*)(ws_ + OFF_RWB);
    const float* Wb = (const float*)(ws_ + OFF_RWW); float* Y = (float*)(ws_ + OFF_RWY);
    if (lane == 0) sRole[wid] = (int)((__builtin_amdgcn_s_getreg(2308)) & 3);
    __syncthreads();
    int role = -1;
    {
        int simd[8];
#pragma unroll
        for (int w = 0; w < 8; ++w) simd[w] = sRole[w];
        unsigned used_simd = 0u, scan_mask = 0u; int nscan = 0;
#pragma unroll
        for (int w = 0; w < 8; ++w) { const unsigned bit = 1u << simd[w]; if (!(used_simd & bit) && nscan < 4) { used_simd |= bit; scan_mask |= 1u << w; ++nscan; } }
#pragma unroll
        for (int w = 0; w < 8; ++w) { if (!((scan_mask >> w) & 1u) && nscan < 4) { scan_mask |= 1u << w; ++nscan; } }
        const int below = __builtin_popcount(scan_mask & ((1u << wid) - 1u));
        role = ((scan_mask >> wid) & 1u) ? below : 4 + (wid - below);
    }
    role = __builtin_amdgcn_readfirstlane(role);
    __syncthreads();
    const bool helper = role >= 4;
    const int lt = (role - 4) * 64 + lane;
    const bool hvec = lt < 128;
    const int hr = (lt >> 4) & 7, hc = lt & 15;
    struct Pre { u32x2 r1, k1, a1, b1, r2, k2, a2, b2; f32x4 w1, w2; };
    auto issue = [&](int chunk, Pre& q) {
        const size_t o1 = (size_t)(chunk * CH + 2 * hr) * 512 + head * 64 + 4 * hc, o2 = o1 + 512;
        if (hvec) {
            q.r1 = *(const u32x2*)(R + o1); q.k1 = *(const u32x2*)(Kb + o1); q.a1 = *(const u32x2*)(Ab + o1); q.b1 = *(const u32x2*)(Bb + o1); q.w1 = *(const f32x4*)(Wb + o1);
            q.r2 = *(const u32x2*)(R + o2); q.k2 = *(const u32x2*)(Kb + o2); q.a2 = *(const u32x2*)(Ab + o2); q.b2 = *(const u32x2*)(Bb + o2); q.w2 = *(const f32x4*)(Wb + o2);
        } else { q.r1 = *(const u32x2*)(Vb + o1); q.r2 = *(const u32x2*)(Vb + o2); }
    };
    auto cv4 = [&](const u32x2& w) { f32x4 f; f[0] = __uint_as_float(w.x << 16); f[1] = __uint_as_float(w.x & 0xFFFF0000u); f[2] = __uint_as_float(w.y << 16); f[3] = __uint_as_float(w.y & 0xFFFF0000u); return f; };
    auto sum4 = [&](const f32x4& x) { return (x[0] + x[1]) + (x[2] + x[3]); };
    auto commit = [&](int bi, const Pre& q) {
        float* base = stg + bi * BUF;
        if (hvec) {
            const f32x4 r1 = cv4(q.r1), k1 = cv4(q.k1), a1 = cv4(q.a1), b1 = cv4(q.b1), r2 = cv4(q.r2), k2 = cv4(q.k2), a2 = cv4(q.a2), b2 = cv4(q.b2), w1 = q.w1, w2 = q.w2;
            float* vp = base + hr * (9 * 64) + 4 * hc;
            *(f32x4*)(vp + 0 * 64) = a1;
            *(f32x4*)(vp + 1 * 64) = w1 * a2;
            *(f32x4*)(vp + 2 * 64) = w1 * r1;
            *(f32x4*)(vp + 3 * 64) = w1 * w2;
            *(f32x4*)(vp + 4 * 64) = b1 * w2;
            *(f32x4*)(vp + 5 * 64) = k1 * w2;
            *(f32x4*)(vp + 6 * 64) = b2;
            *(f32x4*)(vp + 7 * 64) = k2;
            *(f32x4*)(vp + 8 * 64) = r2;
            const float be = row16_sum(sum4(b1 * a2)), ka = row16_sum(sum4(k1 * a2)), rb = row16_sum(sum4(b1 * r1)), rk = row16_sum(sum4(k1 * r1));
            if (hc == 0) *(f32x4*)(base + VEC + hr * 4) = (f32x4){be, ka, rb * (1.0f / 16.0f), rk * (1.0f / 16.0f)};
        } else {
            const f32x4 v1 = cv4(q.r1), v2 = cv4(q.r2);
            float* vv = base + VEC + SCL + (hr * 64 + 4 * hc) * 2;
            *(f32x4*)vv = (f32x4){v1[0], v2[0], v1[1], v2[1]}; *(f32x4*)(vv + 4) = (f32x4){v1[2], v2[2], v1[3], v2[3]};
        }
    };
    auto reduce_store = [&](int chunk) {
        const int t = lt >> 4, k = (lt >> 2) & 3, rr = lt & 3;
        const f32x4* pp = (const f32x4*)(part + ((chunk & 1) * CH + t) * 256 + k * 64 + rr * 16);
        const f32x4 s4 = pp[0] + pp[1] + pp[2] + pp[3];
        Y[(size_t)(chunk * CH + t) * 512 + head * 64 + quarter * 16 + k * 4 + rr] = (s4[0] + s4[1]) + (s4[2] + s4[3]);
    };
    Pre pr0, pr1, pr2, pr3;
    if (helper) { issue(0, pr0); commit(0, pr0); issue(1, pr1); issue(2, pr2); issue(3, pr3); }
    __syncthreads();
    const int row = quarter * 16 + role * 4 + (lane >> 4), cgp = (lane & 15) * 4;
    f32x2 s01 = {0.f, 0.f}, s23 = {0.f, 0.f};
    if (helper) {
        for (int c0 = 0; c0 < NCH; c0 += 4) {
#define RW_HELP(u, PNEXT, PCUR) { const int c = c0 + (u); if (c + 1 < NCH) commit((c + 1) & 1, PNEXT); if (c + 4 < NCH) issue(c + 4, PCUR); if (c > 0) reduce_store(c - 1); RAW_BAR; }
            RW_HELP(0, pr1, pr0) RW_HELP(1, pr2, pr1) RW_HELP(2, pr3, pr2) RW_HELP(3, pr0, pr3)
#undef RW_HELP
        }
    } else for (int chunk = 0; chunk < NCH; ++chunk) {
        {
            const float* bb = stg + (chunk & 1) * BUF;
            float* pw = part + (chunk & 1) * (CH * 256) + role * 64 + lane;
            f32x4 A1, A2, R1, WW, BW, KW, B2, K2, R2, SC; f32x2 VV;
            f32x4 A1n, A2n, R1n, WWn, BWn, KWn, B2n, K2n, R2n, SCn; f32x2 VVn;
            {
                const float* vp = bb + cgp;
                A1n = *(const f32x4*)(vp); A2n = *(const f32x4*)(vp + 64); R1n = *(const f32x4*)(vp + 128); WWn = *(const f32x4*)(vp + 192); BWn = *(const f32x4*)(vp + 256);
                KWn = *(const f32x4*)(vp + 320); B2n = *(const f32x4*)(vp + 384); K2n = *(const f32x4*)(vp + 448); R2n = *(const f32x4*)(vp + 512);
                SCn = *(const f32x4*)(bb + VEC); VVn = *(const f32x2*)(bb + VEC + SCL + row * 2);
            }
#pragma unroll
            for (int rd = 0; rd < NR; ++rd) {
                A1 = A1n; A2 = A2n; R1 = R1n; WW = WWn; BW = BWn; KW = KWn; B2 = B2n; K2 = K2n; R2 = R2n; SC = SCn; VV = VVn;
                const bool pf = (rd + 1 < NR);
                const float* vp = bb + (rd + 1) * (9 * 64) + cgp;
                const float v1 = VV[0], v2 = VV[1];
                const f32x2 p1 = s01 * (f32x2){A1[0], A1[1]} + s23 * (f32x2){A1[2], A1[3]};
                const f32x2 p2 = s01 * (f32x2){A2[0], A2[1]} + s23 * (f32x2){A2[2], A2[3]};
                const f32x2 p3 = s01 * (f32x2){R1[0], R1[1]} + s23 * (f32x2){R1[2], R1[3]};
                float sa1 = p1[0] + p1[1], u2 = p2[0] + p2[1];
                SBM;
                if (pf) { A1n = *(const f32x4*)(vp); A2n = *(const f32x4*)(vp + 64); }
                SBM;
                sa1 += dpp_f<0xB1>(sa1); u2 += dpp_f<0xB1>(u2);
                SBM;
                if (pf) { R1n = *(const f32x4*)(vp + 128); WWn = *(const f32x4*)(vp + 192); }
                f32x2 t01 = s01 * (f32x2){WW[0], WW[1]} + v1 * (f32x2){KW[0], KW[1]};
                SBM;
                sa1 += dpp_f<0x4E>(sa1); u2 += dpp_f<0x4E>(u2);
                SBM;
                if (pf) { BWn = *(const f32x4*)(vp + 256); KWn = *(const f32x4*)(vp + 320); }
                f32x2 t23 = s23 * (f32x2){WW[2], WW[3]} + v1 * (f32x2){KW[2], KW[3]};
                SBM;
                sa1 += dpp_f<0x141>(sa1); u2 += dpp_f<0x141>(u2);
                SBM;
                if (pf) { B2n = *(const f32x4*)(vp + 384); K2n = *(const f32x4*)(vp + 448); }
                t01 += v2 * (f32x2){K2[0], K2[1]}; t23 += v2 * (f32x2){K2[2], K2[3]};
                SBM;
                sa1 += dpp_f<0x140>(sa1); u2 += dpp_f<0x140>(u2);
                SBM;
                if (pf) { R2n = *(const f32x4*)(vp + 512); SCn = *(const f32x4*)(bb + VEC + (rd + 1) * 4); VVn = *(const f32x2*)(bb + VEC + SCL + ((rd + 1) * 64 + row) * 2); }
                const float sa2 = __builtin_fmaf(sa1, SC[0], __builtin_fmaf(v1, SC[1], u2));
                t01 += sa1 * (f32x2){BW[0], BW[1]}; t23 += sa1 * (f32x2){BW[2], BW[3]};
                pw[(2 * rd) * 256] = __builtin_fmaf(sa1, SC[2], __builtin_fmaf(v1, SC[3], p3[0] + p3[1]));
                s01 = t01 + sa2 * (f32x2){B2[0], B2[1]}; s23 = t23 + sa2 * (f32x2){B2[2], B2[3]};
                const f32x2 p4 = s01 * (f32x2){R2[0], R2[1]} + s23 * (f32x2){R2[2], R2[3]};
                pw[(2 * rd + 1) * 256] = p4[0] + p4[1];
            }
        }
        RAW_BAR;
    }
    if (helper) reduce_store(NCH - 1);
    __threadfence();
    __syncthreads();
}
#undef SBM
#undef RAW_BAR

DEVI void rwkv_post(const Params& p, int l, int bid, int nb) {
    int tid_ = threadIdx.x; asm volatile("" : "+v"(tid_)); size_t wz_ = 0; asm volatile("" : "+s"(wz_)); unsigned char* ws_ = p.ws + wz_;
    const int wid = tid_ >> 6, lane = tid_ & 63, c = wid * 64 + lane;
    const bf16_t* R = (const bf16_t*)(ws_ + OFF_RWR); const bf16_t* Kb = (const bf16_t*)(ws_ + OFF_RWK); const bf16_t* Vb = (const bf16_t*)(ws_ + OFF_RWV);
    const bf16_t* Gb = (const bf16_t*)(ws_ + OFF_RWG); const float* Y = (const float*)(ws_ + OFF_RWY);
    bf16_t* O = (bf16_t*)(ws_ + OFF_ORWKV);
    const float rk = ((const float*)p.in[18])[l * 512 + c], lw = ((const float*)p.in[19])[l * 512 + c], lb = ((const float*)p.in[20])[l * 512 + c];
    for (int tok = bid; tok < S; tok += nb) {
        const size_t o = (size_t)tok * 512 + c;
        const float y = Y[o], r = bf2f(R[o]), k = bf2f(Kb[o]), v = bf2f(Vb[o]), g = bf2f(Gb[o]);
        const float mean = wave_sum(y) * (1.0f / 64.0f);
        const float dv = y - mean;
        const float var = wave_sum(dv * dv) * (1.0f / 64.0f);
        const float yn = dv * rsqrtf(var + 64e-5f) * lw + lb;
        const float bonus = wave_sum(r * k * rk) * v;
        O[o] = f2bf((yn + bonus) * g);
    }
}

template <int NQ>
DEVI void attn_compute(const bf16x8 (&kf0)[4], const bf16x8 (&kf1)[4], const bf16x8 (&vf)[8],
                       const bf16x8 (&qf)[NQ][4], const unsigned (&vmask)[NQ], f32x4 (&o)[NQ][8], float (&m)[NQ], float (&l)[NQ]) {
#pragma unroll
    for (int q = 0; q < NQ; ++q) {
        f32x4 s0 = {0.f, 0.f, 0.f, 0.f}, s1 = {0.f, 0.f, 0.f, 0.f};
#pragma unroll
        for (int ks = 0; ks < 4; ++ks) {
            s0 = __builtin_amdgcn_mfma_f32_16x16x32_bf16(kf0[ks], qf[q][ks], s0, 0, 0, 0);
            s1 = __builtin_amdgcn_mfma_f32_16x16x32_bf16(kf1[ks], qf[q][ks], s1, 0, 0, 0);
        }
        float sv[8];
#pragma unroll
        for (int j = 0; j < 4; ++j) { sv[j] = ((vmask[q] >> j) & 1u) ? s0[j] : -1e30f; sv[4 + j] = ((vmask[q] >> (4 + j)) & 1u) ? s1[j] : -1e30f; }
        float cm = sv[0];
#pragma unroll
        for (int j = 1; j < 8; ++j) cm = fmaxf(cm, sv[j]);
        cm = fmaxf(cm, __shfl_xor(cm, 16)); cm = fmaxf(cm, __shfl_xor(cm, 32));
        const float mn = fmaxf(m[q], cm);
        const float alpha = __expf(m[q] - mn);
        m[q] = mn;
        float pr[8]; float ps = 0.f;
#pragma unroll
        for (int j = 0; j < 8; ++j) { pr[j] = __expf(sv[j] - mn); ps += pr[j]; }
        l[q] = l[q] * alpha + ps;
        union { u32x4 u; bf16x8 h; } pb;
        pb.u.x = cvt_pk_bf16(pr[0], pr[1]); pb.u.y = cvt_pk_bf16(pr[2], pr[3]); pb.u.z = cvt_pk_bf16(pr[4], pr[5]); pb.u.w = cvt_pk_bf16(pr[6], pr[7]);
#pragma unroll
        for (int dt = 0; dt < 8; ++dt) { o[q][dt] *= alpha; o[q][dt] = __builtin_amdgcn_mfma_f32_16x16x32_bf16(vf[dt], pb.h, o[q][dt], 0, 0, 0); }
    }
}
template <int NQ>
DEVI void attn_chunk(const bf16_t* k0p, const bf16_t* k1p, const bf16_t* vtp, size_t vt_stride16,
                     const bf16x8 (&qf)[NQ][4], const unsigned (&vmask)[NQ], f32x4 (&o)[NQ][8], float (&m)[NQ], float (&l)[NQ]) {
    bf16x8 kf0[4], kf1[4], vf[8];
#pragma unroll
    for (int ks = 0; ks < 4; ++ks) { kf0[ks] = *(const bf16x8*)(k0p + ks * 32); kf1[ks] = *(const bf16x8*)(k1p + ks * 32); }
#pragma unroll
    for (int dt = 0; dt < 8; ++dt) vf[dt] = *(const bf16x8*)(vtp + (size_t)dt * vt_stride16);
    attn_compute<NQ>(kf0, kf1, vf, qf, vmask, o, m, l);
}

DEVI void vtrans_tile(const Params& p, unsigned char* smem, int a, int ptile) {
    int tid_ = threadIdx.x; asm volatile("" : "+v"(tid_)); size_t wz_ = 0; asm volatile("" : "+s"(wz_)); unsigned char* ws_ = p.ws + wz_;
    const int dil = a < 2 ? 1 : (a < 4 ? 4 : (a < 6 ? 16 : 1));
    const int arr = a < 6 ? 12 + a : 26 + (a - 6);
    const bf16_t* V = (const bf16_t*)(ws_ + OFF_P2) + (size_t)arr * ((size_t)S * 128);
    bf16_t* VT = (bf16_t*)(ws_ + OFF_VT) + (size_t)a * ((size_t)S * 128);
    bf16_t* sT = (bf16_t*)smem;
    const int tid = tid_, p0 = ptile * 64, per = S / dil;
    {
        const int r = tid >> 3, seg = (tid & 7) * 16;
        const int pos = p0 + r, rho = pos / per, mm = pos % per, tok = mm * dil + rho;
        const u32x4 w0 = *(const u32x4*)(V + (size_t)tok * 128 + seg), w1 = *(const u32x4*)(V + (size_t)tok * 128 + seg + 8);
        unsigned* d = (unsigned*)(sT + r * 130 + seg);
        d[0] = w0.x; d[1] = w0.y; d[2] = w0.z; d[3] = w0.w; d[4] = w1.x; d[5] = w1.y; d[6] = w1.z; d[7] = w1.w;
    }
    __syncthreads();
    {
        const int dim = tid >> 2, part = (tid & 3) * 16;
        unsigned w[8];
#pragma unroll
        for (int i = 0; i < 8; ++i) w[i] = (unsigned)sT[(part + 2 * i) * 130 + dim] | ((unsigned)sT[(part + 2 * i + 1) * 130 + dim] << 16);
        u32x4 o0 = {w[0], w[1], w[2], w[3]}, o1 = {w[4], w[5], w[6], w[7]};
        bf16_t* dp = VT + (size_t)dim * S + p0 + part;
        *(u32x4*)dp = o0; *(u32x4*)(dp + 8) = o1;
    }
    __syncthreads();
}

DEVI void moba_kmean(const Params& p, unsigned char* smem, int item) {
    int tid_ = threadIdx.x; asm volatile("" : "+v"(tid_)); size_t wz_ = 0; asm volatile("" : "+s"(wz_)); unsigned char* ws_ = p.ws + wz_;
    const int head = item >> 6, nbk = item & 63, tid = tid_, d = tid & 127, tq = tid >> 7;
    const bf16_t* K = (const bf16_t*)(ws_ + OFF_P2) + (size_t)(22 + head) * ((size_t)S * 128);
    float* red = (float*)smem;
    float a = 0.f;
    for (int i = 0; i < 64; ++i) a += bf2f(K[(size_t)(nbk * 256 + tq * 64 + i) * 128 + d]);
    red[tq * 128 + d] = a;
    __syncthreads();
    if (tid < 128) ((float*)(ws_ + OFF_KM))[(size_t)item * 128 + tid] = (red[tid] + red[128 + tid] + red[256 + tid] + red[384 + tid]) * (1.0f / 256.0f);
    __syncthreads();
}

#define TOP3_INSERT(v, i, v1, v2, v3, i1, i2, i3) do { const float _v = (v); const int _i = (i); \
    const bool _g1 = _v > v1, _g2 = _v > v2, _g3 = _v > v3; \
    const float _n3 = _g2 ? v2 : (_g3 ? _v : v3); const int _m3 = _g2 ? i2 : (_g3 ? _i : i3); \
    const float _n2 = _g1 ? v1 : (_g2 ? _v : v2); const int _m2 = _g1 ? i1 : (_g2 ? _i : i2); \
    const float _n1 = _g1 ? _v : v1; const int _m1 = _g1 ? _i : i1; \
    v1 = _n1; v2 = _n2; v3 = _n3; i1 = _m1; i2 = _m2; i3 = _m3; } while (0)

DEVI void moba_gate(const Params& p, unsigned char* smem, int item) {
    int tid_ = threadIdx.x; asm volatile("" : "+v"(tid_)); size_t wz_ = 0; asm volatile("" : "+s"(wz_)); unsigned char* ws_ = p.ws + wz_;
    const int head = item >> 6, qb = item & 63, cur = qb, tid = tid_;
    unsigned long long* sel = (unsigned long long*)(ws_ + OFF_SEL) + (size_t)head * S + qb * 256;
    unsigned* sQ = (unsigned*)smem;
    float* sKm = (float*)(smem + 256 * 65 * 4);
    const bf16_t* Q = (const bf16_t*)(ws_ + OFF_P2) + (size_t)(18 + head) * ((size_t)S * 128) + (size_t)qb * 256 * 128;
    for (int e = tid; e < 256 * 64; e += NT) sQ[(e >> 6) * 65 + (e & 63)] = ((const unsigned*)Q)[e];
    const float* KM = (const float*)(ws_ + OFF_KM) + (size_t)head * 64 * 128;
    for (int e = tid; e < cur * 128; e += NT) sKm[e] = KM[e];
    __syncthreads();
    const int q = tid >> 1, part = tid & 1;
    float v1 = -INFINITY, v2 = -INFINITY, v3 = -INFINITY; int i1 = -1, i2 = -1, i3 = -1;
    for (int n = part; n < cur; n += 2) {
        float dot = 0.f;
#pragma unroll 4
        for (int w = 0; w < 64; ++w) {
            const unsigned qq = sQ[q * 65 + w];
            dot += __uint_as_float(qq << 16) * sKm[n * 128 + 2 * w] + __uint_as_float(qq & 0xFFFF0000u) * sKm[n * 128 + 2 * w + 1];
        }
        TOP3_INSERT(dot, n, v1, v2, v3, i1, i2, i3);
    }
    const float pv1 = __shfl_xor(v1, 1), pv2 = __shfl_xor(v2, 1), pv3 = __shfl_xor(v3, 1);
    const int pi1 = __shfl_xor(i1, 1), pi2 = __shfl_xor(i2, 1), pi3 = __shfl_xor(i3, 1);
    TOP3_INSERT(pv1, pi1, v1, v2, v3, i1, i2, i3);
    TOP3_INSERT(pv2, pi2, v1, v2, v3, i1, i2, i3);
    TOP3_INSERT(pv3, pi3, v1, v2, v3, i1, i2, i3);
    unsigned long long mk = 0ull;
    if (i1 >= 0) mk |= 1ull << i1;
    if (i2 >= 0) mk |= 1ull << i2;
    if (i3 >= 0) mk |= 1ull << i3;
    if (part == 0) sel[q] = mk;
    __syncthreads();
}

constexpr int MB_KROW = 272, MB_VROW = 144, MB_KBYTES = 64 * MB_KROW, MB_BUF = MB_KBYTES + 128 * MB_VROW;
DEVI void moba_attn(const Params& p, unsigned char* smem, int item) {
    int tid_ = threadIdx.x; asm volatile("" : "+v"(tid_)); size_t wz_ = 0; asm volatile("" : "+s"(wz_)); unsigned char* ws_ = p.ws + wz_;
    const int head = item & 3, qb = 63 - (item >> 2);
    const int tid = tid_, wid = tid >> 6, lane = tid & 63, li = lane & 15, g = lane >> 4;
    LAS unsigned char* lds = (LAS unsigned char*)smem;
    const bf16_t* Q = (const bf16_t*)(ws_ + OFF_P2) + (size_t)(18 + head) * ((size_t)S * 128);
    const bf16_t* K = (const bf16_t*)(ws_ + OFF_P2) + (size_t)(22 + head) * ((size_t)S * 128);
    const bf16_t* VT = (const bf16_t*)(ws_ + OFF_VT) + (size_t)(6 + head) * ((size_t)S * 128);
    const unsigned long long* sel = (const unsigned long long*)(ws_ + OFF_SEL) + (size_t)head * S;
    const int qbase = qb * 256 + wid * 32;
    bf16x8 qf[2][4]; unsigned long long sm[2]; f32x4 o[2][8]; float m[2], l[2];
#pragma unroll
    for (int qt = 0; qt < 2; ++qt) {
        const int qi = qbase + qt * 16 + li;
#pragma unroll
        for (int ks = 0; ks < 4; ++ks) qf[qt][ks] = *(const bf16x8*)(Q + (size_t)qi * 128 + ks * 32 + g * 8);
        sm[qt] = sel[qi]; m[qt] = -1e30f; l[qt] = 0.f;
#pragma unroll
        for (int dt = 0; dt < 8; ++dt) o[qt][dt] = (f32x4){0.f, 0.f, 0.f, 0.f};
    }
    const int krow_s = tid >> 3, kseg = (tid & 7) * 16;
    const int vdim_s = tid >> 2, vpart = (tid & 3) * 16;
    u32x4 rk0, rk1, rv0, rv1;
    auto issue = [&](int st) {
        const bf16_t* kp = K + (size_t)(st * 64 + krow_s) * 128 + kseg;
        rk0 = *(const u32x4*)kp; rk1 = *(const u32x4*)(kp + 8);
        const bf16_t* vp = VT + (size_t)vdim_s * S + st * 64 + vpart;
        rv0 = *(const u32x4*)vp; rv1 = *(const u32x4*)(vp + 8);
    };
    auto commit = [&](int bi) {
        LAS unsigned char* kb = lds + bi * MB_BUF + krow_s * MB_KROW + kseg * 2;
        *(LAS u32x4*)kb = rk0; *(LAS u32x4*)(kb + 16) = rk1;
        LAS unsigned char* vb = lds + bi * MB_BUF + MB_KBYTES + vdim_s * MB_VROW + vpart * 2;
        *(LAS u32x4*)vb = rv0; *(LAS u32x4*)(vb + 16) = rv1;
    };
    const int nst = (qb + 1) * 4;
    issue(0); commit(0);
    __syncthreads();
    const int krow = 8 * (li >> 2) + (li & 3);
    for (int st = 0; st < nst; ++st) {
        if (st + 1 < nst) issue(st + 1);
        const int n = st >> 2;
        LAS unsigned char* kb = lds + (st & 1) * MB_BUF;
        LAS unsigned char* vb = kb + MB_KBYTES;
#pragma unroll
        for (int c = 0; c < 2; ++c) {
            const int c0 = st * 64 + c * 32;
            unsigned vm[2];
            if (n < qb) { vm[0] = ((sm[0] >> n) & 1ull) ? 0xFFu : 0u; vm[1] = ((sm[1] >> n) & 1ull) ? 0xFFu : 0u; }
            else {
#pragma unroll
                for (int qt = 0; qt < 2; ++qt) {
                    const int qpos = qbase + qt * 16 + li; unsigned mk = 0u;
#pragma unroll
                    for (int j = 0; j < 8; ++j) { const int key = c0 + 8 * g + (j & 3) + 4 * (j >> 2); mk |= (key <= qpos) ? (1u << j) : 0u; }
                    vm[qt] = mk;
                }
            }
            if (__ballot((vm[0] | vm[1]) != 0u) != 0ull) {
                bf16x8 kf0[4], kf1[4], vf[8];
#pragma unroll
                for (int ks = 0; ks < 4; ++ks) {
                    kf0[ks] = *(const LAS bf16x8*)(kb + (c * 32 + krow) * MB_KROW + (ks * 32 + g * 8) * 2);
                    kf1[ks] = *(const LAS bf16x8*)(kb + (c * 32 + krow + 4) * MB_KROW + (ks * 32 + g * 8) * 2);
                }
#pragma unroll
                for (int dt = 0; dt < 8; ++dt) vf[dt] = *(const LAS bf16x8*)(vb + (16 * dt + li) * MB_VROW + (c * 32 + 8 * g) * 2);
                attn_compute<2>(kf0, kf1, vf, qf, vm, o, m, l);
            }
        }
        if (st + 1 < nst) commit((st + 1) & 1);
        __syncthreads();
    }
    bf16_t* O = (bf16_t*)(ws_ + OFF_OMOBA);
#pragma unroll
    for (int qt = 0; qt < 2; ++qt) {
        float lt = l[qt]; lt += __shfl_xor(lt, 16); lt += __shfl_xor(lt, 32);
        const float inv = 1.0f / lt;
        const int qi = qbase + qt * 16 + li;
#pragma unroll
        for (int dt = 0; dt < 8; ++dt) {
            const f32x4 v = o[qt][dt] * inv;
            u32x2 w; w.x = cvt_pk_bf16(v[0], v[1]); w.y = cvt_pk_bf16(v[2], v[3]);
            *(u32x2*)(O + (size_t)qi * 512 + head * 128 + dt * 16 + 4 * g) = w;
        }
    }
}

DEVI void dil_attn(const Params& p, int item) {
    int tid_ = threadIdx.x; asm volatile("" : "+v"(tid_)); size_t wz_ = 0; asm volatile("" : "+s"(wz_)); unsigned char* ws_ = p.ws + wz_;
    const int hp = item & 1, T0 = (item >> 1) * 256;
    const int tid = tid_, wid = tid >> 6, lane = tid & 63, li = lane & 15, g = lane >> 4;
    const int krow = 8 * (li >> 2) + (li & 3);
    bf16_t* O = (bf16_t*)(ws_ + OFF_ODIL);
    for (int rr = 0; rr < 2; ++rr) {
        const int rho16 = 2 * wid + rr;
        const int tq = T0 + rho16 + 16 * li;
        f32x4 o[1][8]; float m[1], l[1];
        m[0] = -1e30f; l[0] = 0.f;
#pragma unroll
        for (int dt = 0; dt < 8; ++dt) o[0][dt] = (f32x4){0.f, 0.f, 0.f, 0.f};
        for (int gi = 0; gi < 3; ++gi) {
            const int dil = gi == 0 ? 1 : (gi == 1 ? 4 : 16);
            const int head = 2 * gi + hp, per = S / dil;
            const bf16_t* Q = (const bf16_t*)(ws_ + OFF_P2) + (size_t)(head) * ((size_t)S * 128);
            const bf16_t* K = (const bf16_t*)(ws_ + OFF_P2) + (size_t)(6 + head) * ((size_t)S * 128);
            const bf16_t* VT = (const bf16_t*)(ws_ + OFF_VT) + (size_t)head * ((size_t)S * 128);
            bf16x8 qf[1][4];
#pragma unroll
            for (int ks = 0; ks < 4; ++ks) qf[0][ks] = *(const bf16x8*)(Q + (size_t)tq * 128 + ks * 32 + g * 8);
            const int rho = rho16 % dil;
            const int qm = tq / dil;
            const int qm0 = (T0 + rho16) / dil, qm15 = (T0 + rho16 + 240) / dil;
            const int lo = qm0 - 128;
            int c0 = (lo >> 5) << 5;
            if (c0 < 0) c0 = (c0 < -32) ? 0 : c0;
            if (lo < 0 && c0 < 0 && c0 + 31 < 0) c0 = 0;
            for (; c0 <= qm15; c0 += 32) {
                unsigned vm[1]; unsigned mk = 0u;
#pragma unroll
                for (int j = 0; j < 8; ++j) { const int kap = c0 + 8 * g + (j & 3) + 4 * (j >> 2); mk |= (kap >= 0 && kap <= qm && qm - kap <= 128) ? (1u << j) : 0u; }
                vm[0] = mk;
                int ka0 = c0 + krow, ka1 = ka0 + 4;
                ka0 = ka0 < 0 ? 0 : (ka0 > per - 1 ? per - 1 : ka0); ka1 = ka1 < 0 ? 0 : (ka1 > per - 1 ? per - 1 : ka1);
                int sg = c0 + 8 * g; sg = sg < 0 ? 0 : (sg > per - 8 ? per - 8 : sg);
                const bf16_t* k0p = K + (size_t)(ka0 * dil + rho) * 128 + g * 8;
                const bf16_t* k1p = K + (size_t)(ka1 * dil + rho) * 128 + g * 8;
                attn_chunk<1>(k0p, k1p, VT + (size_t)li * S + (size_t)rho * per + sg, (size_t)16 * S, qf, vm, o, m, l);
            }
        }
        float lt = l[0]; lt += __shfl_xor(lt, 16); lt += __shfl_xor(lt, 32);
        const float inv = 1.0f / lt;
#pragma unroll
        for (int dt = 0; dt < 8; ++dt) {
            const f32x4 v = o[0][dt] * inv;
            u32x2 w; w.x = cvt_pk_bf16(v[0], v[1]); w.y = cvt_pk_bf16(v[2], v[3]);
            *(u32x2*)(O + (size_t)tq * 256 + hp * 128 + dt * 16 + 4 * g) = w;
        }
    }
}

DEVI void sub_barrier(unsigned* ctr, unsigned target) {
    __threadfence();
    __syncthreads();
    if (threadIdx.x == 0) {
        __threadfence();
        __hip_atomic_fetch_add(ctr, 1u, __ATOMIC_RELEASE, __HIP_MEMORY_SCOPE_AGENT);
        while (__hip_atomic_load(ctr, __ATOMIC_ACQUIRE, __HIP_MEMORY_SCOPE_AGENT) < target) __builtin_amdgcn_s_sleep(8);
        __threadfence();
    }
    __syncthreads();
}
#ifndef PHASE_MASK
#define PHASE_MASK 0xFFFFFFFFu
#endif
#define PH(k) ((PHASE_MASK >> (k)) & 1u)
#ifndef PROBE_MASK
#define PROBE_MASK 0u
#endif
#define REPS(k) (1 + (int)((PROBE_MASK >> (k)) & 1u))
__global__ void __launch_bounds__(512, 2) fwd_megakernel(Params p) {
    extern __shared__ __attribute__((aligned(16))) unsigned char smem[];
    cg::grid_group grid = cg::this_grid();
    const int bid = blockIdx.x, nb = gridDim.x;
    unsigned char* ws = p.ws;
    const float* mod = (const float*)(ws + OFF_MOD);

    if (bid == 0 && threadIdx.x < 4) ((unsigned*)(ws + OFF_BAR))[threadIdx.x * 64] = 0u;
    if (PH(0)) phase_mod_rope(p, smem, bid, nb);
    __syncthreads();
    for (int rep = 0; rep < REPS(5); ++rep) if (PH(1)) phase_convert(p, 0, smem, bid, nb);
    grid.sync();

    for (int l = 0; l < NL; ++l) {
        const float* ml = mod + l * 12288;
        const float* xin = (l == 0) ? (const float*)p.in[0] : p.out;
        for (int rep = 0; rep < REPS(4); ++rep) if (PH(2)) phase_norm(xin, (const float*)p.in[5] + l * D, ml, ml + 2048, (bf16_t*)(ws + OFF_H), bid, nb);
        for (int rep = 0; rep < REPS(5); ++rep) if (PH(1) && l > 0) phase_convert(p, l, smem, bid, nb);
        grid.sync();
        {
            EpiInProj E; E.G = (bf16_t*)(ws + OFF_G); E.P1G = (bf16_t*)(ws + OFF_P1G); E.P1R = (bf16_t*)(ws + OFF_P1R); E.P2 = (bf16_t*)(ws + OFF_P2);
            E.cosT = (const float*)(ws + OFF_COS); E.sinT = (const float*)(ws + OFF_SIN);
            for (int rep = 0; rep < REPS(0); ++rep) if (PH(3)) run_gemm(smem, (const bf16_t*)(ws + OFF_H), (const bf16_t*)(ws + OFF_WIN), IN_PAD, D, E);
        }
        grid.sync();
        for (int it = bid; it < 1024; it += nb) rwkv_prep(p, l, smem, it);
        grid.sync();
        if (bid < 32) rwkv_scan(p, smem, bid);
        else {
            const int b2 = bid - 32, nb2 = nb - 32;
            unsigned* ctr = (unsigned*)(ws + OFF_BAR) + l * 128;
            for (int it = b2; it < 1024 + 256 + 2560; it += nb2) {
                if (it < 1024) gla_pass1(p, l, smem, it);
                else if (it < 1280) moba_kmean(p, smem, it - 1024);
                else { const int j = it - 1280; vtrans_tile(p, smem, j >> 8, j & 255); }
            }
            sub_barrier(ctr, (unsigned)nb2);
            for (int it = b2; it < 64 + 256; it += nb2) {
                if (it < 64) gla_pass2(p, it);
                else moba_gate(p, smem, it - 64);
            }
            sub_barrier(ctr + 64, (unsigned)nb2);
            for (int it = b2; it < 256 + 128 + 1024; it += nb2) {
                if (it < 256) moba_attn(p, smem, it);
                else if (it < 384) dil_attn(p, it - 256);
                else gla_pass3(p, l, smem, it - 384);
            }
        }
        grid.sync();
        if (PH(14)) rwkv_post(p, l, bid, nb);
        grid.sync();
        {
            EpiBranch E; E.Mg = (bf16_t*)(ws + OFF_MERGED);
            E.Gb = (const bf16_t*)(ws + OFF_G); E.first = 1;
            if (PH(15)) run_gemm(smem, (const bf16_t*)(ws + OFF_OGLA), (const bf16_t*)(ws + OFF_WBA), D, 512, E);
            E.Gb = (const bf16_t*)(ws + OFF_G) + 2048; E.first = 0;
            if (PH(15)) run_gemm(smem, (const bf16_t*)(ws + OFF_ODIL), (const bf16_t*)(ws + OFF_WBB), D, 256, E);
            E.Gb = (const bf16_t*)(ws + OFF_G) + 4096;
            if (PH(15)) run_gemm(smem, (const bf16_t*)(ws + OFF_ORWKV), (const bf16_t*)(ws + OFF_WBC), D, 512, E);
            E.Gb = (const bf16_t*)(ws + OFF_G) + 6144;
            if (PH(15)) run_gemm(smem, (const bf16_t*)(ws + OFF_OMOBA), (const bf16_t*)(ws + OFF_WBD), D, 512, E);
        }
        grid.sync();
        {
            EpiResid E; E.src = xin; E.dst = p.out; E.gate = ml + 4096;
            if (PH(16)) run_gemm(smem, (const bf16_t*)(ws + OFF_MERGED), (const bf16_t*)(ws + OFF_WOUT), D, D, E);
        }
        grid.sync();
        for (int rep = 0; rep < REPS(4); ++rep) if (PH(2)) phase_norm(p.out, (const float*)p.in[29] + l * D, ml + 6144, ml + 8192, (bf16_t*)(ws + OFF_H), bid, nb);
        grid.sync();
        {
            EpiSwiglu E; E.act = (bf16_t*)(ws + OFF_ACT);
            for (int rep = 0; rep < REPS(1); ++rep) if (PH(17)) run_gemm(smem, (const bf16_t*)(ws + OFF_H), (const bf16_t*)(ws + OFF_WF1), 2 * FFN_H, D, E);
        }
        grid.sync();
        {
            EpiResid E; E.src = p.out; E.dst = p.out; E.gate = ml + 10240;
            if (PH(16)) run_gemm(smem, (const bf16_t*)(ws + OFF_ACT), (const bf16_t*)(ws + OFF_WF2), D, FFN_H, E);
        }
        grid.sync();
    }
    if (PH(18)) phase_final_norm(p.out, (const float*)p.in[32], bid, nb);
}

extern "C" void kernel_launch(void* const* d_in, const int* in_sizes, int n_in, void* d_out, int out_size, void* d_ws, size_t ws_size, hipStream_t stream) {
    static int grid_blocks = 0;
    if (grid_blocks == 0) {
        if (n_in != 33 || ws_size < WS_END) { fprintf(stderr, "kernel_launch: unexpected n_in %d or ws_size %zu (< %zu)\n", n_in, ws_size, (size_t)WS_END); grid_blocks = -1; return; }
        int dev = 0, cus = 0, per_cu = 0;
        hipGetDevice(&dev);
        hipDeviceGetAttribute(&cus, hipDeviceAttributeMultiprocessorCount, dev);
        if (hipFuncSetAttribute((const void*)fwd_megakernel, hipFuncAttributeMaxDynamicSharedMemorySize, LDS_BYTES) != hipSuccess) { fprintf(stderr, "kernel_launch: hipFuncSetAttribute failed\n"); grid_blocks = -1; return; }
        hipOccupancyMaxActiveBlocksPerMultiprocessor(&per_cu, (const void*)fwd_megakernel, NT, LDS_BYTES);
        if (per_cu < 1) { fprintf(stderr, "kernel_launch: occupancy query says 0 blocks per CU\n"); per_cu = 1; }
        grid_blocks = cus * 1;
        (void)hipGetLastError();
    }
    if (grid_blocks < 0) return;
    Params p{};
    for (int i = 0; i < 33; ++i) p.in[i] = d_in[i];
    p.out = (float*)d_out; p.ws = (unsigned char*)d_ws;
    void* args[] = {&p};
    hipError_t e = hipLaunchCooperativeKernel((const void*)fwd_megakernel, dim3(grid_blocks), dim3(NT), args, LDS_BYTES, stream);
    if (e != hipSuccess) fprintf(stderr, "cooperative launch failed: %s (grid %d)\n", hipGetErrorString(e), grid_blocks);
}
```

```cpp
#include <hip/hip_runtime.h>
#include <hip/hip_cooperative_groups.h>
#include <cstdio>
#include <cstdint>
namespace cg = cooperative_groups;

typedef unsigned short bf16_t;
typedef short bf16x8 __attribute__((ext_vector_type(8)));
typedef float f32x4 __attribute__((ext_vector_type(4)));
typedef float f32x2 __attribute__((ext_vector_type(2)));
typedef unsigned u32x4 __attribute__((ext_vector_type(4)));
typedef unsigned u32x2 __attribute__((ext_vector_type(2)));
#define LAS __attribute__((address_space(3)))
#define DEVI __device__ __forceinline__

constexpr int S = 16384, D = 2048, NL = 2;
constexpr int IN_TOTAL = 15568, IN_PAD = 15872;
constexpr int FFN_H = 5632;
constexpr int NT = 512;
constexpr int LDS_BYTES = 131072;

constexpr size_t SZ_HEADARR = (size_t)S * 128 * 2;
constexpr size_t OFF_WIN = 0;
constexpr size_t OFF_WBA = OFF_WIN + (size_t)IN_PAD * D * 2;
constexpr size_t OFF_WBB = OFF_WBA + (size_t)D * 512 * 2;
constexpr size_t OFF_WBC = OFF_WBB + (size_t)D * 256 * 2;
constexpr size_t OFF_WBD = OFF_WBC + (size_t)D * 512 * 2;
constexpr size_t OFF_WOUT = OFF_WBD + (size_t)D * 512 * 2;
constexpr size_t OFF_WF1 = OFF_WOUT + (size_t)D * D * 2;
constexpr size_t OFF_WF2 = OFF_WF1 + (size_t)2 * FFN_H * D * 2;
constexpr size_t WB_END = OFF_WF2 + (size_t)D * FFN_H * 2;
constexpr size_t OFF_VT = OFF_WIN;
constexpr size_t OFF_G = WB_END;
constexpr size_t OFF_P1G = OFF_G + (size_t)S * 8192 * 2;
constexpr size_t OFF_P1R = OFF_P1G + (size_t)S * 1792 * 2;
constexpr size_t OFF_P2 = OFF_P1R + (size_t)S * 2048 * 2;
constexpr size_t OFF_ACT = OFF_P1G;
constexpr size_t OFF_H = OFF_P2 + 30 * SZ_HEADARR;
constexpr size_t OFF_OGLA = OFF_H;
constexpr size_t OFF_ODIL = OFF_OGLA + (size_t)S * 512 * 2;
constexpr size_t OFF_ORWKV = OFF_ODIL + (size_t)S * 256 * 2;
constexpr size_t OFF_OMOBA = OFF_ORWKV + (size_t)S * 512 * 2;
constexpr size_t OFF_X = OFF_H + (size_t)S * D * 2;
constexpr size_t SZ_B512 = (size_t)S * 512 * 2;
constexpr size_t OFF_RWR = OFF_X;
constexpr size_t OFF_RWK = OFF_RWR + SZ_B512;
constexpr size_t OFF_RWV = OFF_RWK + SZ_B512;
constexpr size_t OFF_RWA = OFF_RWV + SZ_B512;
constexpr size_t OFF_RWB = OFF_RWA + SZ_B512;
constexpr size_t OFF_RWG = OFF_RWB + SZ_B512;
constexpr size_t OFF_RWW = OFF_RWG + SZ_B512;
constexpr size_t OFF_RWY = OFF_RWW + (size_t)S * 512 * 4;
constexpr size_t OFF_GLL = OFF_RWY + (size_t)S * 512 * 4;
constexpr size_t OFF_GLB = OFF_GLL + (size_t)256 * 4 * 64 * 128 * 4;
constexpr size_t OFF_GLD = OFF_GLB + (size_t)S * 256 * 4;
constexpr size_t OFF_MERGED = OFF_X;
constexpr size_t OFF_VF = OFF_GLD + (size_t)256 * 4 * 64 * 4;
constexpr size_t OFF_MOD = OFF_VF + SZ_B512;
constexpr size_t OFF_COS = OFF_MOD + (size_t)2 * 12288 * 4;
constexpr size_t OFF_SIN = OFF_COS + (size_t)S * 16 * 4;
constexpr size_t OFF_KM = OFF_SIN + (size_t)S * 16 * 4;
constexpr size_t OFF_SEL = OFF_KM + (size_t)4 * 64 * 128 * 4;
constexpr size_t OFF_LORA = OFF_SEL + (size_t)4 * S * 8;
constexpr size_t OFF_BAR = OFF_LORA + (size_t)512 * 448 * 2;
constexpr size_t WS_END = OFF_BAR + 4 * 256;

struct Params {
    const void* in[33];
    float* out;
    unsigned char* ws;
};

DEVI float bf2f(bf16_t b) { return __uint_as_float(((unsigned)b) << 16); }
typedef __bf16 bf16x2_t __attribute__((ext_vector_type(2)));
DEVI unsigned cvt_pk_bf16(float lo, float hi) {
    const f32x2 v = {lo, hi}; const bf16x2_t r = __builtin_convertvector(v, bf16x2_t); return __builtin_bit_cast(unsigned, r);
}
DEVI bf16_t f2bf(float f) { return (bf16_t)cvt_pk_bf16(f, 0.f); }
DEVI float sigmoidf_(float x) { return __builtin_amdgcn_rcpf(1.0f + __expf(-x)); }
DEVI float siluf_(float x) { return x * __builtin_amdgcn_rcpf(1.0f + __expf(-x)); }
DEVI float wave_sum(float v) {
#pragma unroll
    for (int o = 32; o >= 1; o >>= 1) v += __shfl_xor(v, o);
    return v;
}
template <int CTRL> DEVI float dpp_f(float v) { return __int_as_float(__builtin_amdgcn_update_dpp(0, __float_as_int(v), CTRL, 0xF, 0xF, true)); }
DEVI float row16_sum(float v) {
    v += dpp_f<0xB1>(v);
    v += dpp_f<0x4E>(v);
    v += dpp_f<0x141>(v);
    v += dpp_f<0x140>(v);
    return v;
}

namespace pg8 {
constexpr int BM = 256, BK = 64, HALF = 128, HTB = HALF * BK * 2, STAGE_BYTES = 8 * HTB, NXCD = 8, WGM = 8;
DEVI int lds_byte(int r, int c) { const int st = (r >> 4) * 2 + (c >> 5), rr = r & 15, cc = c & 31, ob = rr * 64 + cc * 2; return st * 1024 + (ob ^ (((ob >> 9) & 1) << 5)); }
DEVI void stage_rc(int b, int& R, int& C) { const int st = b / 1024, sb = b % 1024, swz = sb ^ (((sb >> 9) & 1) << 5); R = (st >> 1) * 16 + swz / 64; C = (st & 1) * 32 + (swz % 64) / 2; }
DEVI int perm32(int rho) { const int n = rho >> 4, i = rho & 15; return 8 * (i >> 2) + 4 * n + (i & 3); }
struct Unit { int pm, pn; };
struct Gemm { const bf16_t* A; const bf16_t* Bt; int M, N, K; };
struct StaticOrder {
    int nM, nN, nwg, G, c;
    DEVI void init(int M, int N, int G_, int c_) { nM = M / BM; nN = N / BM; nwg = nM * nN; G = G_; c = c_; }
    DEVI bool next(int i, Unit& u) const {
        const long L = (long)i * G + c; if (L >= nwg) return false;
        int wgid = (int)L; { const int q = nwg / NXCD, r = nwg % NXCD, xcd = wgid % NXCD, off = wgid / NXCD; wgid = (xcd < r ? xcd * (q + 1) : r * (q + 1) + (xcd - r) * q) + off; }
        const int nig = WGM * nN, gid = wgid / nig, fm = gid * WGM, gsz = (nM - fm) < WGM ? (nM - fm) : WGM;
        u.pm = fm + ((wgid % nig) % gsz); u.pn = (wgid % nig) / gsz; return true;
    }
};
template <class Epi>
DEVI void gemm_phase(LAS unsigned char* lds, const Gemm g, const StaticOrder& S_, const Epi& E) {
    int tid_ = threadIdx.x; asm volatile("" : "+v"(tid_));
    int K_ = g.K; asm volatile("" : "+s"(K_));
    const int tid = tid_, wid = __builtin_amdgcn_readfirstlane(tid >> 6), lane = tid & 63, wr = wid >> 2, wc = wid & 3, fr = lane & 15, fq = lane >> 4;
    const int K = K_, nt = K / BK;
    unsigned voffA[2], voffB[2];
#pragma unroll
    for (int i = 0; i < 2; ++i) { int R, C; stage_rc(tid * 16 + i * 8192, R, C); const int Rb = (R & ~31) + perm32(R & 31);
        voffA[i] = (unsigned)(R * K + C) * 2u; voffB[i] = (unsigned)(Rb * K + C) * 2u; }
    const size_t kstep = (size_t)(BK * 2);
    const size_t hstep = (size_t)HALF * K * 2;
    const size_t tstep = 2 * hstep;
    const unsigned ldsw = (unsigned)wid * 1024u;
    const int aoff = lds_byte(wr * 64 + fr, fq * 8), boff = lds_byte(wc * 32 + fr, fq * 8);
#define PG8_SA(b, h) (((b) * 2 + (h)) * HTB)
#define PG8_SB(b, h) ((4 + (b) * 2 + (h)) * HTB)
#define PG8_STAGE(bufoff, gbase, voff) do { _Pragma("unroll") for (int _i = 0; _i < 2; ++_i) \
        __builtin_amdgcn_global_load_lds((const unsigned*)((const char*)(gbase) + (voff)[_i]), (LAS unsigned*)(lds + (bufoff) + ldsw + _i * 8192), 16, 0, 0); } while (0)
#define PG8_LDA(dst, b, h) do { _Pragma("unroll") for (int m = 0; m < 4; ++m) _Pragma("unroll") for (int k = 0; k < 2; ++k) dst[m][k] = *(const LAS bf16x8*)(lds + PG8_SA(b, h) + aoff + m * 2048 + k * 1024); } while (0)
#define PG8_LDB(dst, b, h) do { _Pragma("unroll") for (int n = 0; n < 2; ++n) _Pragma("unroll") for (int k = 0; k < 2; ++k) dst[n][k] = *(const LAS bf16x8*)(lds + PG8_SB(b, h) + boff + n * 2048 + k * 1024); } while (0)
#define PG8_MMA(ai, bj, At, Bt) do { __builtin_amdgcn_s_setprio(1); _Pragma("unroll") for (int m = 0; m < 4; ++m) _Pragma("unroll") for (int n = 0; n < 2; ++n) _Pragma("unroll") for (int k = 0; k < 2; ++k) \
        acc[ai][bj][m][n] = __builtin_amdgcn_mfma_f32_16x16x32_bf16(Bt[n][k], At[m][k], acc[ai][bj][m][n], 0, 0, 0); __builtin_amdgcn_s_setprio(0); } while (0)
#define PG8_WAIT_V(n) asm volatile("s_waitcnt vmcnt(" #n ")" ::: "memory")
#define PG8_WAIT_L(n) asm volatile("s_waitcnt lgkmcnt(" #n ")" ::: "memory")
#define PG8_BAR __builtin_amdgcn_s_barrier()
#define PG8_SCHED __builtin_amdgcn_sched_barrier(0)
    Unit cur, nxt; int ui = 0;
    if (!S_.next(0, cur)) return;
    f32x4 acc[2][2][4][2];
#pragma unroll
    for (int a = 0; a < 2; ++a)
#pragma unroll
        for (int b = 0; b < 2; ++b)
#pragma unroll
            for (int m = 0; m < 4; ++m)
#pragma unroll
                for (int n = 0; n < 2; ++n) acc[a][b][m][n] = (f32x4){0.f, 0.f, 0.f, 0.f};
    bf16x8 At[4][2], B0[2][2], B1[2][2];
    const char* cA = (const char*)g.A + (size_t)cur.pm * tstep; const char* cB = (const char*)g.Bt + (size_t)cur.pn * tstep;
    PG8_STAGE(PG8_SB(0, 0), cB, voffB); PG8_STAGE(PG8_SA(0, 0), cA, voffA); PG8_STAGE(PG8_SB(0, 1), cB + hstep, voffB); PG8_STAGE(PG8_SA(0, 1), cA + hstep, voffA);
    if (wr == 1) PG8_BAR;
    PG8_WAIT_V(4); PG8_BAR;
    PG8_STAGE(PG8_SB(1, 0), cB + kstep, voffB); PG8_STAGE(PG8_SA(1, 0), cA + kstep, voffA); PG8_STAGE(PG8_SB(1, 1), cB + hstep + kstep, voffB);
    PG8_WAIT_V(6); PG8_BAR;
    for (;;) {
        const bool has_next = S_.next(ui + 1, nxt);
        const char* nA = has_next ? (const char*)g.A + (size_t)nxt.pm * tstep : cA; const char* nB = has_next ? (const char*)g.Bt + (size_t)nxt.pn * tstep : cB;
        for (int t = 0; t < nt; t += 2) {
            const bool last = (t == nt - 2);
            const char* a1 = cA + (size_t)(t + 1) * kstep;
            const char* a2 = last ? nA : cA + (size_t)(t + 2) * kstep; const char* b2 = last ? nB : cB + (size_t)(t + 2) * kstep;
            const char* a3 = a2 + kstep; const char* b3 = b2 + kstep;
            PG8_LDB(B0, 0, 0); PG8_SCHED; PG8_LDA(At, 0, 0); PG8_STAGE(PG8_SA(1, 1), a1 + hstep, voffA);
            PG8_WAIT_L(8); PG8_BAR; PG8_WAIT_L(0); PG8_MMA(0, 0, At, B0); PG8_BAR; PG8_SCHED;
            PG8_LDB(B1, 0, 1); PG8_STAGE(PG8_SB(0, 0), b2, voffB);
            PG8_BAR; PG8_WAIT_L(0); PG8_MMA(0, 1, At, B1); PG8_BAR;
            PG8_LDA(At, 0, 1); PG8_STAGE(PG8_SA(0, 0), a2, voffA);
            PG8_BAR; PG8_WAIT_L(0); PG8_MMA(1, 0, At, B0); PG8_BAR; PG8_SCHED;
            PG8_STAGE(PG8_SB(0, 1), b2 + hstep, voffB);
            PG8_WAIT_V(6); PG8_BAR; PG8_MMA(1, 1, At, B1); PG8_BAR;
            PG8_LDB(B0, 1, 0); PG8_SCHED; PG8_LDA(At, 1, 0); PG8_STAGE(PG8_SA(0, 1), a2 + hstep, voffA);
            PG8_WAIT_L(8); PG8_BAR; PG8_WAIT_L(0); PG8_MMA(0, 0, At, B0); PG8_BAR; PG8_SCHED;
            PG8_LDB(B1, 1, 1); PG8_STAGE(PG8_SB(1, 0), b3, voffB);
            PG8_BAR; PG8_WAIT_L(0); PG8_MMA(0, 1, At, B1); PG8_BAR;
            PG8_LDA(At, 1, 1); PG8_STAGE(PG8_SA(1, 0), a3, voffA);
            PG8_BAR; PG8_WAIT_L(0); PG8_MMA(1, 0, At, B0); PG8_BAR; PG8_SCHED;
            PG8_STAGE(PG8_SB(1, 1), b3 + hstep, voffB);
            PG8_WAIT_V(6); PG8_BAR; PG8_MMA(1, 1, At, B1); PG8_BAR;
        }
        E(acc, cur, wr, wc, fr, fq);
        if (!has_next) break;
#pragma unroll
        for (int a = 0; a < 2; ++a)
#pragma unroll
            for (int b = 0; b < 2; ++b)
#pragma unroll
                for (int m = 0; m < 4; ++m)
#pragma unroll
                    for (int n = 0; n < 2; ++n) acc[a][b][m][n] = (f32x4){0.f, 0.f, 0.f, 0.f};
        cur = nxt; cA = nA; cB = nB; ++ui;
    }
    PG8_WAIT_V(0);
    if (wr == 0) PG8_BAR;
    PG8_BAR;
#undef PG8_SA
#undef PG8_SB
#undef PG8_STAGE
#undef PG8_LDA
#undef PG8_LDB
#undef PG8_MMA
#undef PG8_WAIT_V
#undef PG8_WAIT_L
#undef PG8_BAR
#undef PG8_SCHED
}
}
using pg8::Unit;

struct EpiInProj {
    bf16_t *G, *P1G, *P1R, *P2; const float *cosT, *sinT;
    DEVI void operator()(const f32x4 (&acc)[2][2][4][2], const Unit& u, int wr, int wc, int fr, int fq) const {
        const int pn = u.pn; const int row0 = u.pm * 256 + wr * 64 + fr; const int cl = wc * 32 + 8 * fq;
        const bool plain = (pn < 39) || (pn >= 48 && pn < 56);
        if (plain) {
            bf16_t* base; int ld, pnl; bool sg = false;
            if (pn < 32) { base = G; ld = 8192; pnl = pn; sg = true; }
            else if (pn < 39) { base = P1G; ld = 1792; pnl = pn - 32; }
            else { base = P1R; ld = 2048; pnl = pn - 48; }
#pragma unroll
            for (int ai = 0; ai < 2; ++ai)
#pragma unroll
                for (int m = 0; m < 4; ++m) {
                    bf16_t* rowp = base + (size_t)(row0 + ai * 128 + m * 16) * ld + pnl * 256 + cl;
#pragma unroll
                    for (int bj = 0; bj < 2; ++bj) {
                        f32x4 v0 = acc[ai][bj][m][0], v1 = acc[ai][bj][m][1];
                        if (sg) {
#pragma unroll
                            for (int j = 0; j < 4; ++j) { v0[j] = sigmoidf_(v0[j]); v1[j] = sigmoidf_(v1[j]); }
                        }
                        u32x4 w; w.x = cvt_pk_bf16(v0[0], v0[1]); w.y = cvt_pk_bf16(v0[2], v0[3]); w.z = cvt_pk_bf16(v1[0], v1[1]); w.w = cvt_pk_bf16(v1[2], v1[3]);
                        *(u32x4*)(rowp + bj * 128) = w;
                    }
                    __builtin_amdgcn_sched_barrier(0);
                }
        } else {
            int t, hbase, arr0;
            if (pn < 48) { const int pl = pn - 39; t = pl / 3; hbase = (pl % 3) * 2; arr0 = t * 6 + hbase; }
            else { const int pl = pn - 56; t = pl / 2; hbase = (pl % 2) * 2; arr0 = 18 + t * 4 + hbase; }
            const bool rope = (t < 2) && (wc == 0);
            const float sc = (t == 0) ? 0.08838834764831845f : 1.0f;
#pragma unroll
            for (int ai = 0; ai < 2; ++ai)
#pragma unroll
                for (int m = 0; m < 4; ++m) {
                    const int row = row0 + ai * 128 + m * 16;
#pragma unroll
                    for (int bj = 0; bj < 2; ++bj) {
                        f32x4 v0 = acc[ai][bj][m][0], v1 = acc[ai][bj][m][1];
                        if (rope) {
                            const f32x4 c0 = *(const f32x4*)(cosT + (size_t)row * 16 + 8 * (fq & 1)), c1 = *(const f32x4*)(cosT + (size_t)row * 16 + 8 * (fq & 1) + 4);
                            const f32x4 s0 = *(const f32x4*)(sinT + (size_t)row * 16 + 8 * (fq & 1)), s1 = *(const f32x4*)(sinT + (size_t)row * 16 + 8 * (fq & 1) + 4);
                            const float sgn = (fq < 2) ? -1.0f : 1.0f;
#pragma unroll
                            for (int j = 0; j < 4; ++j) {
                                const float p0 = __shfl_xor(v0[j], 32), p1 = __shfl_xor(v1[j], 32);
                                v0[j] = v0[j] * c0[j] + sgn * p0 * s0[j];
                                v1[j] = v1[j] * c1[j] + sgn * p1 * s1[j];
                            }
                        }
                        v0 *= sc; v1 *= sc;
                        bf16_t* dst = P2 + (size_t)(arr0 + bj) * ((size_t)S * 128) + (size_t)row * 128 + cl;
                        u32x4 w; w.x = cvt_pk_bf16(v0[0], v0[1]); w.y = cvt_pk_bf16(v0[2], v0[3]); w.z = cvt_pk_bf16(v1[0], v1[1]); w.w = cvt_pk_bf16(v1[2], v1[3]);
                        *(u32x4*)dst = w;
                    }
                    __builtin_amdgcn_sched_barrier(0);
                }
        }
    }
};

struct EpiBranch {
    const bf16_t* Gb; bf16_t* Mg; int first;
    DEVI void operator()(const f32x4 (&acc)[2][2][4][2], const Unit& u, int wr, int wc, int fr, int fq) const {
        const int row0 = u.pm * 256 + wr * 64 + fr; const int col0 = u.pn * 256 + wc * 32 + 8 * fq;
#pragma unroll
        for (int ai = 0; ai < 2; ++ai)
#pragma unroll
            for (int m = 0; m < 4; ++m) {
                const int row = row0 + ai * 128 + m * 16;
#pragma unroll
                for (int bj = 0; bj < 2; ++bj) {
                    const int col = col0 + bj * 128;
                    const u32x4 gw = *(const u32x4*)(Gb + (size_t)row * 8192 + col);
                    bf16_t* mp = Mg + (size_t)row * 2048 + col;
                    float o[8];
#pragma unroll
                    for (int j = 0; j < 4; ++j) { o[j] = acc[ai][bj][m][0][j]; o[4 + j] = acc[ai][bj][m][1][j]; }
#pragma unroll
                    for (int j = 0; j < 4; ++j) {
                        o[2 * j] *= __uint_as_float(gw[j] << 16);
                        o[2 * j + 1] *= __uint_as_float(gw[j] & 0xFFFF0000u);
                    }
                    if (!first) {
                        const u32x4 mw = *(const u32x4*)mp;
#pragma unroll
                        for (int j = 0; j < 4; ++j) { o[2 * j] += __uint_as_float(mw[j] << 16); o[2 * j + 1] += __uint_as_float(mw[j] & 0xFFFF0000u); }
                    }
                    u32x4 w; w.x = cvt_pk_bf16(o[0], o[1]); w.y = cvt_pk_bf16(o[2], o[3]); w.z = cvt_pk_bf16(o[4], o[5]); w.w = cvt_pk_bf16(o[6], o[7]);
                    *(u32x4*)mp = w;
                    __builtin_amdgcn_sched_barrier(0);
                }
            }
    }
};

struct EpiResid {
    const float* src; float* dst; const float* gate;
    DEVI void operator()(const f32x4 (&acc)[2][2][4][2], const Unit& u, int wr, int wc, int fr, int fq) const {
        const int row0 = u.pm * 256 + wr * 64 + fr; const int col0 = u.pn * 256 + wc * 32 + 8 * fq;
        f32x4 gv[2][2];
#pragma unroll
        for (int bj = 0; bj < 2; ++bj)
#pragma unroll
            for (int n = 0; n < 2; ++n) gv[bj][n] = *(const f32x4*)(gate + col0 + bj * 128 + 4 * n);
#pragma unroll
        for (int ai = 0; ai < 2; ++ai)
#pragma unroll
            for (int m = 0; m < 4; ++m) {
                const size_t ro = (size_t)(row0 + ai * 128 + m * 16) * 2048 + col0;
#pragma unroll
                for (int bj = 0; bj < 2; ++bj)
#pragma unroll
                    for (int n = 0; n < 2; ++n) {
                        const f32x4 xv = *(const f32x4*)(src + ro + bj * 128 + 4 * n);
                        *(f32x4*)(dst + ro + bj * 128 + 4 * n) = xv + gv[bj][n] * acc[ai][bj][m][n];
                    }
                __builtin_amdgcn_sched_barrier(0);
            }
    }
};

struct EpiSwiglu {
    bf16_t* act;
    DEVI void operator()(const f32x4 (&acc)[2][2][4][2], const Unit& u, int wr, int wc, int fr, int fq) const {
        const int row0 = u.pm * 256 + wr * 64 + fr; const int col0 = u.pn * 128 + wc * 32 + 8 * fq;
#pragma unroll
        for (int ai = 0; ai < 2; ++ai)
#pragma unroll
            for (int m = 0; m < 4; ++m) {
                float o[8];
#pragma unroll
                for (int j = 0; j < 4; ++j) { o[j] = siluf_(acc[ai][0][m][0][j]) * acc[ai][1][m][0][j]; o[4 + j] = siluf_(acc[ai][0][m][1][j]) * acc[ai][1][m][1][j]; }
                u32x4 w; w.x = cvt_pk_bf16(o[0], o[1]); w.y = cvt_pk_bf16(o[2], o[3]); w.z = cvt_pk_bf16(o[4], o[5]); w.w = cvt_pk_bf16(o[6], o[7]);
                *(u32x4*)(act + (size_t)(row0 + ai * 128 + m * 16) * FFN_H + col0) = w;
                __builtin_amdgcn_sched_barrier(0);
            }
    }
};

template <class Epi>
DEVI void run_gemm(unsigned char* smem, const bf16_t* A, const bf16_t* Bt, int N, int K, const Epi& E) {
    pg8::Gemm g; g.A = A; g.Bt = Bt; g.M = S; g.N = N; g.K = K;
    pg8::StaticOrder so; so.init(S, N, gridDim.x, blockIdx.x);
    pg8::gemm_phase<Epi>((LAS unsigned char*)smem, g, so, E);
}

DEVI int srccol_win(int n) {
    if (n < 8192) return n;
    if (n < 9984) { const int j = n - 8192; return j < 1552 ? 8192 + j : -1; }
    if (n < 12288) return 9744 + (n - 9984);
    if (n < 14336) { const int j = n - 12288; return j < 1984 ? 12048 + j : -1; }
    return 14032 + (n - 14336);
}
DEVI int srccol_ffn(int n) { return ((n >> 7) & 1) * FFN_H + (n >> 8) * 128 + (n & 127); }

DEVI void conv_tile(unsigned char* smem, const float* src, int ldsrc, int K, bf16_t* dst, int mode, int ntile, int ktile) {
    int tid_ = threadIdx.x; asm volatile("" : "+v"(tid_));
    float* tile = (float*)smem;
    const int tid = tid_, tx = tid & 63, ty = tid >> 6;
    const int n0 = ntile * 64, k0 = ktile * 64;
    const int n = n0 + tx;
    const int sc = mode == 0 ? srccol_win(n) : (mode == 1 ? srccol_ffn(n) : n);
#pragma unroll
    for (int i = 0; i < 8; ++i) {
        const int kk = ty + 8 * i;
        tile[kk * 65 + tx] = sc >= 0 ? src[(size_t)(k0 + kk) * ldsrc + sc] : 0.0f;
    }
    __syncthreads();
    const int nr = tid >> 3, ks = (tid & 7) * 8;
    float v[8];
#pragma unroll
    for (int j = 0; j < 8; ++j) v[j] = tile[(ks + j) * 65 + nr];
    u32x4 w; w.x = cvt_pk_bf16(v[0], v[1]); w.y = cvt_pk_bf16(v[2], v[3]); w.z = cvt_pk_bf16(v[4], v[5]); w.w = cvt_pk_bf16(v[6], v[7]);
    *(u32x4*)(dst + (size_t)(n0 + nr) * K + k0 + ks) = w;
    __syncthreads();
}

DEVI void phase_convert(const Params& p, int l, unsigned char* smem, int bid, int nb) {
    const int c0 = 248 * 32, c1 = c0 + 32 * 8, c2 = c1 + 32 * 4, c3 = c2 + 32 * 8, c4 = c3 + 32 * 8, c5 = c4 + 32 * 32, c6 = c5 + 176 * 32, c7 = c6 + 32 * 88;
    unsigned char* ws = p.ws;
    {
        int tl_ = threadIdx.x; asm volatile("" : "+v"(tl_)); int ll_ = l; asm volatile("" : "+s"(ll_));
        size_t wzz_ = 0; asm volatile("" : "+s"(wzz_));
        bf16_t* WT = (bf16_t*)(ws + wzz_ + OFF_LORA);
        const float* w2 = (const float*)p.in[12] + (size_t)ll_ * 96 * 512; const float* a2 = (const float*)p.in[14] + (size_t)ll_ * 96 * 512; const float* g2 = (const float*)p.in[15] + (size_t)ll_ * 256 * 512;
        for (int k = bid; k < 448; k += nb) {
            const int n = tl_;
            const float v = k < 96 ? w2[k * 512 + n] : (k < 192 ? a2[(k - 96) * 512 + n] : g2[(k - 192) * 512 + n]);
            WT[n * 448 + k] = f2bf(v);
        }
    }
    for (int it = bid; it < c7; it += nb) {
        if (it < c0) { conv_tile(smem, (const float*)p.in[6] + (size_t)l * D * IN_TOTAL, IN_TOTAL, D, (bf16_t*)(ws + OFF_WIN), 0, it / 32, it % 32); }
        else if (it < c1) { const int j = it - c0; conv_tile(smem, (const float*)p.in[24] + (size_t)l * 512 * D, D, 512, (bf16_t*)(ws + OFF_WBA), 2, j / 8, j % 8); }
        else if (it < c2) { const int j = it - c1; conv_tile(smem, (const float*)p.in[25] + (size_t)l * 256 * D, D, 256, (bf16_t*)(ws + OFF_WBB), 2, j / 4, j % 4); }
        else if (it < c3) { const int j = it - c2; conv_tile(smem, (const float*)p.in[26] + (size_t)l * 512 * D, D, 512, (bf16_t*)(ws + OFF_WBC), 2, j / 8, j % 8); }
        else if (it < c4) { const int j = it - c3; conv_tile(smem, (const float*)p.in[27] + (size_t)l * 512 * D, D, 512, (bf16_t*)(ws + OFF_WBD), 2, j / 8, j % 8); }
        else if (it < c5) { const int j = it - c4; conv_tile(smem, (const float*)p.in[28] + (size_t)l * D * D, D, D, (bf16_t*)(ws + OFF_WOUT), 2, j / 32, j % 32); }
        else if (it < c6) { const int j = it - c5; conv_tile(smem, (const float*)p.in[30] + (size_t)l * D * 2 * FFN_H, 2 * FFN_H, D, (bf16_t*)(ws + OFF_WF1), 1, j / 32, j % 32); }
        else { const int j = it - c6; conv_tile(smem, (const float*)p.in[31] + (size_t)l * FFN_H * D, D, FFN_H, (bf16_t*)(ws + OFF_WF2), 2, j / 88, j % 88); }
    }
}

DEVI void phase_mod_rope(const Params& p, unsigned char* smem, int bid, int nb) {
    int tid_ = threadIdx.x; asm volatile("" : "+v"(tid_)); size_t wz_ = 0; asm volatile("" : "+s"(wz_)); unsigned char* ws_ = p.ws + wz_;
    const int tid = tid_;
    float* sc = (float*)smem;
    float* red = sc + 2048;
    const float* c = (const float*)p.in[1];
    for (int i = tid; i < D; i += NT) sc[i] = siluf_(c[i]);
    __syncthreads();
    float* mod = (float*)(ws_ + OFF_MOD);
    for (int it = bid; it < 192; it += nb) {
        const int l = it / 96, cg0 = (it % 96) * 128;
        const float* W = (const float*)p.in[3] + (size_t)l * D * 12288;
        const int col = tid & 127, kq = tid >> 7;
        float a = 0.f;
        const float* wp = W + (size_t)(kq * 512) * 12288 + cg0 + col;
#pragma unroll 8
        for (int k = 0; k < 512; ++k) a += sc[kq * 512 + k] * wp[(size_t)k * 12288];
        red[kq * 128 + col] = a;
        __syncthreads();
        if (tid < 128) mod[l * 12288 + cg0 + tid] = red[tid] + red[128 + tid] + red[256 + tid] + red[384 + tid] + ((const float*)p.in[4])[l * 12288 + cg0 + tid];
        __syncthreads();
    }
    const float invf[16] = {1.000000000e+00f, 4.403665960e-01f, 1.939227432e-01f, 8.539710194e-02f, 3.760603070e-02f, 1.656043902e-02f, 7.292664610e-03f, 3.211445874e-03f,
                            1.414213562e-03f, 6.227723788e-04f, 2.742481884e-04f, 1.207697351e-04f, 5.318296098e-05f, 2.341999971e-05f, 1.031338616e-05f, 4.541670478e-06f};
    const int* pos = (const int*)p.in[2];
    float* cosT = (float*)(ws_ + OFF_COS); float* sinT = (float*)(ws_ + OFF_SIN);
    for (int e = bid * NT + tid; e < S * 16; e += nb * NT) {
        const int t = e >> 4, i = e & 15;
        float fi = invf[0];
#pragma unroll
        for (int j = 1; j < 16; ++j) fi = (i == j) ? invf[j] : fi;
        const float ang = (float)pos[t] * fi;
        const double a = (double)ang;
        const double kq = __builtin_rint(a * 0.15915494309189535);
        const double r = a - kq * 6.283185307179586;
        const double y = r * 0.25, y2 = y * y;
        double s = y * (1.0 - y2 / 6.0 * (1.0 - y2 / 20.0 * (1.0 - y2 / 42.0 * (1.0 - y2 / 72.0 * (1.0 - y2 / 110.0 * (1.0 - y2 / 156.0))))));
        double cc = 1.0 - y2 / 2.0 * (1.0 - y2 / 12.0 * (1.0 - y2 / 30.0 * (1.0 - y2 / 56.0 * (1.0 - y2 / 90.0 * (1.0 - y2 / 132.0 * (1.0 - y2 / 182.0))))));
        double s2 = 2.0 * s * cc, c2 = 1.0 - 2.0 * s * s;
        double s4 = 2.0 * s2 * c2, c4 = 1.0 - 2.0 * s2 * s2;
        cosT[e] = (float)c4; sinT[e] = (float)s4;
    }
}

DEVI void phase_norm(const float* x, const float* gain, const float* shift, const float* scale, bf16_t* h, int bid, int nb) {
    int tid_ = threadIdx.x; asm volatile("" : "+v"(tid_));
    const int wid = tid_ >> 6, lane = tid_ & 63;
    for (int row = bid * 8 + wid; row < S; row += nb * 8) {
        const f32x4* xr = (const f32x4*)(x + (size_t)row * D);
        f32x4 v[8]; float ss = 0.f;
#pragma unroll
        for (int i = 0; i < 8; ++i) { v[i] = xr[lane + 64 * i]; ss += v[i][0] * v[i][0] + v[i][1] * v[i][1] + v[i][2] * v[i][2] + v[i][3] * v[i][3]; }
        ss = wave_sum(ss);
        const float r = rsqrtf(ss * (1.0f / D) + 1e-6f);
#pragma unroll
        for (int i = 0; i < 8; ++i) {
            const int c4 = lane + 64 * i;
            const f32x4 g = ((const f32x4*)gain)[c4], sh = ((const f32x4*)shift)[c4], sc = ((const f32x4*)scale)[c4];
            f32x4 y = v[i] * r * g * (sc + 1.0f) + sh;
            u32x2 w; w.x = cvt_pk_bf16(y[0], y[1]); w.y = cvt_pk_bf16(y[2], y[3]);
            *(u32x2*)(h + (size_t)row * D + c4 * 4) = w;
        }
    }
}

DEVI void phase_final_norm(float* x, const float* gain, int bid, int nb) {
    int tid_ = threadIdx.x; asm volatile("" : "+v"(tid_));
    const int wid = tid_ >> 6, lane = tid_ & 63;
    for (int row = bid * 8 + wid; row < S; row += nb * 8) {
        f32x4* xr = (f32x4*)(x + (size_t)row * D);
        f32x4 v[8]; float ss = 0.f;
#pragma unroll
        for (int i = 0; i < 8; ++i) { v[i] = xr[lane + 64 * i]; ss += v[i][0] * v[i][0] + v[i][1] * v[i][1] + v[i][2] * v[i][2] + v[i][3] * v[i][3]; }
        ss = wave_sum(ss);
        const float r = rsqrtf(ss * (1.0f / D) + 1e-6f);
#pragma unroll
        for (int i = 0; i < 8; ++i) xr[lane + 64 * i] = v[i] * r * ((const f32x4*)gain)[lane + 64 * i];
    }
}

DEVI float logsigmoidf_(float x) { return fminf(x, 0.f) - log1pf(__expf(-fabsf(x))); }

DEVI void gla_pass1(const Params& p, int l, unsigned char* smem, int item) {
    int tid_ = threadIdx.x; asm volatile("" : "+v"(tid_)); size_t wz_ = 0; asm volatile("" : "+s"(wz_)); unsigned char* ws_ = p.ws + wz_;
    const int n = item >> 2, h = item & 3, tok0 = n * 64, tid = tid_;
    float* sB = (float*)smem;
    float* sK = sB + 4096;
    float* sV = sK + 4096;
    float* sA = sV + 8192;
    float* sW = sA + 1024;
    const bf16_t* P = (const bf16_t*)(ws_ + OFF_P1G);
    const float* wa2 = (const float*)p.in[7] + (size_t)l * 16 * 256;
    const float* ba2 = (const float*)p.in[8] + (size_t)l * 256;
    for (int e = tid; e < 1024; e += NT) { sA[e] = bf2f(P[(size_t)(tok0 + (e >> 4)) * 1792 + 1536 + (e & 15)]); sW[e] = wa2[(e >> 6) * 256 + h * 64 + (e & 63)]; }
    __syncthreads();
    for (int e = tid; e < 4096; e += NT) {
        const int t = e >> 6, d = e & 63;
        float x = ba2[h * 64 + d];
#pragma unroll
        for (int r = 0; r < 16; ++r) x += sA[t * 16 + r] * sW[r * 64 + d];
        sB[e] = logsigmoidf_(x) * (1.0f / 16.0f);
    }
    __syncthreads();
    if (tid < 64) { float a = 0.f; for (int t = 0; t < 64; ++t) { a += sB[t * 64 + tid]; sB[t * 64 + tid] = a; } }
    __syncthreads();
    float* Bbuf = (float*)(ws_ + OFF_GLB);
    for (int e = tid; e < 4096; e += NT) {
        const int s = e >> 6, d = e & 63;
        const float b = sB[e], bl = sB[63 * 64 + d];
        sK[e] = bf2f(P[(size_t)(tok0 + s) * 1792 + 256 + h * 64 + d]) * __expf(bl - b);
        Bbuf[(size_t)(tok0 + s) * 256 + h * 64 + d] = b;
    }
    for (int e = tid; e < 8192; e += NT) sV[e] = bf2f(P[(size_t)(tok0 + (e >> 7)) * 1792 + 512 + h * 128 + (e & 127)]);
    if (tid < 64) ((float*)(ws_ + OFF_GLD))[(size_t)item * 64 + tid] = __expf(sB[63 * 64 + tid]);
    __syncthreads();
    {
        const int d = tid >> 3, eg = (tid & 7) * 16;
        f32x4 a0 = {0, 0, 0, 0}, a1 = a0, a2 = a0, a3 = a0;
        for (int s = 0; s < 64; ++s) {
            const float kd = sK[s * 64 + d];
            const f32x4* vp = (const f32x4*)(sV + s * 128 + eg);
            a0 += kd * vp[0]; a1 += kd * vp[1]; a2 += kd * vp[2]; a3 += kd * vp[3];
        }
        f32x4* Lp = (f32x4*)((float*)(ws_ + OFF_GLL) + ((size_t)item * 64 + d) * 128 + eg);
        Lp[0] = a0; Lp[1] = a1; Lp[2] = a2; Lp[3] = a3;
    }
    __syncthreads();
}

DEVI void gla_pass2(const Params& p, int item) {
    int tid_ = threadIdx.x; asm volatile("" : "+v"(tid_)); size_t wz_ = 0; asm volatile("" : "+s"(wz_)); unsigned char* ws_ = p.ws + wz_;
    const int idx = item * NT + tid_;
    const int h = idx >> 13, de = idx & 8191, d = de >> 7;
    float* L = (float*)(ws_ + OFF_GLL); const float* Dc = (const float*)(ws_ + OFF_GLD);
    float st = 0.f;
    for (int n0 = 0; n0 < 256; n0 += 8) {
        float tmp[8], dc[8];
#pragma unroll
        for (int j = 0; j < 8; ++j) { tmp[j] = L[((size_t)((n0 + j) * 4 + h) * 64) * 128 + de]; dc[j] = Dc[((n0 + j) * 4 + h) * 64 + d]; }
#pragma unroll
        for (int j = 0; j < 8; ++j) { L[((size_t)((n0 + j) * 4 + h) * 64) * 128 + de] = st; st = dc[j] * st + tmp[j]; }
    }
}

DEVI void gla_pass3(const Params& p, int l, unsigned char* smem, int item) {
    int tid_ = threadIdx.x; asm volatile("" : "+v"(tid_)); size_t wz_ = 0; asm volatile("" : "+s"(wz_)); unsigned char* ws_ = p.ws + wz_;
    const int n = item >> 2, h = item & 3, tok0 = n * 64, tid = tid_;
    float* sQ = (float*)smem;
    float* sK = sQ + 4096;
    float* sV = sK + 4160;
    float* sS = sV + 8192;
    float* sSc = sS + 8192;
    const bf16_t* P = (const bf16_t*)(ws_ + OFF_P1G);
    const float* Bbuf = (const float*)(ws_ + OFF_GLB);
    for (int e = tid; e < 4096; e += NT) {
        const int t = e >> 6, d = e & 63;
        const float b = Bbuf[(size_t)(tok0 + t) * 256 + h * 64 + d];
        sQ[e] = bf2f(P[(size_t)(tok0 + t) * 1792 + h * 64 + d]) * 0.125f * __expf(b);
        sK[t * 65 + d] = bf2f(P[(size_t)(tok0 + t) * 1792 + 256 + h * 64 + d]) * __expf(-b);
    }
    const float* Lp = (const float*)(ws_ + OFF_GLL) + (size_t)item * 8192;
    for (int e = tid; e < 8192; e += NT) { sV[e] = bf2f(P[(size_t)(tok0 + (e >> 7)) * 1792 + 512 + h * 128 + (e & 127)]); sS[e] = Lp[e]; }
    __syncthreads();
    {
        const int t = tid >> 3, sg = (tid & 7) * 8;
        float a[8];
#pragma unroll
        for (int j = 0; j < 8; ++j) a[j] = 0.f;
        for (int d = 0; d < 64; ++d) {
            const float qv = sQ[t * 64 + d];
#pragma unroll
            for (int j = 0; j < 8; ++j) a[j] += qv * sK[(sg + j) * 65 + d];
        }
#pragma unroll
        for (int j = 0; j < 8; ++j) sSc[t * 64 + sg + j] = (sg + j <= t) ? a[j] : 0.f;
    }
    __syncthreads();
    {
        const int t = tid >> 3, eg = (tid & 7) * 16;
        f32x4 a0 = {0, 0, 0, 0}, a1 = a0, a2 = a0, a3 = a0;
        for (int d = 0; d < 64; ++d) {
            const float qv = sQ[t * 64 + d];
            const f32x4* sp = (const f32x4*)(sS + d * 128 + eg);
            a0 += qv * sp[0]; a1 += qv * sp[1]; a2 += qv * sp[2]; a3 += qv * sp[3];
        }
        for (int s = 0; s < 64; ++s) {
            const float sc = sSc[t * 64 + s];
            const f32x4* vp = (const f32x4*)(sV + s * 128 + eg);
            a0 += sc * vp[0]; a1 += sc * vp[1]; a2 += sc * vp[2]; a3 += sc * vp[3];
        }
        float ss = 0.f;
#pragma unroll
        for (int j = 0; j < 4; ++j) ss += a0[j] * a0[j] + a1[j] * a1[j] + a2[j] * a2[j] + a3[j] * a3[j];
        ss += __shfl_xor(ss, 1); ss += __shfl_xor(ss, 2); ss += __shfl_xor(ss, 4);
        const float r = rsqrtf(ss * (1.0f / 128.0f) + 1e-6f);
        const float* gn = (const float*)p.in[9] + (size_t)l * 128 + eg;
        const bf16_t* gp = P + (size_t)(tok0 + t) * 1792 + 1024 + h * 128 + eg;
        float o[16];
#pragma unroll
        for (int j = 0; j < 4; ++j) { o[j] = a0[j]; o[4 + j] = a1[j]; o[8 + j] = a2[j]; o[12 + j] = a3[j]; }
#pragma unroll
        for (int j = 0; j < 16; ++j) o[j] = o[j] * r * gn[j] * siluf_(bf2f(gp[j]));
        bf16_t* op = (bf16_t*)(ws_ + OFF_OGLA) + (size_t)(tok0 + t) * 512 + h * 128 + eg;
        u32x4 w0, w1;
        w0.x = cvt_pk_bf16(o[0], o[1]); w0.y = cvt_pk_bf16(o[2], o[3]); w0.z = cvt_pk_bf16(o[4], o[5]); w0.w = cvt_pk_bf16(o[6], o[7]);
        w1.x = cvt_pk_bf16(o[8], o[9]); w1.y = cvt_pk_bf16(o[10], o[11]); w1.z = cvt_pk_bf16(o[12], o[13]); w1.w = cvt_pk_bf16(o[14], o[15]);
        *(u32x4*)op = w0; *(u32x4*)(op + 8) = w1;
    }
    __syncthreads();
}

DEVI void rwkv_prep(const Params& p, int l, unsigned char* smem, int item) {
    int tid_ = threadIdx.x; asm volatile("" : "+v"(tid_)); size_t wz_ = 0; asm volatile("" : "+s"(wz_)); unsigned char* ws_ = p.ws + wz_;
    const int tok0 = item * 16, c = tid_, tid = tid_;
    bf16_t* sX = (bf16_t*)smem;
    float* sAcc = (float*)(smem + 16384);
    float* sVx = (float*)(smem + 16384);
    float* sMid = sVx + 512 * 16;
    const bf16_t* P = (const bf16_t*)(ws_ + OFF_P1R);
    const float* mu = (const float*)p.in[10] + (size_t)l * 1984;
    bf16_t lx[14], lxp[14];
#pragma unroll
    for (int i = 0; i < 14; ++i) {
        const int e = tid + i * NT, t = e / 448, j = e % 448, col = 1536 + j, tok = tok0 + t;
        lx[i] = P[(size_t)tok * 2048 + col]; lxp[i] = tok > 0 ? P[(size_t)(tok - 1) * 2048 + col] : (bf16_t)0;
    }
#pragma unroll
    for (int i = 0; i < 14; ++i) {
        const int e = tid + i * NT;
        const int t = e / 448, j = e % 448, col = 1536 + j;
        const float x = bf2f(lx[i]);
        const float xp = bf2f(lxp[i]);
        const float xs = x + (xp - x) * mu[col];
        float v;
        if (j < 96) { const float e2 = __expf(2.0f * xs); v = 1.0f - 2.0f * __builtin_amdgcn_rcpf(e2 + 1.0f); }
        else if (j < 192) v = xs;
        else v = sigmoidf_(xs);
        sX[t * 456 + j] = f2bf(v);
    }
    const float mu_r = mu[c], mu_k = mu[512 + c], mu_v = mu[1024 + c];
    bf16_t xv[17];
    xv[0] = tok0 > 0 ? P[(size_t)(tok0 - 1) * 2048 + 1024 + c] : (bf16_t)0;
#pragma unroll
    for (int t = 0; t < 16; ++t) xv[t + 1] = P[(size_t)(tok0 + t) * 2048 + 1024 + c];
    __syncthreads();
    {
        const int wid = tid >> 6, lane = tid & 63, li = lane & 15, g = lane >> 4;
        const bf16_t* WT = (const bf16_t*)(ws_ + OFF_LORA);
#pragma unroll
        for (int lo = 0; lo < 3; ++lo) {
            const int kb = lo == 0 ? 0 : (lo == 1 ? 96 : 192), nks = lo == 2 ? 8 : 3;
            f32x4 acc[4];
#pragma unroll
            for (int q = 0; q < 4; ++q) acc[q] = (f32x4){0.f, 0.f, 0.f, 0.f};
            for (int ks = 0; ks < nks; ++ks) {
                const bf16x8 af = *(const bf16x8*)(sX + li * 456 + kb + ks * 32 + g * 8);
#pragma unroll
                for (int q = 0; q < 4; ++q) {
                    const bf16x8 bfr = *(const bf16x8*)(WT + (size_t)((wid * 4 + q) * 16 + li) * 448 + kb + ks * 32 + g * 8);
                    acc[q] = __builtin_amdgcn_mfma_f32_16x16x32_bf16(af, bfr, acc[q], 0, 0, 0);
                }
            }
#pragma unroll
            for (int q = 0; q < 4; ++q)
#pragma unroll
                for (int r = 0; r < 4; ++r) sAcc[(lo * 16 + 4 * g + r) * 512 + (wid * 4 + q) * 16 + li] = acc[q][r];
        }
    }
    __syncthreads();
    float wacc[16], aacc[16], gacc[16];
#pragma unroll
    for (int t = 0; t < 16; ++t) { wacc[t] = sAcc[t * 512 + c]; aacc[t] = sAcc[(16 + t) * 512 + c]; gacc[t] = sAcc[(32 + t) * 512 + c]; }
    __syncthreads();
#pragma unroll
    for (int t = 0; t < 16; ++t) { const float x = bf2f(xv[t + 1]), xp = bf2f(xv[t]); sVx[c * 16 + t] = x + (xp - x) * mu_v; }
    __syncthreads();
    float vacc[16];
#pragma unroll
    for (int t = 0; t < 16; ++t) vacc[t] = 0.f;
    if (l > 0) {
        const float* v1 = (const float*)p.in[22];
        const float* v2 = (const float*)p.in[23];
        {
            const int m = tid & 63, cp = tid >> 6;
            float ma[16];
#pragma unroll
            for (int t = 0; t < 16; ++t) ma[t] = 0.f;
#pragma unroll 8
            for (int cc = 0; cc < 64; ++cc) {
                const float w = v1[(cp * 64 + cc) * 64 + m]; const f32x4* lp = (const f32x4*)(sVx + (cp * 64 + cc) * 16);
#pragma unroll
                for (int q = 0; q < 4; ++q) { const f32x4 x = lp[q]; ma[4 * q] += x[0] * w; ma[4 * q + 1] += x[1] * w; ma[4 * q + 2] += x[2] * w; ma[4 * q + 3] += x[3] * w; }
            }
            float* sP = sMid + 64 * 16;
#pragma unroll
            for (int q = 0; q < 4; ++q) *(f32x4*)(sP + (cp * 64 + m) * 16 + 4 * q) = (f32x4){ma[4 * q], ma[4 * q + 1], ma[4 * q + 2], ma[4 * q + 3]};
            __syncthreads();
            for (int e = tid; e < 1024; e += NT) {
                float a = 0.f;
#pragma unroll
                for (int k = 0; k < 8; ++k) a += sP[k * 1024 + e];
                sMid[e] = a;
            }
        }
        __syncthreads();
#pragma unroll 8
        for (int m = 0; m < 64; ++m) {
            const float w = v2[m * 512 + c]; const f32x4* lp = (const f32x4*)(sMid + m * 16);
#pragma unroll
            for (int q = 0; q < 4; ++q) { const f32x4 x = lp[q]; vacc[4 * q] += x[0] * w; vacc[4 * q + 1] += x[1] * w; vacc[4 * q + 2] += x[2] * w; vacc[4 * q + 3] += x[3] * w; }
        }
    }
    const float w0 = ((const float*)p.in[11])[l * 512 + c], a0 = ((const float*)p.in[13])[l * 512 + c];
    const float k_k = ((const float*)p.in[16])[l * 512 + c], k_a = ((const float*)p.in[17])[l * 512 + c];
    const float v0 = l > 0 ? ((const float*)p.in[21])[c] : 0.f;
    bf16_t* R = (bf16_t*)(ws_ + OFF_RWR); bf16_t* Kb = (bf16_t*)(ws_ + OFF_RWK); bf16_t* Vb = (bf16_t*)(ws_ + OFF_RWV);
    bf16_t* Ab = (bf16_t*)(ws_ + OFF_RWA); bf16_t* Bb = (bf16_t*)(ws_ + OFF_RWB); bf16_t* Gb = (bf16_t*)(ws_ + OFF_RWG);
    float* Wb = (float*)(ws_ + OFF_RWW); bf16_t* VF = (bf16_t*)(ws_ + OFF_VF);
    bf16_t xrr[17], xkr[17], vfr[16];
    xrr[0] = tok0 > 0 ? P[(size_t)(tok0 - 1) * 2048 + c] : (bf16_t)0; xkr[0] = tok0 > 0 ? P[(size_t)(tok0 - 1) * 2048 + 512 + c] : (bf16_t)0;
#pragma unroll
    for (int t = 0; t < 16; ++t) { xrr[t + 1] = P[(size_t)(tok0 + t) * 2048 + c]; xkr[t + 1] = P[(size_t)(tok0 + t) * 2048 + 512 + c]; vfr[t] = l > 0 ? VF[(size_t)(tok0 + t) * 512 + c] : (bf16_t)0; }
#pragma unroll
    for (int t = 0; t < 16; ++t) {
        const size_t tok = tok0 + t;
        const float xr = bf2f(xrr[t + 1]), xk = bf2f(xkr[t + 1]), xpr = bf2f(xrr[t]), xpk = bf2f(xkr[t]);
        const float r = xr + (xpr - xr) * mu_r, k = xk + (xpk - xk) * mu_k;
        float v = sVx[c * 16 + t];
        const float z = -(w0 + wacc[t]);
        const float sp = fmaxf(z, 0.f) + __logf(1.0f + __expf(-fabsf(z)));
        const float decay = __expf(-__expf(-sp - 0.5f));
        const float a = sigmoidf_(a0 + aacc[t]);
        if (l == 0) VF[tok * 512 + c] = f2bf(v);
        else { const float vf = bf2f(vfr[t]); v = v + (vf - v) * sigmoidf_(v0 + vacc[t]); }
        float kk = k * k_k;
        const float ss = wave_sum(kk * kk);
        kk = kk * __builtin_amdgcn_rcpf(fmaxf(__builtin_sqrtf(ss), 1e-12f));
        const float km = k * (1.0f + (a - 1.0f) * k_a);
        R[tok * 512 + c] = f2bf(r); Kb[tok * 512 + c] = f2bf(km); Vb[tok * 512 + c] = f2bf(v);
        Ab[tok * 512 + c] = f2bf(-kk); Bb[tok * 512 + c] = f2bf(kk * a); Gb[tok * 512 + c] = f2bf(gacc[t]);
        Wb[tok * 512 + c] = decay;
    }
    __syncthreads();
}

#define SBM do { asm volatile("" ::: "memory"); __builtin_amdgcn_sched_barrier(0); } while (0)
#define RAW_BAR do { asm volatile("s_waitcnt lgkmcnt(0)" ::: "memory"); __builtin_amdgcn_s_barrier(); asm volatile("" ::: "memory"); } while (0)
DEVI void rwkv_scan(const Params& p, unsigned char* smem, int b) {
    int tid_ = threadIdx.x; asm volatile("" : "+v"(tid_)); size_t wz_ = 0; asm volatile("" : "+s"(wz_)); unsigned char* ws_ = p.ws + wz_;
    constexpr int CH = 16, NR = 8, NCH = S / CH;
    constexpr int VEC = NR * 9 * 64, SCL = NR * 4, VVN = NR * 64 * 2, BUF = VEC + SCL + VVN;
    const int head = b >> 2, quarter = b & 3, tid = tid_, wid = tid >> 6, lane = tid & 63;
    float* stg = (float*)smem;
    float* part = stg + 2 * BUF;
    int* sRole = (int*)(part + 2 * CH * 256);
    const bf16_t* R = (const bf16_t*)(ws_ + OFF_RWR); const bf16_t* Kb = (const bf16_t*)(ws_ + OFF_RWK); const bf16_t* Vb = (const bf16_t*)(ws_ + OFF_RWV);
    const bf16_t* Ab = (const bf16_t*)(ws_ + OFF_RWA); const bf16_t* Bb = (const bf16_t*)(ws_ + OFF_RWB);
    const float* Wb = (const float*)(ws_ + OFF_RWW); float* Y = (float*)(ws_ + OFF_RWY);
    if (lane == 0) sRole[wid] = (int)((__builtin_amdgcn_s_getreg(2308)) & 3);
    __syncthreads();
    int role = -1;
    {
        int simd[8];
#pragma unroll
        for (int w = 0; w < 8; ++w) simd[w] = sRole[w];
        unsigned used_simd = 0u, scan_mask = 0u; int nscan = 0;
#pragma unroll
        for (int w = 0; w < 8; ++w) { const unsigned bit = 1u << simd[w]; if (!(used_simd & bit) && nscan < 4) { used_simd |= bit; scan_mask |= 1u << w; ++nscan; } }
#pragma unroll
        for (int w = 0; w < 8; ++w) { if (!((scan_mask >> w) & 1u) && nscan < 4) { scan_mask |= 1u << w; ++nscan; } }
        const int below = __builtin_popcount(scan_mask & ((1u << wid) - 1u));
        role = ((scan_mask >> wid) & 1u) ? below : 4 + (wid - below);
    }
    role = __builtin_amdgcn_readfirstlane(role);
    __syncthreads();
    const bool helper = role >= 4;
    const int lt = (role - 4) * 64 + lane;
    const bool hvec = lt < 128;
    const int hr = (lt >> 4) & 7, hc = lt & 15;
    struct Pre { u32x2 r1, k1, a1, b1, r2, k2, a2, b2; f32x4 w1, w2; };
    auto issue = [&](int chunk, Pre& q) {
        const size_t o1 = (size_t)(chunk * CH + 2 * hr) * 512 + head * 64 + 4 * hc, o2 = o1 + 512;
        if (hvec) {
            q.r1 = *(const u32x2*)(R + o1); q.k1 = *(const u32x2*)(Kb + o1); q.a1 = *(const u32x2*)(Ab + o1); q.b1 = *(const u32x2*)(Bb + o1); q.w1 = *(const f32x4*)(Wb + o1);
            q.r2 = *(const u32x2*)(R + o2); q.k2 = *(const u32x2*)(Kb + o2); q.a2 = *(const u32x2*)(Ab + o2); q.b2 = *(const u32x2*)(Bb + o2); q.w2 = *(const f32x4*)(Wb + o2);
        } else { q.r1 = *(const u32x2*)(Vb + o1); q.r2 = *(const u32x2*)(Vb + o2); }
    };
    auto cv4 = [&](const u32x2& w) { f32x4 f; f[0] = __uint_as_float(w.x << 16); f[1] = __uint_as_float(w.x & 0xFFFF0000u); f[2] = __uint_as_float(w.y << 16); f[3] = __uint_as_float(w.y & 0xFFFF0000u); return f; };
    auto sum4 = [&](const f32x4& x) { return (x[0] + x[1]) + (x[2] + x[3]); };
    auto commit = [&](int bi, const Pre& q) {
        float* base = stg + bi * BUF;
        if (hvec) {
            const f32x4 r1 = cv4(q.r1), k1 = cv4(q.k1), a1 = cv4(q.a1), b1 = cv4(q.b1), r2 = cv4(q.r2), k2 = cv4(q.k2), a2 = cv4(q.a2), b2 = cv4(q.b2), w1 = q.w1, w2 = q.w2;
            float* vp = base + hr * (9 * 64) + 4 * hc;
            *(f32x4*)(vp + 0 * 64) = a1;
            *(f32x4*)(vp + 1 * 64) = w1 * a2;
            *(f32x4*)(vp + 2 * 64) = w1 * r1;
            *(f32x4*)(vp + 3 * 64) = w1 * w2;
            *(f32x4*)(vp + 4 * 64) = b1 * w2;
            *(f32x4*)(vp + 5 * 64) = k1 * w2;
            *(f32x4*)(vp + 6 * 64) = b2;
            *(f32x4*)(vp + 7 * 64) = k2;
            *(f32x4*)(vp + 8 * 64) = r2;
            const float be = row16_sum(sum4(b1 * a2)), ka = row16_sum(sum4(k1 * a2)), rb = row16_sum(sum4(b1 * r1)), rk = row16_sum(sum4(k1 * r1));
            if (hc == 0) *(f32x4*)(base + VEC + hr * 4) = (f32x4){be, ka, rb * (1.0f / 16.0f), rk * (1.0f / 16.0f)};
        } else {
            const f32x4 v1 = cv4(q.r1), v2 = cv4(q.r2);
            float* vv = base + VEC + SCL + (hr * 64 + 4 * hc) * 2;
            *(f32x4*)vv = (f32x4){v1[0], v2[0], v1[1], v2[1]}; *(f32x4*)(vv + 4) = (f32x4){v1[2], v2[2], v1[3], v2[3]};
        }
    };
    auto reduce_store = [&](int chunk) {
        const int t = lt >> 4, k = (lt >> 2) & 3, rr = lt & 3;
        const f32x4* pp = (const f32x4*)(part + ((chunk & 1) * CH + t) * 256 + k * 64 + rr * 16);
        const f32x4 s4 = pp[0] + pp[1] + pp[2] + pp[3];
        Y[(size_t)(chunk * CH + t) * 512 + head * 64 + quarter * 16 + k * 4 + rr] = (s4[0] + s4[1]) + (s4[2] + s4[3]);
    };
    Pre pr0, pr1, pr2, pr3;
    if (helper) { issue(0, pr0); commit(0, pr0); issue(1, pr1); issue(2, pr2); issue(3, pr3); }
    __syncthreads();
    const int row = quarter * 16 + role * 4 + (lane >> 4), cgp = (lane & 15) * 4;
    f32x2 s01 = {0.f, 0.f}, s23 = {0.f, 0.f};
    if (helper) {
        for (int c0 = 0; c0 < NCH; c0 += 4) {
#define RW_HELP(u, PNEXT, PCUR) { const int c = c0 + (u); if (c + 1 < NCH) commit((c + 1) & 1, PNEXT); if (c + 4 < NCH) issue(c + 4, PCUR); if (c > 0) reduce_store(c - 1); RAW_BAR; }
            RW_HELP(0, pr1, pr0) RW_HELP(1, pr2, pr1) RW_HELP(2, pr3, pr2) RW_HELP(3, pr0, pr3)
#undef RW_HELP
        }
    } else for (int chunk = 0; chunk < NCH; ++chunk) {
        {
            const float* bb = stg + (chunk & 1) * BUF;
            float* pw = part + (chunk & 1) * (CH * 256) + role * 64 + lane;
            f32x4 A1, A2, R1, WW, BW, KW, B2, K2, R2, SC; f32x2 VV;
            f32x4 A1n, A2n, R1n, WWn, BWn, KWn, B2n, K2n, R2n, SCn; f32x2 VVn;
            {
                const float* vp = bb + cgp;
                A1n = *(const f32x4*)(vp); A2n = *(const f32x4*)(vp + 64); R1n = *(const f32x4*)(vp + 128); WWn = *(const f32x4*)(vp + 192); BWn = *(const f32x4*)(vp + 256);
                KWn = *(const f32x4*)(vp + 320); B2n = *(const f32x4*)(vp + 384); K2n = *(const f32x4*)(vp + 448); R2n = *(const f32x4*)(vp + 512);
                SCn = *(const f32x4*)(bb + VEC); VVn = *(const f32x2*)(bb + VEC + SCL + row * 2);
            }
#pragma unroll
            for (int rd = 0; rd < NR; ++rd) {
                A1 = A1n; A2 = A2n; R1 = R1n; WW = WWn; BW = BWn; KW = KWn; B2 = B2n; K2 = K2n; R2 = R2n; SC = SCn; VV = VVn;
                const bool pf = (rd + 1 < NR);
                const float* vp = bb + (rd + 1) * (9 * 64) + cgp;
                const float v1 = VV[0], v2 = VV[1];
                const f32x2 p1 = s01 * (f32x2){A1[0], A1[1]} + s23 * (f32x2){A1[2], A1[3]};
                const f32x2 p2 = s01 * (f32x2){A2[0], A2[1]} + s23 * (f32x2){A2[2], A2[3]};
                const f32x2 p3 = s01 * (f32x2){R1[0], R1[1]} + s23 * (f32x2){R1[2], R1[3]};
                float sa1 = p1[0] + p1[1], u2 = p2[0] + p2[1];
                SBM;
                if (pf) { A1n = *(const f32x4*)(vp); A2n = *(const f32x4*)(vp + 64); }
                SBM;
                sa1 += dpp_f<0xB1>(sa1); u2 += dpp_f<0xB1>(u2);
                SBM;
                if (pf) { R1n = *(const f32x4*)(vp + 128); WWn = *(const f32x4*)(vp + 192); }
                f32x2 t01 = s01 * (f32x2){WW[0], WW[1]} + v1 * (f32x2){KW[0], KW[1]};
                SBM;
                sa1 += dpp_f<0x4E>(sa1); u2 += dpp_f<0x4E>(u2);
                SBM;
                if (pf) { BWn = *(const f32x4*)(vp + 256); KWn = *(const f32x4*)(vp + 320); }
                f32x2 t23 = s23 * (f32x2){WW[2], WW[3]} + v1 * (f32x2){KW[2], KW[3]};
                SBM;
                sa1 += dpp_f<0x141>(sa1); u2 += dpp_f<0x141>(u2);
                SBM;
                if (pf) { B2n = *(const f32x4*)(vp + 384); K2n = *(const f32x4*)(vp + 448); }
                t01 += v2 * (f32x2){K2[0], K2[1]}; t23 += v2 * (f32x2){K2[2], K2[3]};
                SBM;
                sa1 += dpp_f<0x140>(sa1); u2 += dpp_f<0x140>(u2);
                SBM;
                if (pf) { R2n = *(const f32x4*)(vp + 512); SCn = *(const f32x4*)(bb + VEC + (rd + 1) * 4); VVn = *(const f32x2*)(bb + VEC + SCL + ((rd + 1) * 64 + row) * 2); }
                const float sa2 = __builtin_fmaf(sa1, SC[0], __builtin_fmaf(v1, SC[1], u2));
                t01 += sa1 * (f32x2){BW[0], BW[1]}; t23 += sa1 * (f32x2){BW[2], BW[3]};
                pw[(2 * rd) * 256] = __builtin_fmaf(sa1, SC[2], __builtin_fmaf(v1, SC[3], p3[0] + p3[1]));
                s01 = t01 + sa2 * (f32x2){B2[0], B2[1]}; s23 = t23 + sa2 * (f32x2){B2[2], B2[3]};
                const f32x2 p4 = s01 * (f32x2){R2[0], R2[1]} + s23 * (f32x2){R2[2], R2[3]};
                pw[(2 * rd + 1) * 256] = p4[0] + p4[1];
            }
        }
        RAW_BAR;
    }
    if (helper) reduce_store(NCH - 1);
    __threadfence();
    __syncthreads();
}
#undef SBM
#undef RAW_BAR

DEVI void rwkv_post(const Params& p, int l, int bid, int nb) {
    int tid_ = threadIdx.x; asm volatile("" : "+v"(tid_)); size_t wz_ = 0; asm volatile("" : "+s"(wz_)); unsigned char* ws_ = p.ws + wz_;
    const int wid = tid_ >> 6, lane = tid_ & 63, c = wid * 64 + lane;
    const bf16_t* R = (const bf16_t*)(ws_ + OFF_RWR); const bf16_t* Kb = (const bf16_t*)(ws_ + OFF_RWK); const bf16_t* Vb = (const bf16_t*)(ws_ + OFF_RWV);
    const bf16_t* Gb = (const bf16_t*)(ws_ + OFF_RWG); const float* Y = (const float*)(ws_ + OFF_RWY);
    bf16_t* O = (bf16_t*)(ws_ + OFF_ORWKV);
    const float rk = ((const float*)p.in[18])[l * 512 + c], lw = ((const float*)p.in[19])[l * 512 + c], lb = ((const float*)p.in[20])[l * 512 + c];
    for (int tok = bid; tok < S; tok += nb) {
        const size_t o = (size_t)tok * 512 + c;
        const float y = Y[o], r = bf2f(R[o]), k = bf2f(Kb[o]), v = bf2f(Vb[o]), g = bf2f(Gb[o]);
        const float mean = wave_sum(y) * (1.0f / 64.0f);
        const float dv = y - mean;
        const float var = wave_sum(dv * dv) * (1.0f / 64.0f);
        const float yn = dv * rsqrtf(var + 64e-5f) * lw + lb;
        const float bonus = wave_sum(r * k * rk) * v;
        O[o] = f2bf((yn + bonus) * g);
    }
}

template <int NQ>
DEVI void attn_compute(const bf16x8 (&kf0)[4], const bf16x8 (&kf1)[4], const bf16x8 (&vf)[8],
                       const bf16x8 (&qf)[NQ][4], const unsigned (&vmask)[NQ], f32x4 (&o)[NQ][8], float (&m)[NQ], float (&l)[NQ]) {
#pragma unroll
    for (int q = 0; q < NQ; ++q) {
        f32x4 s0 = {0.f, 0.f, 0.f, 0.f}, s1 = {0.f, 0.f, 0.f, 0.f};
#pragma unroll
        for (int ks = 0; ks < 4; ++ks) {
            s0 = __builtin_amdgcn_mfma_f32_16x16x32_bf16(kf0[ks], qf[q][ks], s0, 0, 0, 0);
            s1 = __builtin_amdgcn_mfma_f32_16x16x32_bf16(kf1[ks], qf[q][ks], s1, 0, 0, 0);
        }
        float sv[8];
#pragma unroll
        for (int j = 0; j < 4; ++j) { sv[j] = ((vmask[q] >> j) & 1u) ? s0[j] : -1e30f; sv[4 + j] = ((vmask[q] >> (4 + j)) & 1u) ? s1[j] : -1e30f; }
        float cm = sv[0];
#pragma unroll
        for (int j = 1; j < 8; ++j) cm = fmaxf(cm, sv[j]);
        cm = fmaxf(cm, __shfl_xor(cm, 16)); cm = fmaxf(cm, __shfl_xor(cm, 32));
        const float mn = fmaxf(m[q], cm);
        const float alpha = __expf(m[q] - mn);
        m[q] = mn;
        float pr[8]; float ps = 0.f;
#pragma unroll
        for (int j = 0; j < 8; ++j) { pr[j] = __expf(sv[j] - mn); ps += pr[j]; }
        l[q] = l[q] * alpha + ps;
        union { u32x4 u; bf16x8 h; } pb;
        pb.u.x = cvt_pk_bf16(pr[0], pr[1]); pb.u.y = cvt_pk_bf16(pr[2], pr[3]); pb.u.z = cvt_pk_bf16(pr[4], pr[5]); pb.u.w = cvt_pk_bf16(pr[6], pr[7]);
#pragma unroll
        for (int dt = 0; dt < 8; ++dt) { o[q][dt] *= alpha; o[q][dt] = __builtin_amdgcn_mfma_f32_16x16x32_bf16(vf[dt], pb.h, o[q][dt], 0, 0, 0); }
    }
}
template <int NQ>
DEVI void attn_chunk(const bf16_t* k0p, const bf16_t* k1p, const bf16_t* vtp, size_t vt_stride16,
                     const bf16x8 (&qf)[NQ][4], const unsigned (&vmask)[NQ], f32x4 (&o)[NQ][8], float (&m)[NQ], float (&l)[NQ]) {
    bf16x8 kf0[4], kf1[4], vf[8];
#pragma unroll
    for (int ks = 0; ks < 4; ++ks) { kf0[ks] = *(const bf16x8*)(k0p + ks * 32); kf1[ks] = *(const bf16x8*)(k1p + ks * 32); }
#pragma unroll
    for (int dt = 0; dt < 8; ++dt) vf[dt] = *(const bf16x8*)(vtp + (size_t)dt * vt_stride16);
    attn_compute<NQ>(kf0, kf1, vf, qf, vmask, o, m, l);
}

DEVI void vtrans_tile(const Params& p, unsigned char* smem, int a, int ptile) {
    int tid_ = threadIdx.x; asm volatile("" : "+v"(tid_)); size_t wz_ = 0; asm volatile("" : "+s"(wz_)); unsigned char* ws_ = p.ws + wz_;
    const int dil = a < 2 ? 1 : (a < 4 ? 4 : (a < 6 ? 16 : 1));
    const int arr = a < 6 ? 12 + a : 26 + (a - 6);
    const bf16_t* V = (const bf16_t*)(ws_ + OFF_P2) + (size_t)arr * ((size_t)S * 128);
    bf16_t* VT = (bf16_t*)(ws_ + OFF_VT) + (size_t)a * ((size_t)S * 128);
    bf16_t* sT = (bf16_t*)smem;
    const int tid = tid_, p0 = ptile * 64, per = S / dil;
    {
        const int r = tid >> 3, seg = (tid & 7) * 16;
        const int pos = p0 + r, rho = pos / per, mm = pos % per, tok = mm * dil + rho;
        const u32x4 w0 = *(const u32x4*)(V + (size_t)tok * 128 + seg), w1 = *(const u32x4*)(V + (size_t)tok * 128 + seg + 8);
        unsigned* d = (unsigned*)(sT + r * 130 + seg);
        d[0] = w0.x; d[1] = w0.y; d[2] = w0.z; d[3] = w0.w; d[4] = w1.x; d[5] = w1.y; d[6] = w1.z; d[7] = w1.w;
    }
    __syncthreads();
    {
        const int dim = tid >> 2, part = (tid & 3) * 16;
        unsigned w[8];
#pragma unroll
        for (int i = 0; i < 8; ++i) w[i] = (unsigned)sT[(part + 2 * i) * 130 + dim] | ((unsigned)sT[(part + 2 * i + 1) * 130 + dim] << 16);
        u32x4 o0 = {w[0], w[1], w[2], w[3]}, o1 = {w[4], w[5], w[6], w[7]};
        bf16_t* dp = VT + (size_t)dim * S + p0 + part;
        *(u32x4*)dp = o0; *(u32x4*)(dp + 8) = o1;
    }
    __syncthreads();
}

DEVI void moba_kmean(const Params& p, unsigned char* smem, int item) {
    int tid_ = threadIdx.x; asm volatile("" : "+v"(tid_)); size_t wz_ = 0; asm volatile("" : "+s"(wz_)); unsigned char* ws_ = p.ws + wz_;
    const int head = item >> 6, nbk = item & 63, tid = tid_, d = tid & 127, tq = tid >> 7;
    const bf16_t* K = (const bf16_t*)(ws_ + OFF_P2) + (size_t)(22 + head) * ((size_t)S * 128);
    float* red = (float*)smem;
    float a = 0.f;
    for (int i = 0; i < 64; ++i) a += bf2f(K[(size_t)(nbk * 256 + tq * 64 + i) * 128 + d]);
    red[tq * 128 + d] = a;
    __syncthreads();
    if (tid < 128) ((float*)(ws_ + OFF_KM))[(size_t)item * 128 + tid] = (red[tid] + red[128 + tid] + red[256 + tid] + red[384 + tid]) * (1.0f / 256.0f);
    __syncthreads();
}

#define TOP3_INSERT(v, i, v1, v2, v3, i1, i2, i3) do { const float _v = (v); const int _i = (i); \
    const bool _g1 = _v > v1, _g2 = _v > v2, _g3 = _v > v3; \
    const float _n3 = _g2 ? v2 : (_g3 ? _v : v3); const int _m3 = _g2 ? i2 : (_g3 ? _i : i3); \
    const float _n2 = _g1 ? v1 : (_g2 ? _v : v2); const int _m2 = _g1 ? i1 : (_g2 ? _i : i2); \
    const float _n1 = _g1 ? _v : v1; const int _m1 = _g1 ? _i : i1; \
    v1 = _n1; v2 = _n2; v3 = _n3; i1 = _m1; i2 = _m2; i3 = _m3; } while (0)

DEVI void moba_gate(const Params& p, unsigned char* smem, int item) {
    int tid_ = threadIdx.x; asm volatile("" : "+v"(tid_)); size_t wz_ = 0; asm volatile("" : "+s"(wz_)); unsigned char* ws_ = p.ws + wz_;
    const int head = item >> 6, qb = item & 63, cur = qb, tid = tid_;
    unsigned long long* sel = (unsigned long long*)(ws_ + OFF_SEL) + (size_t)head * S + qb * 256;
    unsigned* sQ = (unsigned*)smem;
    float* sKm = (float*)(smem + 256 * 65 * 4);
    const bf16_t* Q = (const bf16_t*)(ws_ + OFF_P2) + (size_t)(18 + head) * ((size_t)S * 128) + (size_t)qb * 256 * 128;
    for (int e = tid; e < 256 * 64; e += NT) sQ[(e >> 6) * 65 + (e & 63)] = ((const unsigned*)Q)[e];
    const float* KM = (const float*)(ws_ + OFF_KM) + (size_t)head * 64 * 128;
    for (int e = tid; e < cur * 128; e += NT) sKm[e] = KM[e];
    __syncthreads();
    const int q = tid >> 1, part = tid & 1;
    float v1 = -INFINITY, v2 = -INFINITY, v3 = -INFINITY; int i1 = -1, i2 = -1, i3 = -1;
    for (int n = part; n < cur; n += 2) {
        float dot = 0.f;
#pragma unroll 4
        for (int w = 0; w < 64; ++w) {
            const unsigned qq = sQ[q * 65 + w];
            dot += __uint_as_float(qq << 16) * sKm[n * 128 + 2 * w] + __uint_as_float(qq & 0xFFFF0000u) * sKm[n * 128 + 2 * w + 1];
        }
        TOP3_INSERT(dot, n, v1, v2, v3, i1, i2, i3);
    }
    const float pv1 = __shfl_xor(v1, 1), pv2 = __shfl_xor(v2, 1), pv3 = __shfl_xor(v3, 1);
    const int pi1 = __shfl_xor(i1, 1), pi2 = __shfl_xor(i2, 1), pi3 = __shfl_xor(i3, 1);
    TOP3_INSERT(pv1, pi1, v1, v2, v3, i1, i2, i3);
    TOP3_INSERT(pv2, pi2, v1, v2, v3, i1, i2, i3);
    TOP3_INSERT(pv3, pi3, v1, v2, v3, i1, i2, i3);
    unsigned long long mk = 0ull;
    if (i1 >= 0) mk |= 1ull << i1;
    if (i2 >= 0) mk |= 1ull << i2;
    if (i3 >= 0) mk |= 1ull << i3;
    if (part == 0) sel[q] = mk;
    __syncthreads();
}

constexpr int MB_KROW = 272, MB_VROW = 144, MB_KBYTES = 64 * MB_KROW, MB_BUF = MB_KBYTES + 128 * MB_VROW;
DEVI void moba_attn(const Params& p, unsigned char* smem, int item) {
    int tid_ = threadIdx.x; asm volatile("" : "+v"(tid_)); size_t wz_ = 0; asm volatile("" : "+s"(wz_)); unsigned char* ws_ = p.ws + wz_;
    const int head = item & 3, qb = 63 - (item >> 2);
    const int tid = tid_, wid = tid >> 6, lane = tid & 63, li = lane & 15, g = lane >> 4;
    LAS unsigned char* lds = (LAS unsigned char*)smem;
    const bf16_t* Q = (const bf16_t*)(ws_ + OFF_P2) + (size_t)(18 + head) * ((size_t)S * 128);
    const bf16_t* K = (const bf16_t*)(ws_ + OFF_P2) + (size_t)(22 + head) * ((size_t)S * 128);
    const bf16_t* VT = (const bf16_t*)(ws_ + OFF_VT) + (size_t)(6 + head) * ((size_t)S * 128);
    const unsigned long long* sel = (const unsigned long long*)(ws_ + OFF_SEL) + (size_t)head * S;
    const int qbase = qb * 256 + wid * 32;
    bf16x8 qf[2][4]; unsigned long long sm[2]; f32x4 o[2][8]; float m[2], l[2];
#pragma unroll
    for (int qt = 0; qt < 2; ++qt) {
        const int qi = qbase + qt * 16 + li;
#pragma unroll
        for (int ks = 0; ks < 4; ++ks) qf[qt][ks] = *(const bf16x8*)(Q + (size_t)qi * 128 + ks * 32 + g * 8);
        sm[qt] = sel[qi]; m[qt] = -1e30f; l[qt] = 0.f;
#pragma unroll
        for (int dt = 0; dt < 8; ++dt) o[qt][dt] = (f32x4){0.f, 0.f, 0.f, 0.f};
    }
    const int krow_s = tid >> 3, kseg = (tid & 7) * 16;
    const int vdim_s = tid >> 2, vpart = (tid & 3) * 16;
    u32x4 rk0, rk1, rv0, rv1;
    auto issue = [&](int st) {
        const bf16_t* kp = K + (size_t)(st * 64 + krow_s) * 128 + kseg;
        rk0 = *(const u32x4*)kp; rk1 = *(const u32x4*)(kp + 8);
        const bf16_t* vp = VT + (size_t)vdim_s * S + st * 64 + vpart;
        rv0 = *(const u32x4*)vp; rv1 = *(const u32x4*)(vp + 8);
    };
    auto commit = [&](int bi) {
        LAS unsigned char* kb = lds + bi * MB_BUF + krow_s * MB_KROW + kseg * 2;
        *(LAS u32x4*)kb = rk0; *(LAS u32x4*)(kb + 16) = rk1;
        LAS unsigned char* vb = lds + bi * MB_BUF + MB_KBYTES + vdim_s * MB_VROW + vpart * 2;
        *(LAS u32x4*)vb = rv0; *(LAS u32x4*)(vb + 16) = rv1;
    };
    const int nst = (qb + 1) * 4;
    issue(0); commit(0);
    __syncthreads();
    const int krow = 8 * (li >> 2) + (li & 3);
    for (int st = 0; st < nst; ++st) {
        if (st + 1 < nst) issue(st + 1);
        const int n = st >> 2;
        LAS unsigned char* kb = lds + (st & 1) * MB_BUF;
        LAS unsigned char* vb = kb + MB_KBYTES;
#pragma unroll
        for (int c = 0; c < 2; ++c) {
            const int c0 = st * 64 + c * 32;
            unsigned vm[2];
            if (n < qb) { vm[0] = ((sm[0] >> n) & 1ull) ? 0xFFu : 0u; vm[1] = ((sm[1] >> n) & 1ull) ? 0xFFu : 0u; }
            else {
#pragma unroll
                for (int qt = 0; qt < 2; ++qt) {
                    const int qpos = qbase + qt * 16 + li; unsigned mk = 0u;
#pragma unroll
                    for (int j = 0; j < 8; ++j) { const int key = c0 + 8 * g + (j & 3) + 4 * (j >> 2); mk |= (key <= qpos) ? (1u << j) : 0u; }
                    vm[qt] = mk;
                }
            }
            if (__ballot((vm[0] | vm[1]) != 0u) != 0ull) {
                bf16x8 kf0[4], kf1[4], vf[8];
#pragma unroll
                for (int ks = 0; ks < 4; ++ks) {
                    kf0[ks] = *(const LAS bf16x8*)(kb + (c * 32 + krow) * MB_KROW + (ks * 32 + g * 8) * 2);
                    kf1[ks] = *(const LAS bf16x8*)(kb + (c * 32 + krow + 4) * MB_KROW + (ks * 32 + g * 8) * 2);
                }
#pragma unroll
                for (int dt = 0; dt < 8; ++dt) vf[dt] = *(const LAS bf16x8*)(vb + (16 * dt + li) * MB_VROW + (c * 32 + 8 * g) * 2);
                attn_compute<2>(kf0, kf1, vf, qf, vm, o, m, l);
            }
        }
        if (st + 1 < nst) commit((st + 1) & 1);
        __syncthreads();
    }
    bf16_t* O = (bf16_t*)(ws_ + OFF_OMOBA);
#pragma unroll
    for (int qt = 0; qt < 2; ++qt) {
        float lt = l[qt]; lt += __shfl_xor(lt, 16); lt += __shfl_xor(lt, 32);
        const float inv = __builtin_amdgcn_rcpf(lt);
        const int qi = qbase + qt * 16 + li;
#pragma unroll
        for (int dt = 0; dt < 8; ++dt) {
            const f32x4 v = o[qt][dt] * inv;
            u32x2 w; w.x = cvt_pk_bf16(v[0], v[1]); w.y = cvt_pk_bf16(v[2], v[3]);
            *(u32x2*)(O + (size_t)qi * 512 + head * 128 + dt * 16 + 4 * g) = w;
        }
    }
}

DEVI void dil_attn(const Params& p, int item) {
    int tid_ = threadIdx.x; asm volatile("" : "+v"(tid_)); size_t wz_ = 0; asm volatile("" : "+s"(wz_)); unsigned char* ws_ = p.ws + wz_;
    const int hp = item & 1, T0 = (item >> 1) * 256;
    const int tid = tid_, wid = tid >> 6, lane = tid & 63, li = lane & 15, g = lane >> 4;
    const int krow = 8 * (li >> 2) + (li & 3);
    bf16_t* O = (bf16_t*)(ws_ + OFF_ODIL);
    for (int rr = 0; rr < 2; ++rr) {
        const int rho16 = 2 * wid + rr;
        const int tq = T0 + rho16 + 16 * li;
        f32x4 o[1][8]; float m[1], l[1];
        m[0] = -1e30f; l[0] = 0.f;
#pragma unroll
        for (int dt = 0; dt < 8; ++dt) o[0][dt] = (f32x4){0.f, 0.f, 0.f, 0.f};
        for (int gi = 0; gi < 3; ++gi) {
            const int dil = gi == 0 ? 1 : (gi == 1 ? 4 : 16);
            const int head = 2 * gi + hp, per = S / dil;
            const bf16_t* Q = (const bf16_t*)(ws_ + OFF_P2) + (size_t)(head) * ((size_t)S * 128);
            const bf16_t* K = (const bf16_t*)(ws_ + OFF_P2) + (size_t)(6 + head) * ((size_t)S * 128);
            const bf16_t* VT = (const bf16_t*)(ws_ + OFF_VT) + (size_t)head * ((size_t)S * 128);
            bf16x8 qf[1][4];
#pragma unroll
            for (int ks = 0; ks < 4; ++ks) qf[0][ks] = *(const bf16x8*)(Q + (size_t)tq * 128 + ks * 32 + g * 8);
            const int rho = rho16 % dil;
            const int qm = tq / dil;
            const int qm0 = (T0 + rho16) / dil, qm15 = (T0 + rho16 + 240) / dil;
            const int lo = qm0 - 128;
            int c0 = (lo >> 5) << 5;
            if (c0 < 0) c0 = (c0 < -32) ? 0 : c0;
            if (lo < 0 && c0 < 0 && c0 + 31 < 0) c0 = 0;
            for (; c0 <= qm15; c0 += 32) {
                unsigned vm[1]; unsigned mk = 0u;
#pragma unroll
                for (int j = 0; j < 8; ++j) { const int kap = c0 + 8 * g + (j & 3) + 4 * (j >> 2); mk |= (kap >= 0 && kap <= qm && qm - kap <= 128) ? (1u << j) : 0u; }
                vm[0] = mk;
                int ka0 = c0 + krow, ka1 = ka0 + 4;
                ka0 = ka0 < 0 ? 0 : (ka0 > per - 1 ? per - 1 : ka0); ka1 = ka1 < 0 ? 0 : (ka1 > per - 1 ? per - 1 : ka1);
                int sg = c0 + 8 * g; sg = sg < 0 ? 0 : (sg > per - 8 ? per - 8 : sg);
                const bf16_t* k0p = K + (size_t)(ka0 * dil + rho) * 128 + g * 8;
                const bf16_t* k1p = K + (size_t)(ka1 * dil + rho) * 128 + g * 8;
                attn_chunk<1>(k0p, k1p, VT + (size_t)li * S + (size_t)rho * per + sg, (size_t)16 * S, qf, vm, o, m, l);
            }
        }
        float lt = l[0]; lt += __shfl_xor(lt, 16); lt += __shfl_xor(lt, 32);
        const float inv = __builtin_amdgcn_rcpf(lt);
#pragma unroll
        for (int dt = 0; dt < 8; ++dt) {
            const f32x4 v = o[0][dt] * inv;
            u32x2 w; w.x = cvt_pk_bf16(v[0], v[1]); w.y = cvt_pk_bf16(v[2], v[3]);
            *(u32x2*)(O + (size_t)tq * 256 + hp * 128 + dt * 16 + 4 * g) = w;
        }
    }
}

DEVI void sub_barrier(unsigned* ctr, unsigned target) {
    __threadfence();
    __syncthreads();
    if (threadIdx.x == 0) {
        __threadfence();
        __hip_atomic_fetch_add(ctr, 1u, __ATOMIC_RELEASE, __HIP_MEMORY_SCOPE_AGENT);
        while (__hip_atomic_load(ctr, __ATOMIC_ACQUIRE, __HIP_MEMORY_SCOPE_AGENT) < target) __builtin_amdgcn_s_sleep(8);
        __threadfence();
    }
    __syncthreads();
}
#ifndef PHASE_MASK
#define PHASE_MASK 0xFFFFFFFFu
#endif
#define PH(k) ((PHASE_MASK >> (k)) & 1u)
#ifndef PROBE_MASK
#define PROBE_MASK 0u
#endif
#define REPS(k) (1 + (int)((PROBE_MASK >> (k)) & 1u))
__global__ void __launch_bounds__(512, 2) fwd_megakernel(Params p) {
    extern __shared__ __attribute__((aligned(16))) unsigned char smem[];
    cg::grid_group grid = cg::this_grid();
    const int bid = blockIdx.x, nb = gridDim.x;
    unsigned char* ws = p.ws;
    const float* mod = (const float*)(ws + OFF_MOD);

    if (bid == 0 && threadIdx.x < 4) ((unsigned*)(ws + OFF_BAR))[threadIdx.x * 64] = 0u;
    if (PH(0)) phase_mod_rope(p, smem, bid, nb);
    __syncthreads();
    for (int rep = 0; rep < REPS(5); ++rep) if (PH(1)) phase_convert(p, 0, smem, bid, nb);
    grid.sync();

    for (int l = 0; l < NL; ++l) {
        const float* ml = mod + l * 12288;
        const float* xin = (l == 0) ? (const float*)p.in[0] : p.out;
        for (int rep = 0; rep < REPS(4); ++rep) if (PH(2)) phase_norm(xin, (const float*)p.in[5] + l * D, ml, ml + 2048, (bf16_t*)(ws + OFF_H), bid, nb);
        for (int rep = 0; rep < REPS(5); ++rep) if (PH(1) && l > 0) phase_convert(p, l, smem, bid, nb);
        grid.sync();
        {
            EpiInProj E; E.G = (bf16_t*)(ws + OFF_G); E.P1G = (bf16_t*)(ws + OFF_P1G); E.P1R = (bf16_t*)(ws + OFF_P1R); E.P2 = (bf16_t*)(ws + OFF_P2);
            E.cosT = (const float*)(ws + OFF_COS); E.sinT = (const float*)(ws + OFF_SIN);
            for (int rep = 0; rep < REPS(0); ++rep) if (PH(3)) run_gemm(smem, (const bf16_t*)(ws + OFF_H), (const bf16_t*)(ws + OFF_WIN), IN_PAD, D, E);
        }
        grid.sync();
        for (int it = bid; it < 1024; it += nb) rwkv_prep(p, l, smem, it);
        grid.sync();
        if (bid < 32) rwkv_scan(p, smem, bid);
        else {
            const int b2 = bid - 32, nb2 = nb - 32;
            unsigned* ctr = (unsigned*)(ws + OFF_BAR) + l * 128;
            for (int it = b2; it < 1024 + 256 + 2560; it += nb2) {
                if (it < 1024) gla_pass1(p, l, smem, it);
                else if (it < 1280) moba_kmean(p, smem, it - 1024);
                else { const int j = it - 1280; vtrans_tile(p, smem, j >> 8, j & 255); }
            }
            sub_barrier(ctr, (unsigned)nb2);
            for (int it = b2; it < 64 + 256; it += nb2) {
                if (it < 64) gla_pass2(p, it);
                else moba_gate(p, smem, it - 64);
            }
            sub_barrier(ctr + 64, (unsigned)nb2);
            for (int it = b2; it < 256 + 128 + 1024; it += nb2) {
                if (it < 256) moba_attn(p, smem, it);
                else if (it < 384) dil_attn(p, it - 256);
                else gla_pass3(p, l, smem, it - 384);
            }
        }
        grid.sync();
        if (PH(14)) rwkv_post(p, l, bid, nb);
        grid.sync();
        {
            EpiBranch E; E.Mg = (bf16_t*)(ws + OFF_MERGED);
            E.Gb = (const bf16_t*)(ws + OFF_G); E.first = 1;
            if (PH(15)) run_gemm(smem, (const bf16_t*)(ws + OFF_OGLA), (const bf16_t*)(ws + OFF_WBA), D, 512, E);
            E.Gb = (const bf16_t*)(ws + OFF_G) + 2048; E.first = 0;
            if (PH(15)) run_gemm(smem, (const bf16_t*)(ws + OFF_ODIL), (const bf16_t*)(ws + OFF_WBB), D, 256, E);
            E.Gb = (const bf16_t*)(ws + OFF_G) + 4096;
            if (PH(15)) run_gemm(smem, (const bf16_t*)(ws + OFF_ORWKV), (const bf16_t*)(ws + OFF_WBC), D, 512, E);
            E.Gb = (const bf16_t*)(ws + OFF_G) + 6144;
            if (PH(15)) run_gemm(smem, (const bf16_t*)(ws + OFF_OMOBA), (const bf16_t*)(ws + OFF_WBD), D, 512, E);
        }
        grid.sync();
        {
            EpiResid E; E.src = xin; E.dst = p.out; E.gate = ml + 4096;
            if (PH(16)) run_gemm(smem, (const bf16_t*)(ws + OFF_MERGED), (const bf16_t*)(ws + OFF_WOUT), D, D, E);
        }
        grid.sync();
        for (int rep = 0; rep < REPS(4); ++rep) if (PH(2)) phase_norm(p.out, (const float*)p.in[29] + l * D, ml + 6144, ml + 8192, (bf16_t*)(ws + OFF_H), bid, nb);
        grid.sync();
        {
            EpiSwiglu E; E.act = (bf16_t*)(ws + OFF_ACT);
            for (int rep = 0; rep < REPS(1); ++rep) if (PH(17)) run_gemm(smem, (const bf16_t*)(ws + OFF_H), (const bf16_t*)(ws + OFF_WF1), 2 * FFN_H, D, E);
        }
        grid.sync();
        {
            EpiResid E; E.src = p.out; E.dst = p.out; E.gate = ml + 10240;
            if (PH(16)) run_gemm(smem, (const bf16_t*)(ws + OFF_ACT), (const bf16_t*)(ws + OFF_WF2), D, FFN_H, E);
        }
        grid.sync();
    }
    if (PH(18)) phase_final_norm(p.out, (const float*)p.in[32], bid, nb);
}

extern "C" void kernel_launch(void* const* d_in, const int* in_sizes, int n_in, void* d_out, int out_size, void* d_ws, size_t ws_size, hipStream_t stream) {
    static int grid_blocks = 0;
    if (grid_blocks == 0) {
        if (n_in != 33 || ws_size < WS_END) { fprintf(stderr, "kernel_launch: unexpected n_in %d or ws_size %zu (< %zu)\n", n_in, ws_size, (size_t)WS_END); grid_blocks = -1; return; }
        int dev = 0, cus = 0, per_cu = 0;
        hipGetDevice(&dev);
        hipDeviceGetAttribute(&cus, hipDeviceAttributeMultiprocessorCount, dev);
        if (hipFuncSetAttribute((const void*)fwd_megakernel, hipFuncAttributeMaxDynamicSharedMemorySize, LDS_BYTES) != hipSuccess) { fprintf(stderr, "kernel_launch: hipFuncSetAttribute failed\n"); grid_blocks = -1; return; }
        hipOccupancyMaxActiveBlocksPerMultiprocessor(&per_cu, (const void*)fwd_megakernel, NT, LDS_BYTES);
        if (per_cu < 1) { fprintf(stderr, "kernel_launch: occupancy query says 0 blocks per CU\n"); per_cu = 1; }
        grid_blocks = cus * 1;
        (void)hipGetLastError();
    }
    if (grid_blocks < 0) return;
    Params p{};
    for (int i = 0; i < 33; ++i) p.in[i] = d_in[i];
    p.out = (float*)d_out; p.ws = (unsigned char*)d_ws;
    void* args[] = {&p};
    hipError_t e = hipLaunchCooperativeKernel((const void*)fwd_megakernel, dim3(grid_blocks), dim3(NT), args, LDS_BYTES, stream);
    if (e != hipSuccess) fprintf(stderr, "cooperative launch failed: %s (grid %d)\n", hipGetErrorString(e), grid_blocks);
}
```

```cpp
#include <hip/hip_runtime.h>
#include <hip/hip_cooperative_groups.h>
#include <cstdio>
#include <cstdint>
namespace cg = cooperative_groups;

typedef unsigned short bf16_t;
typedef short bf16x8 __attribute__((ext_vector_type(8)));
typedef float f32x4 __attribute__((ext_vector_type(4)));
typedef float f32x2 __attribute__((ext_vector_type(2)));
typedef unsigned u32x4 __attribute__((ext_vector_type(4)));
typedef unsigned u32x2 __attribute__((ext_vector_type(2)));
#define LAS __attribute__((address_space(3)))
#define DEVI __device__ __forceinline__

constexpr int S = 16384, D = 2048, NL = 2;
constexpr int IN_TOTAL = 15568, IN_PAD = 15872;
constexpr int FFN_H = 5632;
constexpr int NT = 512;
constexpr int LDS_BYTES = 131072;

constexpr size_t SZ_HEADARR = (size_t)S * 128 * 2;
constexpr size_t OFF_WIN = 0;
constexpr size_t OFF_WBA = OFF_WIN + (size_t)IN_PAD * D * 2;
constexpr size_t OFF_WBB = OFF_WBA + (size_t)D * 512 * 2;
constexpr size_t OFF_WBC = OFF_WBB + (size_t)D * 256 * 2;
constexpr size_t OFF_WBD = OFF_WBC + (size_t)D * 512 * 2;
constexpr size_t OFF_WOUT = OFF_WBD + (size_t)D * 512 * 2;
constexpr size_t OFF_WF1 = OFF_WOUT + (size_t)D * D * 2;
constexpr size_t OFF_WF2 = OFF_WF1 + (size_t)2 * FFN_H * D * 2;
constexpr size_t WB_END = OFF_WF2 + (size_t)D * FFN_H * 2;
constexpr size_t OFF_VT = OFF_WIN;
constexpr size_t OFF_G = WB_END;
constexpr size_t OFF_P1G = OFF_G + (size_t)S * 8192 * 2;
constexpr size_t OFF_P1R = OFF_P1G + (size_t)S * 1792 * 2;
constexpr size_t OFF_P2 = OFF_P1R + (size_t)S * 2048 * 2;
constexpr size_t OFF_ACT = OFF_P1G;
constexpr size_t OFF_H = OFF_P2 + 30 * SZ_HEADARR;
constexpr size_t OFF_OGLA = OFF_H;
constexpr size_t OFF_ODIL = OFF_OGLA + (size_t)S * 512 * 2;
constexpr size_t OFF_ORWKV = OFF_ODIL + (size_t)S * 256 * 2;
constexpr size_t OFF_OMOBA = OFF_ORWKV + (size_t)S * 512 * 2;
constexpr size_t OFF_X = OFF_H + (size_t)S * D * 2;
constexpr size_t SZ_B512 = (size_t)S * 512 * 2;
constexpr size_t OFF_RWR = OFF_X;
constexpr size_t OFF_RWK = OFF_RWR + SZ_B512;
constexpr size_t OFF_RWV = OFF_RWK + SZ_B512;
constexpr size_t OFF_RWA = OFF_RWV + SZ_B512;
constexpr size_t OFF_RWB = OFF_RWA + SZ_B512;
constexpr size_t OFF_RWG = OFF_RWB + SZ_B512;
constexpr size_t OFF_RWW = OFF_RWG + SZ_B512;
constexpr size_t OFF_RWY = OFF_RWW + (size_t)S * 512 * 4;
constexpr size_t OFF_GLL = OFF_RWY + (size_t)S * 512 * 4;
constexpr size_t OFF_GLB = OFF_GLL + (size_t)256 * 4 * 64 * 128 * 4;
constexpr size_t OFF_GLD = OFF_GLB + (size_t)S * 256 * 4;
constexpr size_t OFF_MERGED = OFF_X;
constexpr size_t OFF_VF = OFF_GLD + (size_t)256 * 4 * 64 * 4;
constexpr size_t OFF_MOD = OFF_VF + SZ_B512;
constexpr size_t OFF_COS = OFF_MOD + (size_t)2 * 12288 * 4;
constexpr size_t OFF_SIN = OFF_COS + (size_t)S * 16 * 4;
constexpr size_t OFF_KM = OFF_SIN + (size_t)S * 16 * 4;
constexpr size_t OFF_SEL = OFF_KM + (size_t)4 * 64 * 128 * 4;
constexpr size_t OFF_LORA = OFF_SEL + (size_t)4 * S * 8;
constexpr size_t OFF_BAR = OFF_LORA + (size_t)512 * 448 * 2;
constexpr size_t WS_END = OFF_BAR + 4 * 256;

struct Params {
    const void* in[33];
    float* out;
    unsigned char* ws;
};

DEVI float bf2f(bf16_t b) { return __uint_as_float(((unsigned)b) << 16); }
typedef __bf16 bf16x2_t __attribute__((ext_vector_type(2)));
DEVI unsigned cvt_pk_bf16(float lo, float hi) {
    const f32x2 v = {lo, hi}; const bf16x2_t r = __builtin_convertvector(v, bf16x2_t); return __builtin_bit_cast(unsigned, r);
}
DEVI bf16_t f2bf(float f) { return (bf16_t)cvt_pk_bf16(f, 0.f); }
DEVI float sigmoidf_(float x) { return __builtin_amdgcn_rcpf(1.0f + __expf(-x)); }
DEVI float siluf_(float x) { return x * __builtin_amdgcn_rcpf(1.0f + __expf(-x)); }
DEVI float wave_sum(float v) {
#pragma unroll
    for (int o = 32; o >= 1; o >>= 1) v += __shfl_xor(v, o);
    return v;
}
template <int CTRL> DEVI float dpp_f(float v) { return __int_as_float(__builtin_amdgcn_update_dpp(0, __float_as_int(v), CTRL, 0xF, 0xF, true)); }
DEVI float row16_sum(float v) {
    v += dpp_f<0xB1>(v);
    v += dpp_f<0x4E>(v);
    v += dpp_f<0x141>(v);
    v += dpp_f<0x140>(v);
    return v;
}

namespace pg8 {
constexpr int BM = 256, BK = 64, HALF = 128, HTB = HALF * BK * 2, STAGE_BYTES = 8 * HTB, NXCD = 8, WGM = 8;
DEVI int lds_byte(int r, int c) { const int st = (r >> 4) * 2 + (c >> 5), rr = r & 15, cc = c & 31, ob = rr * 64 + cc * 2; return st * 1024 + (ob ^ (((ob >> 9) & 1) << 5)); }
DEVI void stage_rc(int b, int& R, int& C) { const int st = b / 1024, sb = b % 1024, swz = sb ^ (((sb >> 9) & 1) << 5); R = (st >> 1) * 16 + swz / 64; C = (st & 1) * 32 + (swz % 64) / 2; }
DEVI int perm32(int rho) { const int n = rho >> 4, i = rho & 15; return 8 * (i >> 2) + 4 * n + (i & 3); }
struct Unit { int pm, pn; };
struct Gemm { const bf16_t* A; const bf16_t* Bt; int M, N, K; };
struct StaticOrder {
    int nM, nN, nwg, G, c;
    DEVI void init(int M, int N, int G_, int c_) { nM = M / BM; nN = N / BM; nwg = nM * nN; G = G_; c = c_; }
    DEVI bool next(int i, Unit& u) const {
        const long L = (long)i * G + c; if (L >= nwg) return false;
        int wgid = (int)L; { const int q = nwg / NXCD, r = nwg % NXCD, xcd = wgid % NXCD, off = wgid / NXCD; wgid = (xcd < r ? xcd * (q + 1) : r * (q + 1) + (xcd - r) * q) + off; }
        const int nig = WGM * nN, gid = wgid / nig, fm = gid * WGM, gsz = (nM - fm) < WGM ? (nM - fm) : WGM;
        u.pm = fm + ((wgid % nig) % gsz); u.pn = (wgid % nig) / gsz; return true;
    }
};
template <class Epi>
DEVI void gemm_phase(LAS unsigned char* lds, const Gemm g, const StaticOrder& S_, const Epi& E) {
    int tid_ = threadIdx.x; asm volatile("" : "+v"(tid_));
    int K_ = g.K; asm volatile("" : "+s"(K_));
    const int tid = tid_, wid = __builtin_amdgcn_readfirstlane(tid >> 6), lane = tid & 63, wr = wid >> 2, wc = wid & 3, fr = lane & 15, fq = lane >> 4;
    const int K = K_, nt = K / BK;
    unsigned voffA[2], voffB[2];
#pragma unroll
    for (int i = 0; i < 2; ++i) { int R, C; stage_rc(tid * 16 + i * 8192, R, C); const int Rb = (R & ~31) + perm32(R & 31);
        voffA[i] = (unsigned)(R * K + C) * 2u; voffB[i] = (unsigned)(Rb * K + C) * 2u; }
    const size_t kstep = (size_t)(BK * 2);
    const size_t hstep = (size_t)HALF * K * 2;
    const size_t tstep = 2 * hstep;
    const unsigned ldsw = (unsigned)wid * 1024u;
    const int aoff = lds_byte(wr * 64 + fr, fq * 8), boff = lds_byte(wc * 32 + fr, fq * 8);
#define PG8_SA(b, h) (((b) * 2 + (h)) * HTB)
#define PG8_SB(b, h) ((4 + (b) * 2 + (h)) * HTB)
#define PG8_STAGE(bufoff, gbase, voff) do { _Pragma("unroll") for (int _i = 0; _i < 2; ++_i) \
        __builtin_amdgcn_global_load_lds((const unsigned*)((const char*)(gbase) + (voff)[_i]), (LAS unsigned*)(lds + (bufoff) + ldsw + _i * 8192), 16, 0, 0); } while (0)
#define PG8_LDA(dst, b, h) do { _Pragma("unroll") for (int m = 0; m < 4; ++m) _Pragma("unroll") for (int k = 0; k < 2; ++k) dst[m][k] = *(const LAS bf16x8*)(lds + PG8_SA(b, h) + aoff + m * 2048 + k * 1024); } while (0)
#define PG8_LDB(dst, b, h) do { _Pragma("unroll") for (int n = 0; n < 2; ++n) _Pragma("unroll") for (int k = 0; k < 2; ++k) dst[n][k] = *(const LAS bf16x8*)(lds + PG8_SB(b, h) + boff + n * 2048 + k * 1024); } while (0)
#define PG8_MMA(ai, bj, At, Bt) do { __builtin_amdgcn_s_setprio(1); _Pragma("unroll") for (int m = 0; m < 4; ++m) _Pragma("unroll") for (int n = 0; n < 2; ++n) _Pragma("unroll") for (int k = 0; k < 2; ++k) \
        acc[ai][bj][m][n] = __builtin_amdgcn_mfma_f32_16x16x32_bf16(Bt[n][k], At[m][k], acc[ai][bj][m][n], 0, 0, 0); __builtin_amdgcn_s_setprio(0); } while (0)
#define PG8_WAIT_V(n) asm volatile("s_waitcnt vmcnt(" #n ")" ::: "memory")
#define PG8_WAIT_L(n) asm volatile("s_waitcnt lgkmcnt(" #n ")" ::: "memory")
#define PG8_BAR __builtin_amdgcn_s_barrier()
#define PG8_SCHED __builtin_amdgcn_sched_barrier(0)
    Unit cur, nxt; int ui = 0;
    if (!S_.next(0, cur)) return;
    f32x4 acc[2][2][4][2];
#pragma unroll
    for (int a = 0; a < 2; ++a)
#pragma unroll
        for (int b = 0; b < 2; ++b)
#pragma unroll
            for (int m = 0; m < 4; ++m)
#pragma unroll
                for (int n = 0; n < 2; ++n) acc[a][b][m][n] = (f32x4){0.f, 0.f, 0.f, 0.f};
    bf16x8 At[4][2], B0[2][2], B1[2][2];
    const char* cA = (const char*)g.A + (size_t)cur.pm * tstep; const char* cB = (const char*)g.Bt + (size_t)cur.pn * tstep;
    PG8_STAGE(PG8_SB(0, 0), cB, voffB); PG8_STAGE(PG8_SA(0, 0), cA, voffA); PG8_STAGE(PG8_SB(0, 1), cB + hstep, voffB); PG8_STAGE(PG8_SA(0, 1), cA + hstep, voffA);
    if (wr == 1) PG8_BAR;
    PG8_WAIT_V(4); PG8_BAR;
    PG8_STAGE(PG8_SB(1, 0), cB + kstep, voffB); PG8_STAGE(PG8_SA(1, 0), cA + kstep, voffA); PG8_STAGE(PG8_SB(1, 1), cB + hstep + kstep, voffB);
    PG8_WAIT_V(6); PG8_BAR;
    for (;;) {
        const bool has_next = S_.next(ui + 1, nxt);
        const char* nA = has_next ? (const char*)g.A + (size_t)nxt.pm * tstep : cA; const char* nB = has_next ? (const char*)g.Bt + (size_t)nxt.pn * tstep : cB;
        for (int t = 0; t < nt; t += 2) {
            const bool last = (t == nt - 2);
            const char* a1 = cA + (size_t)(t + 1) * kstep;
            const char* a2 = last ? nA : cA + (size_t)(t + 2) * kstep; const char* b2 = last ? nB : cB + (size_t)(t + 2) * kstep;
            const char* a3 = a2 + kstep; const char* b3 = b2 + kstep;
            PG8_LDB(B0, 0, 0); PG8_SCHED; PG8_LDA(At, 0, 0); PG8_STAGE(PG8_SA(1, 1), a1 + hstep, voffA);
            PG8_WAIT_L(8); PG8_BAR; PG8_WAIT_L(0); PG8_MMA(0, 0, At, B0); PG8_BAR; PG8_SCHED;
            PG8_LDB(B1, 0, 1); PG8_STAGE(PG8_SB(0, 0), b2, voffB);
            PG8_BAR; PG8_WAIT_L(0); PG8_MMA(0, 1, At, B1); PG8_BAR;
            PG8_LDA(At, 0, 1); PG8_STAGE(PG8_SA(0, 0), a2, voffA);
            PG8_BAR; PG8_WAIT_L(0); PG8_MMA(1, 0, At, B0); PG8_BAR; PG8_SCHED;
            PG8_STAGE(PG8_SB(0, 1), b2 + hstep, voffB);
            PG8_WAIT_V(6); PG8_BAR; PG8_MMA(1, 1, At, B1); PG8_BAR;
            PG8_LDB(B0, 1, 0); PG8_SCHED; PG8_LDA(At, 1, 0); PG8_STAGE(PG8_SA(0, 1), a2 + hstep, voffA);
            PG8_WAIT_L(8); PG8_BAR; PG8_WAIT_L(0); PG8_MMA(0, 0, At, B0); PG8_BAR; PG8_SCHED;
            PG8_LDB(B1, 1, 1); PG8_STAGE(PG8_SB(1, 0), b3, voffB);
            PG8_BAR; PG8_WAIT_L(0); PG8_MMA(0, 1, At, B1); PG8_BAR;
            PG8_LDA(At, 1, 1); PG8_STAGE(PG8_SA(1, 0), a3, voffA);
            PG8_BAR; PG8_WAIT_L(0); PG8_MMA(1, 0, At, B0); PG8_BAR; PG8_SCHED;
            PG8_STAGE(PG8_SB(1, 1), b3 + hstep, voffB);
            PG8_WAIT_V(6); PG8_BAR; PG8_MMA(1, 1, At, B1); PG8_BAR;
        }
        E(acc, cur, wr, wc, fr, fq);
        if (!has_next) break;
#pragma unroll
        for (int a = 0; a < 2; ++a)
#pragma unroll
            for (int b = 0; b < 2; ++b)
#pragma unroll
                for (int m = 0; m < 4; ++m)
#pragma unroll
                    for (int n = 0; n < 2; ++n) acc[a][b][m][n] = (f32x4){0.f, 0.f, 0.f, 0.f};
        cur = nxt; cA = nA; cB = nB; ++ui;
    }
    PG8_WAIT_V(0);
    if (wr == 0) PG8_BAR;
    PG8_BAR;
#undef PG8_SA
#undef PG8_SB
#undef PG8_STAGE
#undef PG8_LDA
#undef PG8_LDB
#undef PG8_MMA
#undef PG8_WAIT_V
#undef PG8_WAIT_L
#undef PG8_BAR
#undef PG8_SCHED
}
}
using pg8::Unit;

struct EpiInProj {
    bf16_t *G, *P1G, *P1R, *P2; const float *cosT, *sinT;
    DEVI void operator()(const f32x4 (&acc)[2][2][4][2], const Unit& u, int wr, int wc, int fr, int fq) const {
        const int pn = u.pn; const int row0 = u.pm * 256 + wr * 64 + fr; const int cl = wc * 32 + 8 * fq;
        const bool plain = (pn < 39) || (pn >= 48 && pn < 56);
        if (plain) {
            bf16_t* base; int ld, pnl; bool sg = false;
            if (pn < 32) { base = G; ld = 8192; pnl = pn; sg = true; }
            else if (pn < 39) { base = P1G; ld = 1792; pnl = pn - 32; }
            else { base = P1R; ld = 2048; pnl = pn - 48; }
#pragma unroll
            for (int ai = 0; ai < 2; ++ai)
#pragma unroll
                for (int m = 0; m < 4; ++m) {
                    bf16_t* rowp = base + (size_t)(row0 + ai * 128 + m * 16) * ld + pnl * 256 + cl;
#pragma unroll
                    for (int bj = 0; bj < 2; ++bj) {
                        f32x4 v0 = acc[ai][bj][m][0], v1 = acc[ai][bj][m][1];
                        if (sg) {
#pragma unroll
                            for (int j = 0; j < 4; ++j) { v0[j] = sigmoidf_(v0[j]); v1[j] = sigmoidf_(v1[j]); }
                        }
                        u32x4 w; w.x = cvt_pk_bf16(v0[0], v0[1]); w.y = cvt_pk_bf16(v0[2], v0[3]); w.z = cvt_pk_bf16(v1[0], v1[1]); w.w = cvt_pk_bf16(v1[2], v1[3]);
                        *(u32x4*)(rowp + bj * 128) = w;
                    }
                    __builtin_amdgcn_sched_barrier(0);
                }
        } else {
            int t, hbase, arr0;
            if (pn < 48) { const int pl = pn - 39; t = pl / 3; hbase = (pl % 3) * 2; arr0 = t * 6 + hbase; }
            else { const int pl = pn - 56; t = pl / 2; hbase = (pl % 2) * 2; arr0 = 18 + t * 4 + hbase; }
            const bool rope = (t < 2) && (wc == 0);
            const float sc = (t == 0) ? 0.08838834764831845f : 1.0f;
#pragma unroll
            for (int ai = 0; ai < 2; ++ai)
#pragma unroll
                for (int m = 0; m < 4; ++m) {
                    const int row = row0 + ai * 128 + m * 16;
#pragma unroll
                    for (int bj = 0; bj < 2; ++bj) {
                        f32x4 v0 = acc[ai][bj][m][0], v1 = acc[ai][bj][m][1];
                        if (rope) {
                            const f32x4 c0 = *(const f32x4*)(cosT + (size_t)row * 16 + 8 * (fq & 1)), c1 = *(const f32x4*)(cosT + (size_t)row * 16 + 8 * (fq & 1) + 4);
                            const f32x4 s0 = *(const f32x4*)(sinT + (size_t)row * 16 + 8 * (fq & 1)), s1 = *(const f32x4*)(sinT + (size_t)row * 16 + 8 * (fq & 1) + 4);
                            const float sgn = (fq < 2) ? -1.0f : 1.0f;
#pragma unroll
                            for (int j = 0; j < 4; ++j) {
                                const float p0 = __shfl_xor(v0[j], 32), p1 = __shfl_xor(v1[j], 32);
                                v0[j] = v0[j] * c0[j] + sgn * p0 * s0[j];
                                v1[j] = v1[j] * c1[j] + sgn * p1 * s1[j];
                            }
                        }
                        v0 *= sc; v1 *= sc;
                        bf16_t* dst = P2 + (size_t)(arr0 + bj) * ((size_t)S * 128) + (size_t)row * 128 + cl;
                        u32x4 w; w.x = cvt_pk_bf16(v0[0], v0[1]); w.y = cvt_pk_bf16(v0[2], v0[3]); w.z = cvt_pk_bf16(v1[0], v1[1]); w.w = cvt_pk_bf16(v1[2], v1[3]);
                        *(u32x4*)dst = w;
                    }
                    __builtin_amdgcn_sched_barrier(0);
                }
        }
    }
};

struct EpiBranch {
    const bf16_t* Gb; bf16_t* Mg; int first;
    DEVI void operator()(const f32x4 (&acc)[2][2][4][2], const Unit& u, int wr, int wc, int fr, int fq) const {
        const int row0 = u.pm * 256 + wr * 64 + fr; const int col0 = u.pn * 256 + wc * 32 + 8 * fq;
        u32x4 gwn[2], mwn[2];
        {
            const int row = row0;
#pragma unroll
            for (int bj = 0; bj < 2; ++bj) { gwn[bj] = *(const u32x4*)(Gb + (size_t)row * 8192 + col0 + bj * 128); mwn[bj] = first ? (u32x4){0u, 0u, 0u, 0u} : *(const u32x4*)(Mg + (size_t)row * 2048 + col0 + bj * 128); }
        }
#pragma unroll
        for (int idx = 0; idx < 8; ++idx) {
            const int ai = idx >> 2, m = idx & 3;
            const int row = row0 + ai * 128 + m * 16;
            u32x4 gw[2], mw[2];
#pragma unroll
            for (int bj = 0; bj < 2; ++bj) { gw[bj] = gwn[bj]; mw[bj] = mwn[bj]; }
            if (idx + 1 < 8) {
                const int rown = row0 + ((idx + 1) >> 2) * 128 + ((idx + 1) & 3) * 16;
#pragma unroll
                for (int bj = 0; bj < 2; ++bj) { gwn[bj] = *(const u32x4*)(Gb + (size_t)rown * 8192 + col0 + bj * 128); mwn[bj] = first ? (u32x4){0u, 0u, 0u, 0u} : *(const u32x4*)(Mg + (size_t)rown * 2048 + col0 + bj * 128); }
            }
            asm volatile("" ::: "memory"); __builtin_amdgcn_sched_barrier(0);
#pragma unroll
            for (int bj = 0; bj < 2; ++bj) {
                float o[8];
#pragma unroll
                for (int j = 0; j < 4; ++j) { o[j] = acc[ai][bj][m][0][j]; o[4 + j] = acc[ai][bj][m][1][j]; }
#pragma unroll
                for (int j = 0; j < 4; ++j) {
                    o[2 * j] = o[2 * j] * __uint_as_float(gw[bj][j] << 16) + __uint_as_float(mw[bj][j] << 16);
                    o[2 * j + 1] = o[2 * j + 1] * __uint_as_float(gw[bj][j] & 0xFFFF0000u) + __uint_as_float(mw[bj][j] & 0xFFFF0000u);
                }
                u32x4 w; w.x = cvt_pk_bf16(o[0], o[1]); w.y = cvt_pk_bf16(o[2], o[3]); w.z = cvt_pk_bf16(o[4], o[5]); w.w = cvt_pk_bf16(o[6], o[7]);
                *(u32x4*)(Mg + (size_t)row * 2048 + col0 + bj * 128) = w;
            }
            asm volatile("" ::: "memory"); __builtin_amdgcn_sched_barrier(0);
        }
    }
};

struct EpiResid {
    const float* src; float* dst; const float* gate;
    DEVI void operator()(const f32x4 (&acc)[2][2][4][2], const Unit& u, int wr, int wc, int fr, int fq) const {
        const int row0 = u.pm * 256 + wr * 64 + fr; const int col0 = u.pn * 256 + wc * 32 + 8 * fq;
        f32x4 gv[2][2];
#pragma unroll
        for (int bj = 0; bj < 2; ++bj)
#pragma unroll
            for (int n = 0; n < 2; ++n) gv[bj][n] = *(const f32x4*)(gate + col0 + bj * 128 + 4 * n);
#pragma unroll
        for (int ai = 0; ai < 2; ++ai)
#pragma unroll
            for (int m = 0; m < 4; ++m) {
                const size_t ro = (size_t)(row0 + ai * 128 + m * 16) * 2048 + col0;
#pragma unroll
                for (int bj = 0; bj < 2; ++bj)
#pragma unroll
                    for (int n = 0; n < 2; ++n) {
                        const f32x4 xv = *(const f32x4*)(src + ro + bj * 128 + 4 * n);
                        *(f32x4*)(dst + ro + bj * 128 + 4 * n) = xv + gv[bj][n] * acc[ai][bj][m][n];
                    }
                __builtin_amdgcn_sched_barrier(0);
            }
    }
};

struct EpiSwiglu {
    bf16_t* act;
    DEVI void operator()(const f32x4 (&acc)[2][2][4][2], const Unit& u, int wr, int wc, int fr, int fq) const {
        const int row0 = u.pm * 256 + wr * 64 + fr; const int col0 = u.pn * 128 + wc * 32 + 8 * fq;
#pragma unroll
        for (int ai = 0; ai < 2; ++ai)
#pragma unroll
            for (int m = 0; m < 4; ++m) {
                float o[8];
#pragma unroll
                for (int j = 0; j < 4; ++j) { o[j] = siluf_(acc[ai][0][m][0][j]) * acc[ai][1][m][0][j]; o[4 + j] = siluf_(acc[ai][0][m][1][j]) * acc[ai][1][m][1][j]; }
                u32x4 w; w.x = cvt_pk_bf16(o[0], o[1]); w.y = cvt_pk_bf16(o[2], o[3]); w.z = cvt_pk_bf16(o[4], o[5]); w.w = cvt_pk_bf16(o[6], o[7]);
                *(u32x4*)(act + (size_t)(row0 + ai * 128 + m * 16) * FFN_H + col0) = w;
                __builtin_amdgcn_sched_barrier(0);
            }
    }
};

template <class Epi>
DEVI void run_gemm(unsigned char* smem, const bf16_t* A, const bf16_t* Bt, int N, int K, const Epi& E) {
    pg8::Gemm g; g.A = A; g.Bt = Bt; g.M = S; g.N = N; g.K = K;
    pg8::StaticOrder so; so.init(S, N, gridDim.x, blockIdx.x);
    pg8::gemm_phase<Epi>((LAS unsigned char*)smem, g, so, E);
}

DEVI int srccol_win(int n) {
    if (n < 8192) return n;
    if (n < 9984) { const int j = n - 8192; return j < 1552 ? 8192 + j : -1; }
    if (n < 12288) return 9744 + (n - 9984);
    if (n < 14336) { const int j = n - 12288; return j < 1984 ? 12048 + j : -1; }
    return 14032 + (n - 14336);
}
DEVI int srccol_ffn(int n) { return ((n >> 7) & 1) * FFN_H + (n >> 8) * 128 + (n & 127); }

DEVI void conv_tile(unsigned char* smem, const float* src, int ldsrc, int K, bf16_t* dst, int mode, int ntile, int ktile) {
    int tid_ = threadIdx.x; asm volatile("" : "+v"(tid_));
    float* tile = (float*)smem;
    const int tid = tid_, tx = tid & 63, ty = tid >> 6;
    const int n0 = ntile * 64, k0 = ktile * 64;
    const int n = n0 + tx;
    const int sc = mode == 0 ? srccol_win(n) : (mode == 1 ? srccol_ffn(n) : n);
#pragma unroll
    for (int i = 0; i < 8; ++i) {
        const int kk = ty + 8 * i;
        tile[kk * 65 + tx] = sc >= 0 ? src[(size_t)(k0 + kk) * ldsrc + sc] : 0.0f;
    }
    __syncthreads();
    const int nr = tid >> 3, ks = (tid & 7) * 8;
    float v[8];
#pragma unroll
    for (int j = 0; j < 8; ++j) v[j] = tile[(ks + j) * 65 + nr];
    u32x4 w; w.x = cvt_pk_bf16(v[0], v[1]); w.y = cvt_pk_bf16(v[2], v[3]); w.z = cvt_pk_bf16(v[4], v[5]); w.w = cvt_pk_bf16(v[6], v[7]);
    *(u32x4*)(dst + (size_t)(n0 + nr) * K + k0 + ks) = w;
    __syncthreads();
}

DEVI void phase_convert(const Params& p, int l, unsigned char* smem, int bid, int nb) {
    const int c0 = 248 * 32, c1 = c0 + 32 * 8, c2 = c1 + 32 * 4, c3 = c2 + 32 * 8, c4 = c3 + 32 * 8, c5 = c4 + 32 * 32, c6 = c5 + 176 * 32, c7 = c6 + 32 * 88;
    unsigned char* ws = p.ws;
    {
        int tl_ = threadIdx.x; asm volatile("" : "+v"(tl_)); int ll_ = l; asm volatile("" : "+s"(ll_));
        size_t wzz_ = 0; asm volatile("" : "+s"(wzz_));
        bf16_t* WT = (bf16_t*)(ws + wzz_ + OFF_LORA);
        const float* w2 = (const float*)p.in[12] + (size_t)ll_ * 96 * 512; const float* a2 = (const float*)p.in[14] + (size_t)ll_ * 96 * 512; const float* g2 = (const float*)p.in[15] + (size_t)ll_ * 256 * 512;
        for (int k = bid; k < 448; k += nb) {
            const int n = tl_;
            const float v = k < 96 ? w2[k * 512 + n] : (k < 192 ? a2[(k - 96) * 512 + n] : g2[(k - 192) * 512 + n]);
            WT[n * 448 + k] = f2bf(v);
        }
    }
    for (int it = bid; it < c7; it += nb) {
        if (it < c0) { conv_tile(smem, (const float*)p.in[6] + (size_t)l * D * IN_TOTAL, IN_TOTAL, D, (bf16_t*)(ws + OFF_WIN), 0, it / 32, it % 32); }
        else if (it < c1) { const int j = it - c0; conv_tile(smem, (const float*)p.in[24] + (size_t)l * 512 * D, D, 512, (bf16_t*)(ws + OFF_WBA), 2, j / 8, j % 8); }
        else if (it < c2) { const int j = it - c1; conv_tile(smem, (const float*)p.in[25] + (size_t)l * 256 * D, D, 256, (bf16_t*)(ws + OFF_WBB), 2, j / 4, j % 4); }
        else if (it < c3) { const int j = it - c2; conv_tile(smem, (const float*)p.in[26] + (size_t)l * 512 * D, D, 512, (bf16_t*)(ws + OFF_WBC), 2, j / 8, j % 8); }
        else if (it < c4) { const int j = it - c3; conv_tile(smem, (const float*)p.in[27] + (size_t)l * 512 * D, D, 512, (bf16_t*)(ws + OFF_WBD), 2, j / 8, j % 8); }
        else if (it < c5) { const int j = it - c4; conv_tile(smem, (const float*)p.in[28] + (size_t)l * D * D, D, D, (bf16_t*)(ws + OFF_WOUT), 2, j / 32, j % 32); }
        else if (it < c6) { const int j = it - c5; conv_tile(smem, (const float*)p.in[30] + (size_t)l * D * 2 * FFN_H, 2 * FFN_H, D, (bf16_t*)(ws + OFF_WF1), 1, j / 32, j % 32); }
        else { const int j = it - c6; conv_tile(smem, (const float*)p.in[31] + (size_t)l * FFN_H * D, D, FFN_H, (bf16_t*)(ws + OFF_WF2), 2, j / 88, j % 88); }
    }
}

DEVI void phase_mod_rope(const Params& p, unsigned char* smem, int bid, int nb) {
    int tid_ = threadIdx.x; asm volatile("" : "+v"(tid_)); size_t wz_ = 0; asm volatile("" : "+s"(wz_)); unsigned char* ws_ = p.ws + wz_;
    const int tid = tid_;
    float* sc = (float*)smem;
    float* red = sc + 2048;
    const float* c = (const float*)p.in[1];
    for (int i = tid; i < D; i += NT) sc[i] = siluf_(c[i]);
    __syncthreads();
    float* mod = (float*)(ws_ + OFF_MOD);
    for (int it = bid; it < 192; it += nb) {
        const int l = it / 96, cg0 = (it % 96) * 128;
        const float* W = (const float*)p.in[3] + (size_t)l * D * 12288;
        const int col = tid & 127, kq = tid >> 7;
        float a = 0.f;
        const float* wp = W + (size_t)(kq * 512) * 12288 + cg0 + col;
#pragma unroll 8
        for (int k = 0; k < 512; ++k) a += sc[kq * 512 + k] * wp[(size_t)k * 12288];
        red[kq * 128 + col] = a;
        __syncthreads();
        if (tid < 128) mod[l * 12288 + cg0 + tid] = red[tid] + red[128 + tid] + red[256 + tid] + red[384 + tid] + ((const float*)p.in[4])[l * 12288 + cg0 + tid];
        __syncthreads();
    }
    const float invf[16] = {1.000000000e+00f, 4.403665960e-01f, 1.939227432e-01f, 8.539710194e-02f, 3.760603070e-02f, 1.656043902e-02f, 7.292664610e-03f, 3.211445874e-03f,
                            1.414213562e-03f, 6.227723788e-04f, 2.742481884e-04f, 1.207697351e-04f, 5.318296098e-05f, 2.341999971e-05f, 1.031338616e-05f, 4.541670478e-06f};
    const int* pos = (const int*)p.in[2];
    float* cosT = (float*)(ws_ + OFF_COS); float* sinT = (float*)(ws_ + OFF_SIN);
    for (int e = bid * NT + tid; e < S * 16; e += nb * NT) {
        const int t = e >> 4, i = e & 15;
        float fi = invf[0];
#pragma unroll
        for (int j = 1; j < 16; ++j) fi = (i == j) ? invf[j] : fi;
        const float ang = (float)pos[t] * fi;
        const double a = (double)ang;
        const double kq = __builtin_rint(a * 0.15915494309189535);
        const double r = a - kq * 6.283185307179586;
        const double y = r * 0.25, y2 = y * y;
        double s = y * (1.0 - y2 / 6.0 * (1.0 - y2 / 20.0 * (1.0 - y2 / 42.0 * (1.0 - y2 / 72.0 * (1.0 - y2 / 110.0 * (1.0 - y2 / 156.0))))));
        double cc = 1.0 - y2 / 2.0 * (1.0 - y2 / 12.0 * (1.0 - y2 / 30.0 * (1.0 - y2 / 56.0 * (1.0 - y2 / 90.0 * (1.0 - y2 / 132.0 * (1.0 - y2 / 182.0))))));
        double s2 = 2.0 * s * cc, c2 = 1.0 - 2.0 * s * s;
        double s4 = 2.0 * s2 * c2, c4 = 1.0 - 2.0 * s2 * s2;
        cosT[e] = (float)c4; sinT[e] = (float)s4;
    }
}

DEVI void phase_norm(const float* x, const float* gain, const float* shift, const float* scale, bf16_t* h, int bid, int nb) {
    int tid_ = threadIdx.x; asm volatile("" : "+v"(tid_));
    const int wid = tid_ >> 6, lane = tid_ & 63;
    for (int row = bid * 8 + wid; row < S; row += nb * 8) {
        const f32x4* xr = (const f32x4*)(x + (size_t)row * D);
        f32x4 v[8]; float ss = 0.f;
#pragma unroll
        for (int i = 0; i < 8; ++i) { v[i] = xr[lane + 64 * i]; ss += v[i][0] * v[i][0] + v[i][1] * v[i][1] + v[i][2] * v[i][2] + v[i][3] * v[i][3]; }
        ss = wave_sum(ss);
        const float r = rsqrtf(ss * (1.0f / D) + 1e-6f);
#pragma unroll
        for (int i = 0; i < 8; ++i) {
            const int c4 = lane + 64 * i;
            const f32x4 g = ((const f32x4*)gain)[c4], sh = ((const f32x4*)shift)[c4], sc = ((const f32x4*)scale)[c4];
            f32x4 y = v[i] * r * g * (sc + 1.0f) + sh;
            u32x2 w; w.x = cvt_pk_bf16(y[0], y[1]); w.y = cvt_pk_bf16(y[2], y[3]);
            *(u32x2*)(h + (size_t)row * D + c4 * 4) = w;
        }
    }
}

DEVI void phase_final_norm(float* x, const float* gain, int bid, int nb) {
    int tid_ = threadIdx.x; asm volatile("" : "+v"(tid_));
    const int wid = tid_ >> 6, lane = tid_ & 63;
    for (int row = bid * 8 + wid; row < S; row += nb * 8) {
        f32x4* xr = (f32x4*)(x + (size_t)row * D);
        f32x4 v[8]; float ss = 0.f;
#pragma unroll
        for (int i = 0; i < 8; ++i) { v[i] = xr[lane + 64 * i]; ss += v[i][0] * v[i][0] + v[i][1] * v[i][1] + v[i][2] * v[i][2] + v[i][3] * v[i][3]; }
        ss = wave_sum(ss);
        const float r = rsqrtf(ss * (1.0f / D) + 1e-6f);
#pragma unroll
        for (int i = 0; i < 8; ++i) xr[lane + 64 * i] = v[i] * r * ((const f32x4*)gain)[lane + 64 * i];
    }
}

DEVI float logsigmoidf_(float x) { return fminf(x, 0.f) - log1pf(__expf(-fabsf(x))); }

DEVI void gla_pass1(const Params& p, int l, unsigned char* smem, int item) {
    int tid_ = threadIdx.x; asm volatile("" : "+v"(tid_)); size_t wz_ = 0; asm volatile("" : "+s"(wz_)); unsigned char* ws_ = p.ws + wz_;
    const int n = item >> 2, h = item & 3, tok0 = n * 64, tid = tid_;
    float* sB = (float*)smem;
    float* sK = sB + 4096;
    float* sV = sK + 4096;
    float* sA = sV + 8192;
    float* sW = sA + 1024;
    const bf16_t* P = (const bf16_t*)(ws_ + OFF_P1G);
    const float* wa2 = (const float*)p.in[7] + (size_t)l * 16 * 256;
    const float* ba2 = (const float*)p.in[8] + (size_t)l * 256;
    for (int e = tid; e < 1024; e += NT) { sA[e] = bf2f(P[(size_t)(tok0 + (e >> 4)) * 1792 + 1536 + (e & 15)]); sW[e] = wa2[(e >> 6) * 256 + h * 64 + (e & 63)]; }
    __syncthreads();
    for (int e = tid; e < 4096; e += NT) {
        const int t = e >> 6, d = e & 63;
        float x = ba2[h * 64 + d];
#pragma unroll
        for (int r = 0; r < 16; ++r) x += sA[t * 16 + r] * sW[r * 64 + d];
        sB[e] = logsigmoidf_(x) * (1.0f / 16.0f);
    }
    __syncthreads();
    if (tid < 64) { float a = 0.f; for (int t = 0; t < 64; ++t) { a += sB[t * 64 + tid]; sB[t * 64 + tid] = a; } }
    __syncthreads();
    float* Bbuf = (float*)(ws_ + OFF_GLB);
    for (int e = tid; e < 4096; e += NT) {
        const int s = e >> 6, d = e & 63;
        const float b = sB[e], bl = sB[63 * 64 + d];
        sK[e] = bf2f(P[(size_t)(tok0 + s) * 1792 + 256 + h * 64 + d]) * __expf(bl - b);
        Bbuf[(size_t)(tok0 + s) * 256 + h * 64 + d] = b;
    }
    for (int e = tid; e < 8192; e += NT) sV[e] = bf2f(P[(size_t)(tok0 + (e >> 7)) * 1792 + 512 + h * 128 + (e & 127)]);
    if (tid < 64) ((float*)(ws_ + OFF_GLD))[(size_t)item * 64 + tid] = __expf(sB[63 * 64 + tid]);
    __syncthreads();
    {
        const int d = tid >> 3, eg = (tid & 7) * 16;
        f32x4 a0 = {0, 0, 0, 0}, a1 = a0, a2 = a0, a3 = a0;
        for (int s = 0; s < 64; ++s) {
            const float kd = sK[s * 64 + d];
            const f32x4* vp = (const f32x4*)(sV + s * 128 + eg);
            a0 += kd * vp[0]; a1 += kd * vp[1]; a2 += kd * vp[2]; a3 += kd * vp[3];
        }
        f32x4* Lp = (f32x4*)((float*)(ws_ + OFF_GLL) + ((size_t)item * 64 + d) * 128 + eg);
        Lp[0] = a0; Lp[1] = a1; Lp[2] = a2; Lp[3] = a3;
    }
    __syncthreads();
}

DEVI void gla_pass2(const Params& p, int item) {
    int tid_ = threadIdx.x; asm volatile("" : "+v"(tid_)); size_t wz_ = 0; asm volatile("" : "+s"(wz_)); unsigned char* ws_ = p.ws + wz_;
    const int idx = item * NT + tid_;
    const int h = idx >> 13, de = idx & 8191, d = de >> 7;
    float* L = (float*)(ws_ + OFF_GLL); const float* Dc = (const float*)(ws_ + OFF_GLD);
    float st = 0.f;
    for (int n0 = 0; n0 < 256; n0 += 8) {
        float tmp[8], dc[8];
#pragma unroll
        for (int j = 0; j < 8; ++j) { tmp[j] = L[((size_t)((n0 + j) * 4 + h) * 64) * 128 + de]; dc[j] = Dc[((n0 + j) * 4 + h) * 64 + d]; }
#pragma unroll
        for (int j = 0; j < 8; ++j) { L[((size_t)((n0 + j) * 4 + h) * 64) * 128 + de] = st; st = dc[j] * st + tmp[j]; }
    }
}

DEVI void gla_pass3(const Params& p, int l, unsigned char* smem, int item) {
    int tid_ = threadIdx.x; asm volatile("" : "+v"(tid_)); size_t wz_ = 0; asm volatile("" : "+s"(wz_)); unsigned char* ws_ = p.ws + wz_;
    const int n = item >> 2, h = item & 3, tok0 = n * 64, tid = tid_;
    float* sQ = (float*)smem;
    float* sK = sQ + 4096;
    float* sV = sK + 4160;
    float* sS = sV + 8192;
    float* sSc = sS + 8192;
    const bf16_t* P = (const bf16_t*)(ws_ + OFF_P1G);
    const float* Bbuf = (const float*)(ws_ + OFF_GLB);
    for (int e = tid; e < 4096; e += NT) {
        const int t = e >> 6, d = e & 63;
        const float b = Bbuf[(size_t)(tok0 + t) * 256 + h * 64 + d];
        sQ[e] = bf2f(P[(size_t)(tok0 + t) * 1792 + h * 64 + d]) * 0.125f * __expf(b);
        sK[t * 65 + d] = bf2f(P[(size_t)(tok0 + t) * 1792 + 256 + h * 64 + d]) * __expf(-b);
    }
    const float* Lp = (const float*)(ws_ + OFF_GLL) + (size_t)item * 8192;
    for (int e = tid; e < 8192; e += NT) { sV[e] = bf2f(P[(size_t)(tok0 + (e >> 7)) * 1792 + 512 + h * 128 + (e & 127)]); sS[e] = Lp[e]; }
    __syncthreads();
    {
        const int t = tid >> 3, sg = (tid & 7) * 8;
        float a[8];
#pragma unroll
        for (int j = 0; j < 8; ++j) a[j] = 0.f;
        for (int d = 0; d < 64; ++d) {
            const float qv = sQ[t * 64 + d];
#pragma unroll
            for (int j = 0; j < 8; ++j) a[j] += qv * sK[(sg + j) * 65 + d];
        }
#pragma unroll
        for (int j = 0; j < 8; ++j) sSc[t * 64 + sg + j] = (sg + j <= t) ? a[j] : 0.f;
    }
    __syncthreads();
    {
        const int t = tid >> 3, eg = (tid & 7) * 16;
        f32x4 a0 = {0, 0, 0, 0}, a1 = a0, a2 = a0, a3 = a0;
        for (int d = 0; d < 64; ++d) {
            const float qv = sQ[t * 64 + d];
            const f32x4* sp = (const f32x4*)(sS + d * 128 + eg);
            a0 += qv * sp[0]; a1 += qv * sp[1]; a2 += qv * sp[2]; a3 += qv * sp[3];
        }
        for (int s = 0; s < 64; ++s) {
            const float sc = sSc[t * 64 + s];
            const f32x4* vp = (const f32x4*)(sV + s * 128 + eg);
            a0 += sc * vp[0]; a1 += sc * vp[1]; a2 += sc * vp[2]; a3 += sc * vp[3];
        }
        float ss = 0.f;
#pragma unroll
        for (int j = 0; j < 4; ++j) ss += a0[j] * a0[j] + a1[j] * a1[j] + a2[j] * a2[j] + a3[j] * a3[j];
        ss += __shfl_xor(ss, 1); ss += __shfl_xor(ss, 2); ss += __shfl_xor(ss, 4);
        const float r = rsqrtf(ss * (1.0f / 128.0f) + 1e-6f);
        const float* gn = (const float*)p.in[9] + (size_t)l * 128 + eg;
        const bf16_t* gp = P + (size_t)(tok0 + t) * 1792 + 1024 + h * 128 + eg;
        float o[16];
#pragma unroll
        for (int j = 0; j < 4; ++j) { o[j] = a0[j]; o[4 + j] = a1[j]; o[8 + j] = a2[j]; o[12 + j] = a3[j]; }
#pragma unroll
        for (int j = 0; j < 16; ++j) o[j] = o[j] * r * gn[j] * siluf_(bf2f(gp[j]));
        bf16_t* op = (bf16_t*)(ws_ + OFF_OGLA) + (size_t)(tok0 + t) * 512 + h * 128 + eg;
        u32x4 w0, w1;
        w0.x = cvt_pk_bf16(o[0], o[1]); w0.y = cvt_pk_bf16(o[2], o[3]); w0.z = cvt_pk_bf16(o[4], o[5]); w0.w = cvt_pk_bf16(o[6], o[7]);
        w1.x = cvt_pk_bf16(o[8], o[9]); w1.y = cvt_pk_bf16(o[10], o[11]); w1.z = cvt_pk_bf16(o[12], o[13]); w1.w = cvt_pk_bf16(o[14], o[15]);
        *(u32x4*)op = w0; *(u32x4*)(op + 8) = w1;
    }
    __syncthreads();
}

DEVI void rwkv_prep(const Params& p, int l, unsigned char* smem, int item) {
    int tid_ = threadIdx.x; asm volatile("" : "+v"(tid_)); size_t wz_ = 0; asm volatile("" : "+s"(wz_)); unsigned char* ws_ = p.ws + wz_;
    const int tok0 = item * 16, c = tid_, tid = tid_;
    bf16_t* sX = (bf16_t*)smem;
    float* sAcc = (float*)(smem + 16384);
    float* sVx = (float*)(smem + 16384);
    float* sMid = sVx + 512 * 16;
    const bf16_t* P = (const bf16_t*)(ws_ + OFF_P1R);
    const float* mu = (const float*)p.in[10] + (size_t)l * 1984;
    bf16_t lx[14], lxp[14];
#pragma unroll
    for (int i = 0; i < 14; ++i) {
        const int e = tid + i * NT, t = e / 448, j = e % 448, col = 1536 + j, tok = tok0 + t;
        lx[i] = P[(size_t)tok * 2048 + col]; lxp[i] = tok > 0 ? P[(size_t)(tok - 1) * 2048 + col] : (bf16_t)0;
    }
#pragma unroll
    for (int i = 0; i < 14; ++i) {
        const int e = tid + i * NT;
        const int t = e / 448, j = e % 448, col = 1536 + j;
        const float x = bf2f(lx[i]);
        const float xp = bf2f(lxp[i]);
        const float xs = x + (xp - x) * mu[col];
        float v;
        if (j < 96) { const float e2 = __expf(2.0f * xs); v = 1.0f - 2.0f * __builtin_amdgcn_rcpf(e2 + 1.0f); }
        else if (j < 192) v = xs;
        else v = sigmoidf_(xs);
        sX[t * 456 + j] = f2bf(v);
    }
    const float mu_r = mu[c], mu_k = mu[512 + c], mu_v = mu[1024 + c];
    bf16_t xv[17];
    xv[0] = tok0 > 0 ? P[(size_t)(tok0 - 1) * 2048 + 1024 + c] : (bf16_t)0;
#pragma unroll
    for (int t = 0; t < 16; ++t) xv[t + 1] = P[(size_t)(tok0 + t) * 2048 + 1024 + c];
    __syncthreads();
    {
        const int wid = tid >> 6, lane = tid & 63, li = lane & 15, g = lane >> 4;
        const bf16_t* WT = (const bf16_t*)(ws_ + OFF_LORA);
#pragma unroll
        for (int lo = 0; lo < 3; ++lo) {
            const int kb = lo == 0 ? 0 : (lo == 1 ? 96 : 192), nks = lo == 2 ? 8 : 3;
            f32x4 acc[4];
#pragma unroll
            for (int q = 0; q < 4; ++q) acc[q] = (f32x4){0.f, 0.f, 0.f, 0.f};
            for (int ks = 0; ks < nks; ++ks) {
                const bf16x8 af = *(const bf16x8*)(sX + li * 456 + kb + ks * 32 + g * 8);
#pragma unroll
                for (int q = 0; q < 4; ++q) {
                    const bf16x8 bfr = *(const bf16x8*)(WT + (size_t)((wid * 4 + q) * 16 + li) * 448 + kb + ks * 32 + g * 8);
                    acc[q] = __builtin_amdgcn_mfma_f32_16x16x32_bf16(af, bfr, acc[q], 0, 0, 0);
                }
            }
#pragma unroll
            for (int q = 0; q < 4; ++q)
#pragma unroll
                for (int r = 0; r < 4; ++r) sAcc[(lo * 16 + 4 * g + r) * 512 + (wid * 4 + q) * 16 + li] = acc[q][r];
        }
    }
    __syncthreads();
    float wacc[16], aacc[16], gacc[16];
#pragma unroll
    for (int t = 0; t < 16; ++t) { wacc[t] = sAcc[t * 512 + c]; aacc[t] = sAcc[(16 + t) * 512 + c]; gacc[t] = sAcc[(32 + t) * 512 + c]; }
    __syncthreads();
#pragma unroll
    for (int t = 0; t < 16; ++t) { const float x = bf2f(xv[t + 1]), xp = bf2f(xv[t]); sVx[c * 16 + t] = x + (xp - x) * mu_v; }
    __syncthreads();
    float vacc[16];
#pragma unroll
    for (int t = 0; t < 16; ++t) vacc[t] = 0.f;
    if (l > 0) {
        const float* v1 = (const float*)p.in[22];
        const float* v2 = (const float*)p.in[23];
        {
            const int m = tid & 63, cp = tid >> 6;
            float ma[16];
#pragma unroll
            for (int t = 0; t < 16; ++t) ma[t] = 0.f;
#pragma unroll 8
            for (int cc = 0; cc < 64; ++cc) {
                const float w = v1[(cp * 64 + cc) * 64 + m]; const f32x4* lp = (const f32x4*)(sVx + (cp * 64 + cc) * 16);
#pragma unroll
                for (int q = 0; q < 4; ++q) { const f32x4 x = lp[q]; ma[4 * q] += x[0] * w; ma[4 * q + 1] += x[1] * w; ma[4 * q + 2] += x[2] * w; ma[4 * q + 3] += x[3] * w; }
            }
            float* sP = sMid + 64 * 16;
#pragma unroll
            for (int q = 0; q < 4; ++q) *(f32x4*)(sP + (cp * 64 + m) * 16 + 4 * q) = (f32x4){ma[4 * q], ma[4 * q + 1], ma[4 * q + 2], ma[4 * q + 3]};
            __syncthreads();
            for (int e = tid; e < 1024; e += NT) {
                float a = 0.f;
#pragma unroll
                for (int k = 0; k < 8; ++k) a += sP[k * 1024 + e];
                sMid[e] = a;
            }
        }
        __syncthreads();
#pragma unroll 8
        for (int m = 0; m < 64; ++m) {
            const float w = v2[m * 512 + c]; const f32x4* lp = (const f32x4*)(sMid + m * 16);
#pragma unroll
            for (int q = 0; q < 4; ++q) { const f32x4 x = lp[q]; vacc[4 * q] += x[0] * w; vacc[4 * q + 1] += x[1] * w; vacc[4 * q + 2] += x[2] * w; vacc[4 * q + 3] += x[3] * w; }
        }
    }
    const float w0 = ((const float*)p.in[11])[l * 512 + c], a0 = ((const float*)p.in[13])[l * 512 + c];
    const float k_k = ((const float*)p.in[16])[l * 512 + c], k_a = ((const float*)p.in[17])[l * 512 + c];
    const float v0 = l > 0 ? ((const float*)p.in[21])[c] : 0.f;
    bf16_t* R = (bf16_t*)(ws_ + OFF_RWR); bf16_t* Kb = (bf16_t*)(ws_ + OFF_RWK); bf16_t* Vb = (bf16_t*)(ws_ + OFF_RWV);
    bf16_t* Ab = (bf16_t*)(ws_ + OFF_RWA); bf16_t* Bb = (bf16_t*)(ws_ + OFF_RWB); bf16_t* Gb = (bf16_t*)(ws_ + OFF_RWG);
    float* Wb = (float*)(ws_ + OFF_RWW); bf16_t* VF = (bf16_t*)(ws_ + OFF_VF);
    bf16_t xrr[17], xkr[17], vfr[16];
    xrr[0] = tok0 > 0 ? P[(size_t)(tok0 - 1) * 2048 + c] : (bf16_t)0; xkr[0] = tok0 > 0 ? P[(size_t)(tok0 - 1) * 2048 + 512 + c] : (bf16_t)0;
#pragma unroll
    for (int t = 0; t < 16; ++t) { xrr[t + 1] = P[(size_t)(tok0 + t) * 2048 + c]; xkr[t + 1] = P[(size_t)(tok0 + t) * 2048 + 512 + c]; vfr[t] = l > 0 ? VF[(size_t)(tok0 + t) * 512 + c] : (bf16_t)0; }
#pragma unroll
    for (int t = 0; t < 16; ++t) {
        const size_t tok = tok0 + t;
        const float xr = bf2f(xrr[t + 1]), xk = bf2f(xkr[t + 1]), xpr = bf2f(xrr[t]), xpk = bf2f(xkr[t]);
        const float r = xr + (xpr - xr) * mu_r, k = xk + (xpk - xk) * mu_k;
        float v = sVx[c * 16 + t];
        const float z = -(w0 + wacc[t]);
        const float sp = fmaxf(z, 0.f) + __logf(1.0f + __expf(-fabsf(z)));
        const float decay = __expf(-__expf(-sp - 0.5f));
        const float a = sigmoidf_(a0 + aacc[t]);
        if (l == 0) VF[tok * 512 + c] = f2bf(v);
        else { const float vf = bf2f(vfr[t]); v = v + (vf - v) * sigmoidf_(v0 + vacc[t]); }
        float kk = k * k_k;
        const float ss = wave_sum(kk * kk);
        kk = kk * __builtin_amdgcn_rcpf(fmaxf(__builtin_sqrtf(ss), 1e-12f));
        const float km = k * (1.0f + (a - 1.0f) * k_a);
        R[tok * 512 + c] = f2bf(r); Kb[tok * 512 + c] = f2bf(km); Vb[tok * 512 + c] = f2bf(v);
        Ab[tok * 512 + c] = f2bf(-kk); Bb[tok * 512 + c] = f2bf(kk * a); Gb[tok * 512 + c] = f2bf(gacc[t]);
        Wb[tok * 512 + c] = decay;
    }
    __syncthreads();
}

#define SBM do { asm volatile("" ::: "memory"); __builtin_amdgcn_sched_barrier(0); } while (0)
#define RAW_BAR do { asm volatile("s_waitcnt lgkmcnt(0)" ::: "memory"); __builtin_amdgcn_s_barrier(); asm volatile("" ::: "memory"); } while (0)
DEVI void rwkv_scan(const Params& p, unsigned char* smem, int b) {
    int tid_ = threadIdx.x; asm volatile("" : "+v"(tid_)); size_t wz_ = 0; asm volatile("" : "+s"(wz_)); unsigned char* ws_ = p.ws + wz_;
    constexpr int CH = 16, NR = 8, NCH = S / CH;
    constexpr int VEC = NR * 9 * 64, SCL = NR * 4, VVN = NR * 64 * 2, BUF = VEC + SCL + VVN;
    const int head = b >> 2, quarter = b & 3, tid = tid_, wid = tid >> 6, lane = tid & 63;
    float* stg = (float*)smem;
    float* part = stg + 2 * BUF;
    int* sRole = (int*)(part + 2 * CH * 256);
    const bf16_t* R = (const bf16_t*)(ws_ + OFF_RWR); const bf16_t* Kb = (const bf16_t*)(ws_ + OFF_RWK); const bf16_t* Vb = (const bf16_t*)(ws_ + OFF_RWV);
    const bf16_t* Ab = (const bf16_t*)(ws_ + OFF_RWA); const bf16_t* Bb = (const bf16_t*)(ws_ + OFF_RWB);
    const float* Wb = (const float*)(ws_ + OFF_RWW); float* Y = (float*)(ws_ + OFF_RWY);
    if (lane == 0) sRole[wid] = (int)((__builtin_amdgcn_s_getreg(2308)) & 3);
    __syncthreads();
    int role = -1;
    {
        int simd[8];
#pragma unroll
        for (int w = 0; w < 8; ++w) simd[w] = sRole[w];
        unsigned used_simd = 0u, scan_mask = 0u; int nscan = 0;
#pragma unroll
        for (int w = 0; w < 8; ++w) { const unsigned bit = 1u << simd[w]; if (!(used_simd & bit) && nscan < 4) { used_simd |= bit; scan_mask |= 1u << w; ++nscan; } }
#pragma unroll
        for (int w = 0; w < 8; ++w) { if (!((scan_mask >> w) & 1u) && nscan < 4) { scan_mask |= 1u << w; ++nscan; } }
        const int below = __builtin_popcount(scan_mask & ((1u << wid) - 1u));
        role = ((scan_mask >> wid) & 1u) ? below : 4 + (wid - below);
    }
    role = __builtin_amdgcn_readfirstlane(role);
    __syncthreads();
    const bool helper = role >= 4;
    const int lt = (role - 4) * 64 + lane;
    const bool hvec = lt < 128;
    const int hr = (lt >> 4) & 7, hc = lt & 15;
    struct Pre { u32x2 r1, k1, a1, b1, r2, k2, a2, b2; f32x4 w1, w2; };
    auto issue = [&](int chunk, Pre& q) {
        const size_t o1 = (size_t)(chunk * CH + 2 * hr) * 512 + head * 64 + 4 * hc, o2 = o1 + 512;
        if (hvec) {
            q.r1 = *(const u32x2*)(R + o1); q.k1 = *(const u32x2*)(Kb + o1); q.a1 = *(const u32x2*)(Ab + o1); q.b1 = *(const u32x2*)(Bb + o1); q.w1 = *(const f32x4*)(Wb + o1);
            q.r2 = *(const u32x2*)(R + o2); q.k2 = *(const u32x2*)(Kb + o2); q.a2 = *(const u32x2*)(Ab + o2); q.b2 = *(const u32x2*)(Bb + o2); q.w2 = *(const f32x4*)(Wb + o2);
        } else { q.r1 = *(const u32x2*)(Vb + o1); q.r2 = *(const u32x2*)(Vb + o2); }
    };
    auto cv4 = [&](const u32x2& w) { f32x4 f; f[0] = __uint_as_float(w.x << 16); f[1] = __uint_as_float(w.x & 0xFFFF0000u); f[2] = __uint_as_float(w.y << 16); f[3] = __uint_as_float(w.y & 0xFFFF0000u); return f; };
    auto sum4 = [&](const f32x4& x) { return (x[0] + x[1]) + (x[2] + x[3]); };
    auto commit = [&](int bi, const Pre& q) {
        float* base = stg + bi * BUF;
        if (hvec) {
            const f32x4 r1 = cv4(q.r1), k1 = cv4(q.k1), a1 = cv4(q.a1), b1 = cv4(q.b1), r2 = cv4(q.r2), k2 = cv4(q.k2), a2 = cv4(q.a2), b2 = cv4(q.b2), w1 = q.w1, w2 = q.w2;
            float* vp = base + hr * (9 * 64) + 4 * hc;
            *(f32x4*)(vp + 0 * 64) = a1;
            *(f32x4*)(vp + 1 * 64) = w1 * a2;
            *(f32x4*)(vp + 2 * 64) = w1 * r1;
            *(f32x4*)(vp + 3 * 64) = w1 * w2;
            *(f32x4*)(vp + 4 * 64) = b1 * w2;
            *(f32x4*)(vp + 5 * 64) = k1 * w2;
            *(f32x4*)(vp + 6 * 64) = b2;
            *(f32x4*)(vp + 7 * 64) = k2;
            *(f32x4*)(vp + 8 * 64) = r2;
            const float be = row16_sum(sum4(b1 * a2)), ka = row16_sum(sum4(k1 * a2)), rb = row16_sum(sum4(b1 * r1)), rk = row16_sum(sum4(k1 * r1));
            if (hc == 0) *(f32x4*)(base + VEC + hr * 4) = (f32x4){be, ka, rb * (1.0f / 16.0f), rk * (1.0f / 16.0f)};
        } else {
            const f32x4 v1 = cv4(q.r1), v2 = cv4(q.r2);
            float* vv = base + VEC + SCL + (hr * 64 + 4 * hc) * 2;
            *(f32x4*)vv = (f32x4){v1[0], v2[0], v1[1], v2[1]}; *(f32x4*)(vv + 4) = (f32x4){v1[2], v2[2], v1[3], v2[3]};
        }
    };
    auto reduce_store = [&](int chunk) {
        const int t = lt >> 4, k = (lt >> 2) & 3, rr = lt & 3;
        const f32x4* pp = (const f32x4*)(part + ((chunk & 1) * CH + t) * 256 + k * 64 + rr * 16);
        const f32x4 s4 = pp[0] + pp[1] + pp[2] + pp[3];
        Y[(size_t)(chunk * CH + t) * 512 + head * 64 + quarter * 16 + k * 4 + rr] = (s4[0] + s4[1]) + (s4[2] + s4[3]);
    };
    Pre pr0, pr1, pr2, pr3;
    if (helper) { issue(0, pr0); commit(0, pr0); issue(1, pr1); issue(2, pr2); issue(3, pr3); }
    __syncthreads();
    const int row = quarter * 16 + role * 4 + (lane >> 4), cgp = (lane & 15) * 4;
    f32x2 s01 = {0.f, 0.f}, s23 = {0.f, 0.f};
    if (helper) {
        for (int c0 = 0; c0 < NCH; c0 += 4) {
#define RW_HELP(u, PNEXT, PCUR) { const int c = c0 + (u); if (c + 1 < NCH) commit((c + 1) & 1, PNEXT); if (c + 4 < NCH) issue(c + 4, PCUR); if (c > 0) reduce_store(c - 1); RAW_BAR; }
            RW_HELP(0, pr1, pr0) RW_HELP(1, pr2, pr1) RW_HELP(2, pr3, pr2) RW_HELP(3, pr0, pr3)
#undef RW_HELP
        }
    } else for (int chunk = 0; chunk < NCH; ++chunk) {
        {
            const float* bb = stg + (chunk & 1) * BUF;
            float* pw = part + (chunk & 1) * (CH * 256) + role * 64 + lane;
            f32x4 A1, A2, R1, WW, BW, KW, B2, K2, R2, SC; f32x2 VV;
            f32x4 A1n, A2n, R1n, WWn, BWn, KWn, B2n, K2n, R2n, SCn; f32x2 VVn;
            {
                const float* vp = bb + cgp;
                A1n = *(const f32x4*)(vp); A2n = *(const f32x4*)(vp + 64); R1n = *(const f32x4*)(vp + 128); WWn = *(const f32x4*)(vp + 192); BWn = *(const f32x4*)(vp + 256);
                KWn = *(const f32x4*)(vp + 320); B2n = *(const f32x4*)(vp + 384); K2n = *(const f32x4*)(vp + 448); R2n = *(const f32x4*)(vp + 512);
                SCn = *(const f32x4*)(bb + VEC); VVn = *(const f32x2*)(bb + VEC + SCL + row * 2);
            }
#pragma unroll
            for (int rd = 0; rd < NR; ++rd) {
                A1 = A1n; A2 = A2n; R1 = R1n; WW = WWn; BW = BWn; KW = KWn; B2 = B2n; K2 = K2n; R2 = R2n; SC = SCn; VV = VVn;
                const bool pf = (rd + 1 < NR);
                const float* vp = bb + (rd + 1) * (9 * 64) + cgp;
                const float v1 = VV[0], v2 = VV[1];
                const f32x2 p1 = s01 * (f32x2){A1[0], A1[1]} + s23 * (f32x2){A1[2], A1[3]};
                const f32x2 p2 = s01 * (f32x2){A2[0], A2[1]} + s23 * (f32x2){A2[2], A2[3]};
                const f32x2 p3 = s01 * (f32x2){R1[0], R1[1]} + s23 * (f32x2){R1[2], R1[3]};
                float sa1 = p1[0] + p1[1], u2 = p2[0] + p2[1];
                SBM;
                if (pf) { A1n = *(const f32x4*)(vp); A2n = *(const f32x4*)(vp + 64); }
                SBM;
                sa1 += dpp_f<0xB1>(sa1); u2 += dpp_f<0xB1>(u2);
                SBM;
                if (pf) { R1n = *(const f32x4*)(vp + 128); WWn = *(const f32x4*)(vp + 192); }
                f32x2 t01 = s01 * (f32x2){WW[0], WW[1]} + v1 * (f32x2){KW[0], KW[1]};
                SBM;
                sa1 += dpp_f<0x4E>(sa1); u2 += dpp_f<0x4E>(u2);
                SBM;
                if (pf) { BWn = *(const f32x4*)(vp + 256); KWn = *(const f32x4*)(vp + 320); }
                f32x2 t23 = s23 * (f32x2){WW[2], WW[3]} + v1 * (f32x2){KW[2], KW[3]};
                SBM;
                sa1 += dpp_f<0x141>(sa1); u2 += dpp_f<0x141>(u2);
                SBM;
                if (pf) { B2n = *(const f32x4*)(vp + 384); K2n = *(const f32x4*)(vp + 448); }
                t01 += v2 * (f32x2){K2[0], K2[1]}; t23 += v2 * (f32x2){K2[2], K2[3]};
                SBM;
                sa1 += dpp_f<0x140>(sa1); u2 += dpp_f<0x140>(u2);
                SBM;
                if (pf) { R2n = *(const f32x4*)(vp + 512); SCn = *(const f32x4*)(bb + VEC + (rd + 1) * 4); VVn = *(const f32x2*)(bb + VEC + SCL + ((rd + 1) * 64 + row) * 2); }
                const float sa2 = __builtin_fmaf(sa1, SC[0], __builtin_fmaf(v1, SC[1], u2));
                t01 += sa1 * (f32x2){BW[0], BW[1]}; t23 += sa1 * (f32x2){BW[2], BW[3]};
                pw[(2 * rd) * 256] = __builtin_fmaf(sa1, SC[2], __builtin_fmaf(v1, SC[3], p3[0] + p3[1]));
                s01 = t01 + sa2 * (f32x2){B2[0], B2[1]}; s23 = t23 + sa2 * (f32x2){B2[2], B2[3]};
                const f32x2 p4 = s01 * (f32x2){R2[0], R2[1]} + s23 * (f32x2){R2[2], R2[3]};
                pw[(2 * rd + 1) * 256] = p4[0] + p4[1];
            }
        }
        RAW_BAR;
    }
    if (helper) reduce_store(NCH - 1);
    __threadfence();
    __syncthreads();
}
#undef SBM
#undef RAW_BAR

DEVI void rwkv_post(const Params& p, int l, int bid, int nb) {
    int tid_ = threadIdx.x; asm volatile("" : "+v"(tid_)); size_t wz_ = 0; asm volatile("" : "+s"(wz_)); unsigned char* ws_ = p.ws + wz_;
    const int wid = tid_ >> 6, lane = tid_ & 63, c = wid * 64 + lane;
    const bf16_t* R = (const bf16_t*)(ws_ + OFF_RWR); const bf16_t* Kb = (const bf16_t*)(ws_ + OFF_RWK); const bf16_t* Vb = (const bf16_t*)(ws_ + OFF_RWV);
    const bf16_t* Gb = (const bf16_t*)(ws_ + OFF_RWG); const float* Y = (const float*)(ws_ + OFF_RWY);
    bf16_t* O = (bf16_t*)(ws_ + OFF_ORWKV);
    const float rk = ((const float*)p.in[18])[l * 512 + c], lw = ((const float*)p.in[19])[l * 512 + c], lb = ((const float*)p.in[20])[l * 512 + c];
    for (int tok = bid; tok < S; tok += nb) {
        const size_t o = (size_t)tok * 512 + c;
        const float y = Y[o], r = bf2f(R[o]), k = bf2f(Kb[o]), v = bf2f(Vb[o]), g = bf2f(Gb[o]);
        const float mean = wave_sum(y) * (1.0f / 64.0f);
        const float dv = y - mean;
        const float var = wave_sum(dv * dv) * (1.0f / 64.0f);
        const float yn = dv * rsqrtf(var + 64e-5f) * lw + lb;
        const float bonus = wave_sum(r * k * rk) * v;
        O[o] = f2bf((yn + bonus) * g);
    }
}

template <int NQ>
DEVI void attn_compute(const bf16x8 (&kf0)[4], const bf16x8 (&kf1)[4], const bf16x8 (&vf)[8],
                       const bf16x8 (&qf)[NQ][4], const unsigned (&vmask)[NQ], f32x4 (&o)[NQ][8], float (&m)[NQ], float (&l)[NQ]) {
#pragma unroll
    for (int q = 0; q < NQ; ++q) {
        f32x4 s0 = {0.f, 0.f, 0.f, 0.f}, s1 = {0.f, 0.f, 0.f, 0.f};
#pragma unroll
        for (int ks = 0; ks < 4; ++ks) {
            s0 = __builtin_amdgcn_mfma_f32_16x16x32_bf16(kf0[ks], qf[q][ks], s0, 0, 0, 0);
            s1 = __builtin_amdgcn_mfma_f32_16x16x32_bf16(kf1[ks], qf[q][ks], s1, 0, 0, 0);
        }
        float sv[8];
#pragma unroll
        for (int j = 0; j < 4; ++j) { sv[j] = ((vmask[q] >> j) & 1u) ? s0[j] : -1e30f; sv[4 + j] = ((vmask[q] >> (4 + j)) & 1u) ? s1[j] : -1e30f; }
        float cm = sv[0];
#pragma unroll
        for (int j = 1; j < 8; ++j) cm = fmaxf(cm, sv[j]);
        cm = fmaxf(cm, __shfl_xor(cm, 16)); cm = fmaxf(cm, __shfl_xor(cm, 32));
        const float mn = fmaxf(m[q], cm);
        const float alpha = __expf(m[q] - mn);
        m[q] = mn;
        float pr[8]; float ps = 0.f;
#pragma unroll
        for (int j = 0; j < 8; ++j) { pr[j] = __expf(sv[j] - mn); ps += pr[j]; }
        l[q] = l[q] * alpha + ps;
        union { u32x4 u; bf16x8 h; } pb;
        pb.u.x = cvt_pk_bf16(pr[0], pr[1]); pb.u.y = cvt_pk_bf16(pr[2], pr[3]); pb.u.z = cvt_pk_bf16(pr[4], pr[5]); pb.u.w = cvt_pk_bf16(pr[6], pr[7]);
#pragma unroll
        for (int dt = 0; dt < 8; ++dt) { o[q][dt] *= alpha; o[q][dt] = __builtin_amdgcn_mfma_f32_16x16x32_bf16(vf[dt], pb.h, o[q][dt], 0, 0, 0); }
    }
}
template <int NQ>
DEVI void attn_chunk(const bf16_t* k0p, const bf16_t* k1p, const bf16_t* vtp, size_t vt_stride16,
                     const bf16x8 (&qf)[NQ][4], const unsigned (&vmask)[NQ], f32x4 (&o)[NQ][8], float (&m)[NQ], float (&l)[NQ]) {
    bf16x8 kf0[4], kf1[4], vf[8];
#pragma unroll
    for (int ks = 0; ks < 4; ++ks) { kf0[ks] = *(const bf16x8*)(k0p + ks * 32); kf1[ks] = *(const bf16x8*)(k1p + ks * 32); }
#pragma unroll
    for (int dt = 0; dt < 8; ++dt) vf[dt] = *(const bf16x8*)(vtp + (size_t)dt * vt_stride16);
    attn_compute<NQ>(kf0, kf1, vf, qf, vmask, o, m, l);
}

DEVI void vtrans_tile(const Params& p, unsigned char* smem, int a, int ptile) {
    int tid_ = threadIdx.x; asm volatile("" : "+v"(tid_)); size_t wz_ = 0; asm volatile("" : "+s"(wz_)); unsigned char* ws_ = p.ws + wz_;
    const int dil = a < 2 ? 1 : (a < 4 ? 4 : (a < 6 ? 16 : 1));
    const int arr = a < 6 ? 12 + a : 26 + (a - 6);
    const bf16_t* V = (const bf16_t*)(ws_ + OFF_P2) + (size_t)arr * ((size_t)S * 128);
    bf16_t* VT = (bf16_t*)(ws_ + OFF_VT) + (size_t)a * ((size_t)S * 128);
    bf16_t* sT = (bf16_t*)smem;
    const int tid = tid_, p0 = ptile * 64, per = S / dil;
    {
        const int r = tid >> 3, seg = (tid & 7) * 16;
        const int pos = p0 + r, rho = pos / per, mm = pos % per, tok = mm * dil + rho;
        const u32x4 w0 = *(const u32x4*)(V + (size_t)tok * 128 + seg), w1 = *(const u32x4*)(V + (size_t)tok * 128 + seg + 8);
        unsigned* d = (unsigned*)(sT + r * 130 + seg);
        d[0] = w0.x; d[1] = w0.y; d[2] = w0.z; d[3] = w0.w; d[4] = w1.x; d[5] = w1.y; d[6] = w1.z; d[7] = w1.w;
    }
    __syncthreads();
    {
        const int dim = tid >> 2, part = (tid & 3) * 16;
        unsigned w[8];
#pragma unroll
        for (int i = 0; i < 8; ++i) w[i] = (unsigned)sT[(part + 2 * i) * 130 + dim] | ((unsigned)sT[(part + 2 * i + 1) * 130 + dim] << 16);
        u32x4 o0 = {w[0], w[1], w[2], w[3]}, o1 = {w[4], w[5], w[6], w[7]};
        bf16_t* dp = VT + (size_t)dim * S + p0 + part;
        *(u32x4*)dp = o0; *(u32x4*)(dp + 8) = o1;
    }
    __syncthreads();
}

DEVI void moba_kmean(const Params& p, unsigned char* smem, int item) {
    int tid_ = threadIdx.x; asm volatile("" : "+v"(tid_)); size_t wz_ = 0; asm volatile("" : "+s"(wz_)); unsigned char* ws_ = p.ws + wz_;
    const int head = item >> 6, nbk = item & 63, tid = tid_, d = tid & 127, tq = tid >> 7;
    const bf16_t* K = (const bf16_t*)(ws_ + OFF_P2) + (size_t)(22 + head) * ((size_t)S * 128);
    float* red = (float*)smem;
    float a = 0.f;
    for (int i = 0; i < 64; ++i) a += bf2f(K[(size_t)(nbk * 256 + tq * 64 + i) * 128 + d]);
    red[tq * 128 + d] = a;
    __syncthreads();
    if (tid < 128) ((float*)(ws_ + OFF_KM))[(size_t)item * 128 + tid] = (red[tid] + red[128 + tid] + red[256 + tid] + red[384 + tid]) * (1.0f / 256.0f);
    __syncthreads();
}

#define TOP3_INSERT(v, i, v1, v2, v3, i1, i2, i3) do { const float _v = (v); const int _i = (i); \
    const bool _g1 = _v > v1, _g2 = _v > v2, _g3 = _v > v3; \
    const float _n3 = _g2 ? v2 : (_g3 ? _v : v3); const int _m3 = _g2 ? i2 : (_g3 ? _i : i3); \
    const float _n2 = _g1 ? v1 : (_g2 ? _v : v2); const int _m2 = _g1 ? i1 : (_g2 ? _i : i2); \
    const float _n1 = _g1 ? _v : v1; const int _m1 = _g1 ? _i : i1; \
    v1 = _n1; v2 = _n2; v3 = _n3; i1 = _m1; i2 = _m2; i3 = _m3; } while (0)

DEVI void moba_gate(const Params& p, unsigned char* smem, int item) {
    int tid_ = threadIdx.x; asm volatile("" : "+v"(tid_)); size_t wz_ = 0; asm volatile("" : "+s"(wz_)); unsigned char* ws_ = p.ws + wz_;
    const int head = item >> 6, qb = item & 63, cur = qb, tid = tid_;
    unsigned long long* sel = (unsigned long long*)(ws_ + OFF_SEL) + (size_t)head * S + qb * 256;
    unsigned* sQ = (unsigned*)smem;
    float* sKm = (float*)(smem + 256 * 65 * 4);
    const bf16_t* Q = (const bf16_t*)(ws_ + OFF_P2) + (size_t)(18 + head) * ((size_t)S * 128) + (size_t)qb * 256 * 128;
    for (int e = tid; e < 256 * 64; e += NT) sQ[(e >> 6) * 65 + (e & 63)] = ((const unsigned*)Q)[e];
    const float* KM = (const float*)(ws_ + OFF_KM) + (size_t)head * 64 * 128;
    for (int e = tid; e < cur * 128; e += NT) sKm[e] = KM[e];
    __syncthreads();
    const int q = tid >> 1, part = tid & 1;
    float v1 = -INFINITY, v2 = -INFINITY, v3 = -INFINITY; int i1 = -1, i2 = -1, i3 = -1;
    for (int n = part; n < cur; n += 2) {
        float dot = 0.f;
#pragma unroll 4
        for (int w = 0; w < 64; ++w) {
            const unsigned qq = sQ[q * 65 + w];
            dot += __uint_as_float(qq << 16) * sKm[n * 128 + 2 * w] + __uint_as_float(qq & 0xFFFF0000u) * sKm[n * 128 + 2 * w + 1];
        }
        TOP3_INSERT(dot, n, v1, v2, v3, i1, i2, i3);
    }
    const float pv1 = __shfl_xor(v1, 1), pv2 = __shfl_xor(v2, 1), pv3 = __shfl_xor(v3, 1);
    const int pi1 = __shfl_xor(i1, 1), pi2 = __shfl_xor(i2, 1), pi3 = __shfl_xor(i3, 1);
    TOP3_INSERT(pv1, pi1, v1, v2, v3, i1, i2, i3);
    TOP3_INSERT(pv2, pi2, v1, v2, v3, i1, i2, i3);
    TOP3_INSERT(pv3, pi3, v1, v2, v3, i1, i2, i3);
    unsigned long long mk = 0ull;
    if (i1 >= 0) mk |= 1ull << i1;
    if (i2 >= 0) mk |= 1ull << i2;
    if (i3 >= 0) mk |= 1ull << i3;
    if (part == 0) sel[q] = mk;
    __syncthreads();
}

constexpr int MB_KROW = 272, MB_VROW = 144, MB_KBYTES = 64 * MB_KROW, MB_BUF = MB_KBYTES + 128 * MB_VROW;
DEVI void moba_attn(const Params& p, unsigned char* smem, int item) {
    int tid_ = threadIdx.x; asm volatile("" : "+v"(tid_)); size_t wz_ = 0; asm volatile("" : "+s"(wz_)); unsigned char* ws_ = p.ws + wz_;
    const int head = item & 3, qb = 63 - (item >> 2);
    const int tid = tid_, wid = tid >> 6, lane = tid & 63, li = lane & 15, g = lane >> 4;
    LAS unsigned char* lds = (LAS unsigned char*)smem;
    const bf16_t* Q = (const bf16_t*)(ws_ + OFF_P2) + (size_t)(18 + head) * ((size_t)S * 128);
    const bf16_t* K = (const bf16_t*)(ws_ + OFF_P2) + (size_t)(22 + head) * ((size_t)S * 128);
    const bf16_t* VT = (const bf16_t*)(ws_ + OFF_VT) + (size_t)(6 + head) * ((size_t)S * 128);
    const unsigned long long* sel = (const unsigned long long*)(ws_ + OFF_SEL) + (size_t)head * S;
    const int qbase = qb * 256 + wid * 32;
    bf16x8 qf[2][4]; unsigned long long sm[2]; f32x4 o[2][8]; float m[2], l[2];
#pragma unroll
    for (int qt = 0; qt < 2; ++qt) {
        const int qi = qbase + qt * 16 + li;
#pragma unroll
        for (int ks = 0; ks < 4; ++ks) qf[qt][ks] = *(const bf16x8*)(Q + (size_t)qi * 128 + ks * 32 + g * 8);
        sm[qt] = sel[qi]; m[qt] = -1e30f; l[qt] = 0.f;
#pragma unroll
        for (int dt = 0; dt < 8; ++dt) o[qt][dt] = (f32x4){0.f, 0.f, 0.f, 0.f};
    }
    const int krow_s = tid >> 3, kseg = (tid & 7) * 16;
    const int vdim_s = tid >> 2, vpart = (tid & 3) * 16;
    u32x4 rk0, rk1, rv0, rv1;
    auto issue = [&](int st) {
        const bf16_t* kp = K + (size_t)(st * 64 + krow_s) * 128 + kseg;
        rk0 = *(const u32x4*)kp; rk1 = *(const u32x4*)(kp + 8);
        const bf16_t* vp = VT + (size_t)vdim_s * S + st * 64 + vpart;
        rv0 = *(const u32x4*)vp; rv1 = *(const u32x4*)(vp + 8);
    };
    auto commit = [&](int bi) {
        LAS unsigned char* kb = lds + bi * MB_BUF + krow_s * MB_KROW + kseg * 2;
        *(LAS u32x4*)kb = rk0; *(LAS u32x4*)(kb + 16) = rk1;
        LAS unsigned char* vb = lds + bi * MB_BUF + MB_KBYTES + vdim_s * MB_VROW + vpart * 2;
        *(LAS u32x4*)vb = rv0; *(LAS u32x4*)(vb + 16) = rv1;
    };
    const int nst = (qb + 1) * 4;
    issue(0); commit(0);
    __syncthreads();
    const int krow = 8 * (li >> 2) + (li & 3);
    for (int st = 0; st < nst; ++st) {
        if (st + 1 < nst) issue(st + 1);
        const int n = st >> 2;
        LAS unsigned char* kb = lds + (st & 1) * MB_BUF;
        LAS unsigned char* vb = kb + MB_KBYTES;
#pragma unroll
        for (int c = 0; c < 2; ++c) {
            const int c0 = st * 64 + c * 32;
            unsigned vm[2];
            if (n < qb) { vm[0] = ((sm[0] >> n) & 1ull) ? 0xFFu : 0u; vm[1] = ((sm[1] >> n) & 1ull) ? 0xFFu : 0u; }
            else {
#pragma unroll
                for (int qt = 0; qt < 2; ++qt) {
                    const int qpos = qbase + qt * 16 + li; unsigned mk = 0u;
#pragma unroll
                    for (int j = 0; j < 8; ++j) { const int key = c0 + 8 * g + (j & 3) + 4 * (j >> 2); mk |= (key <= qpos) ? (1u << j) : 0u; }
                    vm[qt] = mk;
                }
            }
            if (__ballot((vm[0] | vm[1]) != 0u) != 0ull) {
                bf16x8 kf0[4], kf1[4], vf[8];
#pragma unroll
                for (int ks = 0; ks < 4; ++ks) {
                    kf0[ks] = *(const LAS bf16x8*)(kb + (c * 32 + krow) * MB_KROW + (ks * 32 + g * 8) * 2);
                    kf1[ks] = *(const LAS bf16x8*)(kb + (c * 32 + krow + 4) * MB_KROW + (ks * 32 + g * 8) * 2);
                }
#pragma unroll
                for (int dt = 0; dt < 8; ++dt) vf[dt] = *(const LAS bf16x8*)(vb + (16 * dt + li) * MB_VROW + (c * 32 + 8 * g) * 2);
                attn_compute<2>(kf0, kf1, vf, qf, vm, o, m, l);
            }
        }
        if (st + 1 < nst) commit((st + 1) & 1);
        __syncthreads();
    }
    bf16_t* O = (bf16_t*)(ws_ + OFF_OMOBA);
#pragma unroll
    for (int qt = 0; qt < 2; ++qt) {
        float lt = l[qt]; lt += __shfl_xor(lt, 16); lt += __shfl_xor(lt, 32);
        const float inv = __builtin_amdgcn_rcpf(lt);
        const int qi = qbase + qt * 16 + li;
#pragma unroll
        for (int dt = 0; dt < 8; ++dt) {
            const f32x4 v = o[qt][dt] * inv;
            u32x2 w; w.x = cvt_pk_bf16(v[0], v[1]); w.y = cvt_pk_bf16(v[2], v[3]);
            *(u32x2*)(O + (size_t)qi * 512 + head * 128 + dt * 16 + 4 * g) = w;
        }
    }
}

DEVI void dil_attn(const Params& p, int item) {
    int tid_ = threadIdx.x; asm volatile("" : "+v"(tid_)); size_t wz_ = 0; asm volatile("" : "+s"(wz_)); unsigned char* ws_ = p.ws + wz_;
    const int hp = item & 1, T0 = (item >> 1) * 256;
    const int tid = tid_, wid = tid >> 6, lane = tid & 63, li = lane & 15, g = lane >> 4;
    const int krow = 8 * (li >> 2) + (li & 3);
    bf16_t* O = (bf16_t*)(ws_ + OFF_ODIL);
    for (int rr = 0; rr < 2; ++rr) {
        const int rho16 = 2 * wid + rr;
        const int tq = T0 + rho16 + 16 * li;
        f32x4 o[1][8]; float m[1], l[1];
        m[0] = -1e30f; l[0] = 0.f;
#pragma unroll
        for (int dt = 0; dt < 8; ++dt) o[0][dt] = (f32x4){0.f, 0.f, 0.f, 0.f};
        for (int gi = 0; gi < 3; ++gi) {
            const int dil = gi == 0 ? 1 : (gi == 1 ? 4 : 16);
            const int head = 2 * gi + hp, per = S / dil;
            const bf16_t* Q = (const bf16_t*)(ws_ + OFF_P2) + (size_t)(head) * ((size_t)S * 128);
            const bf16_t* K = (const bf16_t*)(ws_ + OFF_P2) + (size_t)(6 + head) * ((size_t)S * 128);
            const bf16_t* VT = (const bf16_t*)(ws_ + OFF_VT) + (size_t)head * ((size_t)S * 128);
            bf16x8 qf[1][4];
#pragma unroll
            for (int ks = 0; ks < 4; ++ks) qf[0][ks] = *(const bf16x8*)(Q + (size_t)tq * 128 + ks * 32 + g * 8);
            const int rho = rho16 % dil;
            const int qm = tq / dil;
            const int qm0 = (T0 + rho16) / dil, qm15 = (T0 + rho16 + 240) / dil;
            const int lo = qm0 - 128;
            int c0 = (lo >> 5) << 5;
            if (c0 < 0) c0 = (c0 < -32) ? 0 : c0;
            if (lo < 0 && c0 < 0 && c0 + 31 < 0) c0 = 0;
            for (; c0 <= qm15; c0 += 32) {
                unsigned vm[1]; unsigned mk = 0u;
#pragma unroll
                for (int j = 0; j < 8; ++j) { const int kap = c0 + 8 * g + (j & 3) + 4 * (j >> 2); mk |= (kap >= 0 && kap <= qm && qm - kap <= 128) ? (1u << j) : 0u; }
                vm[0] = mk;
                int ka0 = c0 + krow, ka1 = ka0 + 4;
                ka0 = ka0 < 0 ? 0 : (ka0 > per - 1 ? per - 1 : ka0); ka1 = ka1 < 0 ? 0 : (ka1 > per - 1 ? per - 1 : ka1);
                int sg = c0 + 8 * g; sg = sg < 0 ? 0 : (sg > per - 8 ? per - 8 : sg);
                const bf16_t* k0p = K + (size_t)(ka0 * dil + rho) * 128 + g * 8;
                const bf16_t* k1p = K + (size_t)(ka1 * dil + rho) * 128 + g * 8;
                attn_chunk<1>(k0p, k1p, VT + (size_t)li * S + (size_t)rho * per + sg, (size_t)16 * S, qf, vm, o, m, l);
            }
        }
        float lt = l[0]; lt += __shfl_xor(lt, 16); lt += __shfl_xor(lt, 32);
        const float inv = __builtin_amdgcn_rcpf(lt);
#pragma unroll
        for (int dt = 0; dt < 8; ++dt) {
            const f32x4 v = o[0][dt] * inv;
            u32x2 w; w.x = cvt_pk_bf16(v[0], v[1]); w.y = cvt_pk_bf16(v[2], v[3]);
            *(u32x2*)(O + (size_t)tq * 256 + hp * 128 + dt * 16 + 4 * g) = w;
        }
    }
}

DEVI void sub_barrier(unsigned* ctr, unsigned target) {
    __threadfence();
    __syncthreads();
    if (threadIdx.x == 0) {
        __threadfence();
        __hip_atomic_fetch_add(ctr, 1u, __ATOMIC_RELEASE, __HIP_MEMORY_SCOPE_AGENT);
        while (__hip_atomic_load(ctr, __ATOMIC_ACQUIRE, __HIP_MEMORY_SCOPE_AGENT) < target) __builtin_amdgcn_s_sleep(8);
        __threadfence();
    }
    __syncthreads();
}
#ifndef PHASE_MASK
#define PHASE_MASK 0xFFFFFFFFu
#endif
#define PH(k) ((PHASE_MASK >> (k)) & 1u)
#ifndef PROBE_MASK
#define PROBE_MASK 0u
#endif
#define REPS(k) (1 + (int)((PROBE_MASK >> (k)) & 1u))
__global__ void __launch_bounds__(512, 2) fwd_megakernel(Params p) {
    extern __shared__ __attribute__((aligned(16))) unsigned char smem[];
    cg::grid_group grid = cg::this_grid();
    const int bid = blockIdx.x, nb = gridDim.x;
    unsigned char* ws = p.ws;
    const float* mod = (const float*)(ws + OFF_MOD);

    if (bid == 0 && threadIdx.x < 4) ((unsigned*)(ws + OFF_BAR))[threadIdx.x * 64] = 0u;
    if (PH(0)) phase_mod_rope(p, smem, bid, nb);
    __syncthreads();
    for (int rep = 0; rep < REPS(5); ++rep) if (PH(1)) phase_convert(p, 0, smem, bid, nb);
    grid.sync();

    for (int l = 0; l < NL; ++l) {
        const float* ml = mod + l * 12288;
        const float* xin = (l == 0) ? (const float*)p.in[0] : p.out;
        for (int rep = 0; rep < REPS(4); ++rep) if (PH(2)) phase_norm(xin, (const float*)p.in[5] + l * D, ml, ml + 2048, (bf16_t*)(ws + OFF_H), bid, nb);
        for (int rep = 0; rep < REPS(5); ++rep) if (PH(1) && l > 0) phase_convert(p, l, smem, bid, nb);
        grid.sync();
        {
            EpiInProj E; E.G = (bf16_t*)(ws + OFF_G); E.P1G = (bf16_t*)(ws + OFF_P1G); E.P1R = (bf16_t*)(ws + OFF_P1R); E.P2 = (bf16_t*)(ws + OFF_P2);
            E.cosT = (const float*)(ws + OFF_COS); E.sinT = (const float*)(ws + OFF_SIN);
            for (int rep = 0; rep < REPS(0); ++rep) if (PH(3)) run_gemm(smem, (const bf16_t*)(ws + OFF_H), (const bf16_t*)(ws + OFF_WIN), IN_PAD, D, E);
        }
        grid.sync();
        for (int it = bid; it < 1024; it += nb) rwkv_prep(p, l, smem, it);
        grid.sync();
        if (bid < 32) rwkv_scan(p, smem, bid);
        else {
            const int b2 = bid - 32, nb2 = nb - 32;
            unsigned* ctr = (unsigned*)(ws + OFF_BAR) + l * 128;
            for (int it = b2; it < 1024 + 256 + 2560; it += nb2) {
                if (it < 1024) gla_pass1(p, l, smem, it);
                else if (it < 1280) moba_kmean(p, smem, it - 1024);
                else { const int j = it - 1280; vtrans_tile(p, smem, j >> 8, j & 255); }
            }
            sub_barrier(ctr, (unsigned)nb2);
            for (int it = b2; it < 64 + 256; it += nb2) {
                if (it < 64) gla_pass2(p, it);
                else moba_gate(p, smem, it - 64);
            }
            sub_barrier(ctr + 64, (unsigned)nb2);
            for (int it = b2; it < 256 + 128 + 1024; it += nb2) {
                if (it < 256) moba_attn(p, smem, it);
                else if (it < 384) dil_attn(p, it - 256);
                else gla_pass3(p, l, smem, it - 384);
            }
        }
        grid.sync();
        if (PH(14)) rwkv_post(p, l, bid, nb);
        grid.sync();
        {
            EpiBranch E; E.Mg = (bf16_t*)(ws + OFF_MERGED);
            E.Gb = (const bf16_t*)(ws + OFF_G); E.first = 1;
            if (PH(15)) run_gemm(smem, (const bf16_t*)(ws + OFF_OGLA), (const bf16_t*)(ws + OFF_WBA), D, 512, E);
            E.Gb = (const bf16_t*)(ws + OFF_G) + 2048; E.first = 0;
            if (PH(15)) run_gemm(smem, (const bf16_t*)(ws + OFF_ODIL), (const bf16_t*)(ws + OFF_WBB), D, 256, E);
            E.Gb = (const bf16_t*)(ws + OFF_G) + 4096;
            if (PH(15)) run_gemm(smem, (const bf16_t*)(ws + OFF_ORWKV), (const bf16_t*)(ws + OFF_WBC), D, 512, E);
            E.Gb = (const bf16_t*)(ws + OFF_G) + 6144;
            if (PH(15)) run_gemm(smem, (const bf16_t*)(ws + OFF_OMOBA), (const bf16_t*)(ws + OFF_WBD), D, 512, E);
        }
        grid.sync();
        {
            EpiResid E; E.src = xin; E.dst = p.out; E.gate = ml + 4096;
            if (PH(16)) run_gemm(smem, (const bf16_t*)(ws + OFF_MERGED), (const bf16_t*)(ws + OFF_WOUT), D, D, E);
        }
        grid.sync();
        for (int rep = 0; rep < REPS(4); ++rep) if (PH(2)) phase_norm(p.out, (const float*)p.in[29] + l * D, ml + 6144, ml + 8192, (bf16_t*)(ws + OFF_H), bid, nb);
        grid.sync();
        {
            EpiSwiglu E; E.act = (bf16_t*)(ws + OFF_ACT);
            for (int rep = 0; rep < REPS(1); ++rep) if (PH(17)) run_gemm(smem, (const bf16_t*)(ws + OFF_H), (const bf16_t*)(ws + OFF_WF1), 2 * FFN_H, D, E);
        }
        grid.sync();
        {
            EpiResid E; E.src = p.out; E.dst = p.out; E.gate = ml + 10240;
            if (PH(16)) run_gemm(smem, (const bf16_t*)(ws + OFF_ACT), (const bf16_t*)(ws + OFF_WF2), D, FFN_H, E);
        }
        grid.sync();
    }
    if (PH(18)) phase_final_norm(p.out, (const float*)p.in[32], bid, nb);
}

extern "C" void kernel_launch(void* const* d_in, const int* in_sizes, int n_in, void* d_out, int out_size, void* d_ws, size_t ws_size, hipStream_t stream) {
    static int grid_blocks = 0;
    if (grid_blocks == 0) {
        if (n_in != 33 || ws_size < WS_END) { fprintf(stderr, "kernel_launch: unexpected n_in %d or ws_size %zu (< %zu)\n", n_in, ws_size, (size_t)WS_END); grid_blocks = -1; return; }
        int dev = 0, cus = 0, per_cu = 0;
        hipGetDevice(&dev);
        hipDeviceGetAttribute(&cus, hipDeviceAttributeMultiprocessorCount, dev);
        if (hipFuncSetAttribute((const void*)fwd_megakernel, hipFuncAttributeMaxDynamicSharedMemorySize, LDS_BYTES) != hipSuccess) { fprintf(stderr, "kernel_launch: hipFuncSetAttribute failed\n"); grid_blocks = -1; return; }
        hipOccupancyMaxActiveBlocksPerMultiprocessor(&per_cu, (const void*)fwd_megakernel, NT, LDS_BYTES);
        if (per_cu < 1) { fprintf(stderr, "kernel_launch: occupancy query says 0 blocks per CU\n"); per_cu = 1; }
        grid_blocks = cus * 1;
        (void)hipGetLastError();
    }
    if (grid_blocks < 0) return;
    Params p{};
    for (int i = 0; i < 33; ++i) p.in[i] = d_in[i];
    p.out = (float*)d_out; p.ws = (unsigned char*)d_ws;
    void* args[] = {&p};
    hipError_t e = hipLaunchCooperativeKernel((const void*)fwd_megakernel, dim3(grid_blocks), dim3(NT), args, LDS_BYTES, stream);
    if (e != hipSuccess) fprintf(stderr, "cooperative launch failed: %s (grid %d)\n", hipGetErrorString(e), grid_blocks);
}
```

```cpp
#include <hip/hip_runtime.h>
#include <hip/hip_cooperative_groups.h>
#include <cstdio>
#include <cstdint>
namespace cg = cooperative_groups;

typedef unsigned short bf16_t;
typedef short bf16x8 __attribute__((ext_vector_type(8)));
typedef float f32x4 __attribute__((ext_vector_type(4)));
typedef float f32x2 __attribute__((ext_vector_type(2)));
typedef unsigned u32x4 __attribute__((ext_vector_type(4)));
typedef unsigned u32x2 __attribute__((ext_vector_type(2)));
#define LAS __attribute__((address_space(3)))
#define DEVI __device__ __forceinline__

constexpr int S = 16384, D = 2048, NL = 2;
constexpr int IN_TOTAL = 15568, IN_PAD = 15872;
constexpr int FFN_H = 5632;
constexpr int NT = 512;
constexpr int LDS_BYTES = 131072;

constexpr size_t SZ_HEADARR = (size_t)S * 128 * 2;
constexpr size_t OFF_WIN = 0;
constexpr size_t OFF_WBA = OFF_WIN + (size_t)IN_PAD * D * 2;
constexpr size_t OFF_WBB = OFF_WBA + (size_t)D * 512 * 2;
constexpr size_t OFF_WBC = OFF_WBB + (size_t)D * 256 * 2;
constexpr size_t OFF_WBD = OFF_WBC + (size_t)D * 512 * 2;
constexpr size_t OFF_WOUT = OFF_WBD + (size_t)D * 512 * 2;
constexpr size_t OFF_WF1 = OFF_WOUT + (size_t)D * D * 2;
constexpr size_t OFF_WF2 = OFF_WF1 + (size_t)2 * FFN_H * D * 2;
constexpr size_t WB_END = OFF_WF2 + (size_t)D * FFN_H * 2;
constexpr size_t OFF_VT = OFF_WIN;
constexpr size_t OFF_G = WB_END;
constexpr size_t OFF_P1G = OFF_G + (size_t)S * 8192 * 2;
constexpr size_t OFF_P1R = OFF_P1G + (size_t)S * 1792 * 2;
constexpr size_t OFF_P2 = OFF_P1R + (size_t)S * 2048 * 2;
constexpr size_t OFF_ACT = OFF_P1G;
constexpr size_t OFF_H = OFF_P2 + 30 * SZ_HEADARR;
constexpr size_t OFF_OGLA = OFF_H;
constexpr size_t OFF_ODIL = OFF_OGLA + (size_t)S * 512 * 2;
constexpr size_t OFF_ORWKV = OFF_ODIL + (size_t)S * 256 * 2;
constexpr size_t OFF_OMOBA = OFF_ORWKV + (size_t)S * 512 * 2;
constexpr size_t OFF_X = OFF_H + (size_t)S * D * 2;
constexpr size_t SZ_B512 = (size_t)S * 512 * 2;
constexpr size_t OFF_RWR = OFF_X;
constexpr size_t OFF_RWK = OFF_RWR + SZ_B512;
constexpr size_t OFF_RWV = OFF_RWK + SZ_B512;
constexpr size_t OFF_RWA = OFF_RWV + SZ_B512;
constexpr size_t OFF_RWB = OFF_RWA + SZ_B512;
constexpr size_t OFF_RWG = OFF_RWB + SZ_B512;
constexpr size_t OFF_RWW = OFF_RWG + SZ_B512;
constexpr size_t OFF_RWY = OFF_RWW + (size_t)S * 512 * 4;
constexpr size_t OFF_GLL = OFF_RWY + (size_t)S * 512 * 4;
constexpr size_t OFF_GLB = OFF_GLL + (size_t)256 * 4 * 64 * 128 * 4;
constexpr size_t OFF_GLD = OFF_GLB + (size_t)S * 256 * 4;
constexpr size_t OFF_MERGED = OFF_X;
constexpr size_t OFF_VF = OFF_GLD + (size_t)256 * 4 * 64 * 4;
constexpr size_t OFF_MOD = OFF_VF + SZ_B512;
constexpr size_t OFF_COS = OFF_MOD + (size_t)2 * 12288 * 4;
constexpr size_t OFF_SIN = OFF_COS + (size_t)S * 16 * 4;
constexpr size_t OFF_KM = OFF_SIN + (size_t)S * 16 * 4;
constexpr size_t OFF_SEL = OFF_KM + (size_t)4 * 64 * 128 * 4;
constexpr size_t OFF_LORA = OFF_SEL + (size_t)4 * S * 8;
constexpr size_t OFF_BAR = OFF_LORA + (size_t)512 * 448 * 2;
constexpr size_t WS_END = OFF_BAR + 4 * 256;

struct Params {
    const void* in[33];
    float* out;
    unsigned char* ws;
};

DEVI float bf2f(bf16_t b) { return __uint_as_float(((unsigned)b) << 16); }
typedef __bf16 bf16x2_t __attribute__((ext_vector_type(2)));
DEVI unsigned cvt_pk_bf16(float lo, float hi) {
    const f32x2 v = {lo, hi}; const bf16x2_t r = __builtin_convertvector(v, bf16x2_t); return __builtin_bit_cast(unsigned, r);
}
DEVI bf16_t f2bf(float f) { return (bf16_t)cvt_pk_bf16(f, 0.f); }
DEVI float sigmoidf_(float x) { return __builtin_amdgcn_rcpf(1.0f + __expf(-x)); }
DEVI float siluf_(float x) { return x * __builtin_amdgcn_rcpf(1.0f + __expf(-x)); }
DEVI float wave_sum(float v) {
#pragma unroll
    for (int o = 32; o >= 1; o >>= 1) v += __shfl_xor(v, o);
    return v;
}
template <int CTRL> DEVI float dpp_f(float v) { return __int_as_float(__builtin_amdgcn_update_dpp(0, __float_as_int(v), CTRL, 0xF, 0xF, true)); }
DEVI float row16_sum(float v) {
    v += dpp_f<0xB1>(v);
    v += dpp_f<0x4E>(v);
    v += dpp_f<0x141>(v);
    v += dpp_f<0x140>(v);
    return v;
}

namespace pg8 {
constexpr int BM = 256, BK = 64, HALF = 128, HTB = HALF * BK * 2, STAGE_BYTES = 8 * HTB, NXCD = 8, WGM = 8;
DEVI int lds_byte(int r, int c) { const int st = (r >> 4) * 2 + (c >> 5), rr = r & 15, cc = c & 31, ob = rr * 64 + cc * 2; return st * 1024 + (ob ^ (((ob >> 9) & 1) << 5)); }
DEVI void stage_rc(int b, int& R, int& C) { const int st = b / 1024, sb = b % 1024, swz = sb ^ (((sb >> 9) & 1) << 5); R = (st >> 1) * 16 + swz / 64; C = (st & 1) * 32 + (swz % 64) / 2; }
DEVI int perm32(int rho) { const int n = rho >> 4, i = rho & 15; return 8 * (i >> 2) + 4 * n + (i & 3); }
struct Unit { int pm, pn; };
struct Gemm { const bf16_t* A; const bf16_t* Bt; int M, N, K; };
struct StaticOrder {
    int nM, nN, nwg, G, c;
    DEVI void init(int M, int N, int G_, int c_) { nM = M / BM; nN = N / BM; nwg = nM * nN; G = G_; c = c_; }
    DEVI bool next(int i, Unit& u) const {
        const long L = (long)i * G + c; if (L >= nwg) return false;
        int wgid = (int)L; { const int q = nwg / NXCD, r = nwg % NXCD, xcd = wgid % NXCD, off = wgid / NXCD; wgid = (xcd < r ? xcd * (q + 1) : r * (q + 1) + (xcd - r) * q) + off; }
        const int nig = WGM * nN, gid = wgid / nig, fm = gid * WGM, gsz = (nM - fm) < WGM ? (nM - fm) : WGM;
        u.pm = fm + ((wgid % nig) % gsz); u.pn = (wgid % nig) / gsz; return true;
    }
};
template <class Epi>
DEVI void gemm_phase(LAS unsigned char* lds, const Gemm g, const StaticOrder& S_, const Epi& E) {
    int tid_ = threadIdx.x; asm volatile("" : "+v"(tid_));
    int K_ = g.K; asm volatile("" : "+s"(K_));
    const int tid = tid_, wid = __builtin_amdgcn_readfirstlane(tid >> 6), lane = tid & 63, wr = wid >> 2, wc = wid & 3, fr = lane & 15, fq = lane >> 4;
    const int K = K_, nt = K / BK;
    unsigned voffA[2], voffB[2];
#pragma unroll
    for (int i = 0; i < 2; ++i) { int R, C; stage_rc(tid * 16 + i * 8192, R, C); const int Rb = (R & ~31) + perm32(R & 31);
        voffA[i] = (unsigned)(R * K + C) * 2u; voffB[i] = (unsigned)(Rb * K + C) * 2u; }
    const size_t kstep = (size_t)(BK * 2);
    const size_t hstep = (size_t)HALF * K * 2;
    const size_t tstep = 2 * hstep;
    const unsigned ldsw = (unsigned)wid * 1024u;
    const int aoff = lds_byte(wr * 64 + fr, fq * 8), boff = lds_byte(wc * 32 + fr, fq * 8);
#define PG8_SA(b, h) (((b) * 2 + (h)) * HTB)
#define PG8_SB(b, h) ((4 + (b) * 2 + (h)) * HTB)
#define PG8_STAGE(bufoff, gbase, voff) do { _Pragma("unroll") for (int _i = 0; _i < 2; ++_i) \
        __builtin_amdgcn_global_load_lds((const unsigned*)((const char*)(gbase) + (voff)[_i]), (LAS unsigned*)(lds + (bufoff) + ldsw + _i * 8192), 16, 0, 0); } while (0)
#define PG8_LDA(dst, b, h) do { _Pragma("unroll") for (int m = 0; m < 4; ++m) _Pragma("unroll") for (int k = 0; k < 2; ++k) dst[m][k] = *(const LAS bf16x8*)(lds + PG8_SA(b, h) + aoff + m * 2048 + k * 1024); } while (0)
#define PG8_LDB(dst, b, h) do { _Pragma("unroll") for (int n = 0; n < 2; ++n) _Pragma("unroll") for (int k = 0; k < 2; ++k) dst[n][k] = *(const LAS bf16x8*)(lds + PG8_SB(b, h) + boff + n * 2048 + k * 1024); } while (0)
#define PG8_MMA(ai, bj, At, Bt) do { __builtin_amdgcn_s_setprio(1); _Pragma("unroll") for (int m = 0; m < 4; ++m) _Pragma("unroll") for (int n = 0; n < 2; ++n) _Pragma("unroll") for (int k = 0; k < 2; ++k) \
        acc[ai][bj][m][n] = __builtin_amdgcn_mfma_f32_16x16x32_bf16(Bt[n][k], At[m][k], acc[ai][bj][m][n], 0, 0, 0); __builtin_amdgcn_s_setprio(0); } while (0)
#define PG8_WAIT_V(n) asm volatile("s_waitcnt vmcnt(" #n ")" ::: "memory")
#define PG8_WAIT_L(n) asm volatile("s_waitcnt lgkmcnt(" #n ")" ::: "memory")
#define PG8_BAR __builtin_amdgcn_s_barrier()
#define PG8_SCHED __builtin_amdgcn_sched_barrier(0)
    Unit cur, nxt; int ui = 0;
    if (!S_.next(0, cur)) return;
    f32x4 acc[2][2][4][2];
#pragma unroll
    for (int a = 0; a < 2; ++a)
#pragma unroll
        for (int b = 0; b < 2; ++b)
#pragma unroll
            for (int m = 0; m < 4; ++m)
#pragma unroll
                for (int n = 0; n < 2; ++n) acc[a][b][m][n] = (f32x4){0.f, 0.f, 0.f, 0.f};
    bf16x8 At[4][2], B0[2][2], B1[2][2];
    const char* cA = (const char*)g.A + (size_t)cur.pm * tstep; const char* cB = (const char*)g.Bt + (size_t)cur.pn * tstep;
    PG8_STAGE(PG8_SB(0, 0), cB, voffB); PG8_STAGE(PG8_SA(0, 0), cA, voffA); PG8_STAGE(PG8_SB(0, 1), cB + hstep, voffB); PG8_STAGE(PG8_SA(0, 1), cA + hstep, voffA);
    if (wr == 1) PG8_BAR;
    PG8_WAIT_V(4); PG8_BAR;
    PG8_STAGE(PG8_SB(1, 0), cB + kstep, voffB); PG8_STAGE(PG8_SA(1, 0), cA + kstep, voffA); PG8_STAGE(PG8_SB(1, 1), cB + hstep + kstep, voffB);
    PG8_WAIT_V(6); PG8_BAR;
    for (;;) {
        const bool has_next = S_.next(ui + 1, nxt);
        const char* nA = has_next ? (const char*)g.A + (size_t)nxt.pm * tstep : cA; const char* nB = has_next ? (const char*)g.Bt + (size_t)nxt.pn * tstep : cB;
        for (int t = 0; t < nt; t += 2) {
            const bool last = (t == nt - 2);
            const char* a1 = cA + (size_t)(t + 1) * kstep;
            const char* a2 = last ? nA : cA + (size_t)(t + 2) * kstep; const char* b2 = last ? nB : cB + (size_t)(t + 2) * kstep;
            const char* a3 = a2 + kstep; const char* b3 = b2 + kstep;
            PG8_LDB(B0, 0, 0); PG8_SCHED; PG8_LDA(At, 0, 0); PG8_STAGE(PG8_SA(1, 1), a1 + hstep, voffA);
            PG8_WAIT_L(8); PG8_BAR; PG8_WAIT_L(0); PG8_MMA(0, 0, At, B0); PG8_BAR; PG8_SCHED;
            PG8_LDB(B1, 0, 1); PG8_STAGE(PG8_SB(0, 0), b2, voffB);
            PG8_BAR; PG8_WAIT_L(0); PG8_MMA(0, 1, At, B1); PG8_BAR;
            PG8_LDA(At, 0, 1); PG8_STAGE(PG8_SA(0, 0), a2, voffA);
            PG8_BAR; PG8_WAIT_L(0); PG8_MMA(1, 0, At, B0); PG8_BAR; PG8_SCHED;
            PG8_STAGE(PG8_SB(0, 1), b2 + hstep, voffB);
            PG8_WAIT_V(6); PG8_BAR; PG8_MMA(1, 1, At, B1); PG8_BAR;
            PG8_LDB(B0, 1, 0); PG8_SCHED; PG8_LDA(At, 1, 0); PG8_STAGE(PG8_SA(0, 1), a2 + hstep, voffA);
            PG8_WAIT_L(8); PG8_BAR; PG8_WAIT_L(0); PG8_MMA(0, 0, At, B0); PG8_BAR; PG8_SCHED;
            PG8_LDB(B1, 1, 1); PG8_STAGE(PG8_SB(1, 0), b3, voffB);
            PG8_BAR; PG8_WAIT_L(0); PG8_MMA(0, 1, At, B1); PG8_BAR;
            PG8_LDA(At, 1, 1); PG8_STAGE(PG8_SA(1, 0), a3, voffA);
            PG8_BAR; PG8_WAIT_L(0); PG8_MMA(1, 0, At, B0); PG8_BAR; PG8_SCHED;
            PG8_STAGE(PG8_SB(1, 1), b3 + hstep, voffB);
            PG8_WAIT_V(6); PG8_BAR; PG8_MMA(1, 1, At, B1); PG8_BAR;
        }
        E(acc, cur, wr, wc, fr, fq);
        if (!has_next) break;
#pragma unroll
        for (int a = 0; a < 2; ++a)
#pragma unroll
            for (int b = 0; b < 2; ++b)
#pragma unroll
                for (int m = 0; m < 4; ++m)
#pragma unroll
                    for (int n = 0; n < 2; ++n) acc[a][b][m][n] = (f32x4){0.f, 0.f, 0.f, 0.f};
        cur = nxt; cA = nA; cB = nB; ++ui;
    }
    PG8_WAIT_V(0);
    if (wr == 0) PG8_BAR;
    PG8_BAR;
#undef PG8_SA
#undef PG8_SB
#undef PG8_STAGE
#undef PG8_LDA
#undef PG8_LDB
#undef PG8_MMA
#undef PG8_WAIT_V
#undef PG8_WAIT_L
#undef PG8_BAR
#undef PG8_SCHED
}
}
using pg8::Unit;

struct EpiInProj {
    bf16_t *G, *P1G, *P1R, *P2; const float *cosT, *sinT;
    DEVI void operator()(const f32x4 (&acc)[2][2][4][2], const Unit& u, int wr, int wc, int fr, int fq) const {
        const int pn = u.pn; const int row0 = u.pm * 256 + wr * 64 + fr; const int cl = wc * 32 + 8 * fq;
        const bool plain = (pn < 39) || (pn >= 48 && pn < 56);
        if (plain) {
            bf16_t* base; int ld, pnl; bool sg = false;
            if (pn < 32) { base = G; ld = 8192; pnl = pn; sg = true; }
            else if (pn < 39) { base = P1G; ld = 1792; pnl = pn - 32; }
            else { base = P1R; ld = 2048; pnl = pn - 48; }
#pragma unroll
            for (int ai = 0; ai < 2; ++ai)
#pragma unroll
                for (int m = 0; m < 4; ++m) {
                    bf16_t* rowp = base + (size_t)(row0 + ai * 128 + m * 16) * ld + pnl * 256 + cl;
#pragma unroll
                    for (int bj = 0; bj < 2; ++bj) {
                        f32x4 v0 = acc[ai][bj][m][0], v1 = acc[ai][bj][m][1];
                        if (sg) {
#pragma unroll
                            for (int j = 0; j < 4; ++j) { v0[j] = sigmoidf_(v0[j]); v1[j] = sigmoidf_(v1[j]); }
                        }
                        u32x4 w; w.x = cvt_pk_bf16(v0[0], v0[1]); w.y = cvt_pk_bf16(v0[2], v0[3]); w.z = cvt_pk_bf16(v1[0], v1[1]); w.w = cvt_pk_bf16(v1[2], v1[3]);
                        *(u32x4*)(rowp + bj * 128) = w;
                    }
                    __builtin_amdgcn_sched_barrier(0);
                }
        } else {
            int t, hbase, arr0;
            if (pn < 48) { const int pl = pn - 39; t = pl / 3; hbase = (pl % 3) * 2; arr0 = t * 6 + hbase; }
            else { const int pl = pn - 56; t = pl / 2; hbase = (pl % 2) * 2; arr0 = 18 + t * 4 + hbase; }
            const bool rope = (t < 2) && (wc == 0);
            const float sc = (t == 0) ? 0.08838834764831845f : 1.0f;
#pragma unroll
            for (int ai = 0; ai < 2; ++ai)
#pragma unroll
                for (int m = 0; m < 4; ++m) {
                    const int row = row0 + ai * 128 + m * 16;
#pragma unroll
                    for (int bj = 0; bj < 2; ++bj) {
                        f32x4 v0 = acc[ai][bj][m][0], v1 = acc[ai][bj][m][1];
                        if (rope) {
                            const f32x4 c0 = *(const f32x4*)(cosT + (size_t)row * 16 + 8 * (fq & 1)), c1 = *(const f32x4*)(cosT + (size_t)row * 16 + 8 * (fq & 1) + 4);
                            const f32x4 s0 = *(const f32x4*)(sinT + (size_t)row * 16 + 8 * (fq & 1)), s1 = *(const f32x4*)(sinT + (size_t)row * 16 + 8 * (fq & 1) + 4);
                            const float sgn = (fq < 2) ? -1.0f : 1.0f;
#pragma unroll
                            for (int j = 0; j < 4; ++j) {
                                const float p0 = __shfl_xor(v0[j], 32), p1 = __shfl_xor(v1[j], 32);
                                v0[j] = v0[j] * c0[j] + sgn * p0 * s0[j];
                                v1[j] = v1[j] * c1[j] + sgn * p1 * s1[j];
                            }
                        }
                        v0 *= sc; v1 *= sc;
                        bf16_t* dst = P2 + (size_t)(arr0 + bj) * ((size_t)S * 128) + (size_t)row * 128 + cl;
                        u32x4 w; w.x = cvt_pk_bf16(v0[0], v0[1]); w.y = cvt_pk_bf16(v0[2], v0[3]); w.z = cvt_pk_bf16(v1[0], v1[1]); w.w = cvt_pk_bf16(v1[2], v1[3]);
                        *(u32x4*)dst = w;
                    }
                    __builtin_amdgcn_sched_barrier(0);
                }
        }
    }
};

struct EpiBranch {
    const bf16_t* Gb; bf16_t* Mg; int first;
    DEVI void operator()(const f32x4 (&acc)[2][2][4][2], const Unit& u, int wr, int wc, int fr, int fq) const {
        const int row0 = u.pm * 256 + wr * 64 + fr; const int col0 = u.pn * 256 + wc * 32 + 8 * fq;
        u32x4 gwn[2], mwn[2];
        {
            const int row = row0;
#pragma unroll
            for (int bj = 0; bj < 2; ++bj) { gwn[bj] = *(const u32x4*)(Gb + (size_t)row * 8192 + col0 + bj * 128); mwn[bj] = first ? (u32x4){0u, 0u, 0u, 0u} : *(const u32x4*)(Mg + (size_t)row * 2048 + col0 + bj * 128); }
        }
#pragma unroll
        for (int idx = 0; idx < 8; ++idx) {
            const int ai = idx >> 2, m = idx & 3;
            const int row = row0 + ai * 128 + m * 16;
            u32x4 gw[2], mw[2];
#pragma unroll
            for (int bj = 0; bj < 2; ++bj) { gw[bj] = gwn[bj]; mw[bj] = mwn[bj]; }
            if (idx + 1 < 8) {
                const int rown = row0 + ((idx + 1) >> 2) * 128 + ((idx + 1) & 3) * 16;
#pragma unroll
                for (int bj = 0; bj < 2; ++bj) { gwn[bj] = *(const u32x4*)(Gb + (size_t)rown * 8192 + col0 + bj * 128); mwn[bj] = first ? (u32x4){0u, 0u, 0u, 0u} : *(const u32x4*)(Mg + (size_t)rown * 2048 + col0 + bj * 128); }
            }
            asm volatile("" ::: "memory"); __builtin_amdgcn_sched_barrier(0);
#pragma unroll
            for (int bj = 0; bj < 2; ++bj) {
                float o[8];
#pragma unroll
                for (int j = 0; j < 4; ++j) { o[j] = acc[ai][bj][m][0][j]; o[4 + j] = acc[ai][bj][m][1][j]; }
#pragma unroll
                for (int j = 0; j < 4; ++j) {
                    o[2 * j] = o[2 * j] * __uint_as_float(gw[bj][j] << 16) + __uint_as_float(mw[bj][j] << 16);
                    o[2 * j + 1] = o[2 * j + 1] * __uint_as_float(gw[bj][j] & 0xFFFF0000u) + __uint_as_float(mw[bj][j] & 0xFFFF0000u);
                }
                u32x4 w; w.x = cvt_pk_bf16(o[0], o[1]); w.y = cvt_pk_bf16(o[2], o[3]); w.z = cvt_pk_bf16(o[4], o[5]); w.w = cvt_pk_bf16(o[6], o[7]);
                *(u32x4*)(Mg + (size_t)row * 2048 + col0 + bj * 128) = w;
            }
            asm volatile("" ::: "memory"); __builtin_amdgcn_sched_barrier(0);
        }
    }
};

struct EpiResid {
    const float* src; float* dst; const float* gate;
    DEVI void operator()(const f32x4 (&acc)[2][2][4][2], const Unit& u, int wr, int wc, int fr, int fq) const {
        const int row0 = u.pm * 256 + wr * 64 + fr; const int col0 = u.pn * 256 + wc * 32 + 8 * fq;
        f32x4 gv[2][2];
#pragma unroll
        for (int bj = 0; bj < 2; ++bj)
#pragma unroll
            for (int n = 0; n < 2; ++n) gv[bj][n] = *(const f32x4*)(gate + col0 + bj * 128 + 4 * n);
        f32x4 xn[2][2];
        {
            const size_t ro = (size_t)row0 * 2048 + col0;
#pragma unroll
            for (int bj = 0; bj < 2; ++bj)
#pragma unroll
                for (int n = 0; n < 2; ++n) xn[bj][n] = *(const f32x4*)(src + ro + bj * 128 + 4 * n);
        }
#pragma unroll
        for (int idx = 0; idx < 8; ++idx) {
            const int ai = idx >> 2, m = idx & 3;
            const size_t ro = (size_t)(row0 + ai * 128 + m * 16) * 2048 + col0;
            f32x4 xv[2][2];
#pragma unroll
            for (int bj = 0; bj < 2; ++bj)
#pragma unroll
                for (int n = 0; n < 2; ++n) xv[bj][n] = xn[bj][n];
            if (idx + 1 < 8) {
                const size_t ron = (size_t)(row0 + ((idx + 1) >> 2) * 128 + ((idx + 1) & 3) * 16) * 2048 + col0;
#pragma unroll
                for (int bj = 0; bj < 2; ++bj)
#pragma unroll
                    for (int n = 0; n < 2; ++n) xn[bj][n] = *(const f32x4*)(src + ron + bj * 128 + 4 * n);
            }
            asm volatile("" ::: "memory"); __builtin_amdgcn_sched_barrier(0);
#pragma unroll
            for (int bj = 0; bj < 2; ++bj)
#pragma unroll
                for (int n = 0; n < 2; ++n) *(f32x4*)(dst + ro + bj * 128 + 4 * n) = xv[bj][n] + gv[bj][n] * acc[ai][bj][m][n];
            asm volatile("" ::: "memory"); __builtin_amdgcn_sched_barrier(0);
        }
    }
};

struct EpiSwiglu {
    bf16_t* act;
    DEVI void operator()(const f32x4 (&acc)[2][2][4][2], const Unit& u, int wr, int wc, int fr, int fq) const {
        const int row0 = u.pm * 256 + wr * 64 + fr; const int col0 = u.pn * 128 + wc * 32 + 8 * fq;
#pragma unroll
        for (int ai = 0; ai < 2; ++ai)
#pragma unroll
            for (int m = 0; m < 4; ++m) {
                float o[8];
#pragma unroll
                for (int j = 0; j < 4; ++j) { o[j] = siluf_(acc[ai][0][m][0][j]) * acc[ai][1][m][0][j]; o[4 + j] = siluf_(acc[ai][0][m][1][j]) * acc[ai][1][m][1][j]; }
                u32x4 w; w.x = cvt_pk_bf16(o[0], o[1]); w.y = cvt_pk_bf16(o[2], o[3]); w.z = cvt_pk_bf16(o[4], o[5]); w.w = cvt_pk_bf16(o[6], o[7]);
                *(u32x4*)(act + (size_t)(row0 + ai * 128 + m * 16) * FFN_H + col0) = w;
                __builtin_amdgcn_sched_barrier(0);
            }
    }
};

template <class Epi>
DEVI void run_gemm(unsigned char* smem, const bf16_t* A, const bf16_t* Bt, int N, int K, const Epi& E) {
    pg8::Gemm g; g.A = A; g.Bt = Bt; g.M = S; g.N = N; g.K = K;
    pg8::StaticOrder so; so.init(S, N, gridDim.x, blockIdx.x);
    pg8::gemm_phase<Epi>((LAS unsigned char*)smem, g, so, E);
}

DEVI int srccol_win(int n) {
    if (n < 8192) return n;
    if (n < 9984) { const int j = n - 8192; return j < 1552 ? 8192 + j : -1; }
    if (n < 12288) return 9744 + (n - 9984);
    if (n < 14336) { const int j = n - 12288; return j < 1984 ? 12048 + j : -1; }
    return 14032 + (n - 14336);
}
DEVI int srccol_ffn(int n) { return ((n >> 7) & 1) * FFN_H + (n >> 8) * 128 + (n & 127); }

DEVI void conv_tile(unsigned char* smem, const float* src, int ldsrc, int K, bf16_t* dst, int mode, int ntile, int ktile) {
    int tid_ = threadIdx.x; asm volatile("" : "+v"(tid_));
    float* tile = (float*)smem;
    const int tid = tid_, tx = tid & 63, ty = tid >> 6;
    const int n0 = ntile * 64, k0 = ktile * 64;
    const int n = n0 + tx;
    const int sc = mode == 0 ? srccol_win(n) : (mode == 1 ? srccol_ffn(n) : n);
#pragma unroll
    for (int i = 0; i < 8; ++i) {
        const int kk = ty + 8 * i;
        tile[kk * 65 + tx] = sc >= 0 ? src[(size_t)(k0 + kk) * ldsrc + sc] : 0.0f;
    }
    __syncthreads();
    const int nr = tid >> 3, ks = (tid & 7) * 8;
    float v[8];
#pragma unroll
    for (int j = 0; j < 8; ++j) v[j] = tile[(ks + j) * 65 + nr];
    u32x4 w; w.x = cvt_pk_bf16(v[0], v[1]); w.y = cvt_pk_bf16(v[2], v[3]); w.z = cvt_pk_bf16(v[4], v[5]); w.w = cvt_pk_bf16(v[6], v[7]);
    *(u32x4*)(dst + (size_t)(n0 + nr) * K + k0 + ks) = w;
    __syncthreads();
}

DEVI void phase_convert(const Params& p, int l, unsigned char* smem, int bid, int nb) {
    const int c0 = 248 * 32, c1 = c0 + 32 * 8, c2 = c1 + 32 * 4, c3 = c2 + 32 * 8, c4 = c3 + 32 * 8, c5 = c4 + 32 * 32, c6 = c5 + 176 * 32, c7 = c6 + 32 * 88;
    unsigned char* ws = p.ws;
    {
        int tl_ = threadIdx.x; asm volatile("" : "+v"(tl_)); int ll_ = l; asm volatile("" : "+s"(ll_));
        size_t wzz_ = 0; asm volatile("" : "+s"(wzz_));
        bf16_t* WT = (bf16_t*)(ws + wzz_ + OFF_LORA);
        const float* w2 = (const float*)p.in[12] + (size_t)ll_ * 96 * 512; const float* a2 = (const float*)p.in[14] + (size_t)ll_ * 96 * 512; const float* g2 = (const float*)p.in[15] + (size_t)ll_ * 256 * 512;
        for (int k = bid; k < 448; k += nb) {
            const int n = tl_;
            const float v = k < 96 ? w2[k * 512 + n] : (k < 192 ? a2[(k - 96) * 512 + n] : g2[(k - 192) * 512 + n]);
            WT[n * 448 + k] = f2bf(v);
        }
    }
    for (int it = bid; it < c7; it += nb) {
        if (it < c0) { conv_tile(smem, (const float*)p.in[6] + (size_t)l * D * IN_TOTAL, IN_TOTAL, D, (bf16_t*)(ws + OFF_WIN), 0, it / 32, it % 32); }
        else if (it < c1) { const int j = it - c0; conv_tile(smem, (const float*)p.in[24] + (size_t)l * 512 * D, D, 512, (bf16_t*)(ws + OFF_WBA), 2, j / 8, j % 8); }
        else if (it < c2) { const int j = it - c1; conv_tile(smem, (const float*)p.in[25] + (size_t)l * 256 * D, D, 256, (bf16_t*)(ws + OFF_WBB), 2, j / 4, j % 4); }
        else if (it < c3) { const int j = it - c2; conv_tile(smem, (const float*)p.in[26] + (size_t)l * 512 * D, D, 512, (bf16_t*)(ws + OFF_WBC), 2, j / 8, j % 8); }
        else if (it < c4) { const int j = it - c3; conv_tile(smem, (const float*)p.in[27] + (size_t)l * 512 * D, D, 512, (bf16_t*)(ws + OFF_WBD), 2, j / 8, j % 8); }
        else if (it < c5) { const int j = it - c4; conv_tile(smem, (const float*)p.in[28] + (size_t)l * D * D, D, D, (bf16_t*)(ws + OFF_WOUT), 2, j / 32, j % 32); }
        else if (it < c6) { const int j = it - c5; conv_tile(smem, (const float*)p.in[30] + (size_t)l * D * 2 * FFN_H, 2 * FFN_H, D, (bf16_t*)(ws + OFF_WF1), 1, j / 32, j % 32); }
        else { const int j = it - c6; conv_tile(smem, (const float*)p.in[31] + (size_t)l * FFN_H * D, D, FFN_H, (bf16_t*)(ws + OFF_WF2), 2, j / 88, j % 88); }
    }
}

DEVI void phase_mod_rope(const Params& p, unsigned char* smem, int bid, int nb) {
    int tid_ = threadIdx.x; asm volatile("" : "+v"(tid_)); size_t wz_ = 0; asm volatile("" : "+s"(wz_)); unsigned char* ws_ = p.ws + wz_;
    const int tid = tid_;
    float* sc = (float*)smem;
    float* red = sc + 2048;
    const float* c = (const float*)p.in[1];
    for (int i = tid; i < D; i += NT) sc[i] = siluf_(c[i]);
    __syncthreads();
    float* mod = (float*)(ws_ + OFF_MOD);
    for (int it = bid; it < 192; it += nb) {
        const int l = it / 96, cg0 = (it % 96) * 128;
        const float* W = (const float*)p.in[3] + (size_t)l * D * 12288;
        const int col = tid & 127, kq = tid >> 7;
        float a = 0.f;
        const float* wp = W + (size_t)(kq * 512) * 12288 + cg0 + col;
#pragma unroll 8
        for (int k = 0; k < 512; ++k) a += sc[kq * 512 + k] * wp[(size_t)k * 12288];
        red[kq * 128 + col] = a;
        __syncthreads();
        if (tid < 128) mod[l * 12288 + cg0 + tid] = red[tid] + red[128 + tid] + red[256 + tid] + red[384 + tid] + ((const float*)p.in[4])[l * 12288 + cg0 + tid];
        __syncthreads();
    }
    const float invf[16] = {1.000000000e+00f, 4.403665960e-01f, 1.939227432e-01f, 8.539710194e-02f, 3.760603070e-02f, 1.656043902e-02f, 7.292664610e-03f, 3.211445874e-03f,
                            1.414213562e-03f, 6.227723788e-04f, 2.742481884e-04f, 1.207697351e-04f, 5.318296098e-05f, 2.341999971e-05f, 1.031338616e-05f, 4.541670478e-06f};
    const int* pos = (const int*)p.in[2];
    float* cosT = (float*)(ws_ + OFF_COS); float* sinT = (float*)(ws_ + OFF_SIN);
    for (int e = bid * NT + tid; e < S * 16; e += nb * NT) {
        const int t = e >> 4, i = e & 15;
        float fi = invf[0];
#pragma unroll
        for (int j = 1; j < 16; ++j) fi = (i == j) ? invf[j] : fi;
        const float ang = (float)pos[t] * fi;
        const double a = (double)ang;
        const double kq = __builtin_rint(a * 0.15915494309189535);
        const double r = a - kq * 6.283185307179586;
        const double y = r * 0.25, y2 = y * y;
        double s = y * (1.0 - y2 / 6.0 * (1.0 - y2 / 20.0 * (1.0 - y2 / 42.0 * (1.0 - y2 / 72.0 * (1.0 - y2 / 110.0 * (1.0 - y2 / 156.0))))));
        double cc = 1.0 - y2 / 2.0 * (1.0 - y2 / 12.0 * (1.0 - y2 / 30.0 * (1.0 - y2 / 56.0 * (1.0 - y2 / 90.0 * (1.0 - y2 / 132.0 * (1.0 - y2 / 182.0))))));
        double s2 = 2.0 * s * cc, c2 = 1.0 - 2.0 * s * s;
        double s4 = 2.0 * s2 * c2, c4 = 1.0 - 2.0 * s2 * s2;
        cosT[e] = (float)c4; sinT[e] = (float)s4;
    }
}

DEVI void phase_norm(const float* x, const float* gain, const float* shift, const float* scale, bf16_t* h, int bid, int nb) {
    int tid_ = threadIdx.x; asm volatile("" : "+v"(tid_));
    const int wid = tid_ >> 6, lane = tid_ & 63;
    for (int row = bid * 8 + wid; row < S; row += nb * 8) {
        const f32x4* xr = (const f32x4*)(x + (size_t)row * D);
        f32x4 v[8]; float ss = 0.f;
#pragma unroll
        for (int i = 0; i < 8; ++i) { v[i] = xr[lane + 64 * i]; ss += v[i][0] * v[i][0] + v[i][1] * v[i][1] + v[i][2] * v[i][2] + v[i][3] * v[i][3]; }
        ss = wave_sum(ss);
        const float r = rsqrtf(ss * (1.0f / D) + 1e-6f);
#pragma unroll
        for (int i = 0; i < 8; ++i) {
            const int c4 = lane + 64 * i;
            const f32x4 g = ((const f32x4*)gain)[c4], sh = ((const f32x4*)shift)[c4], sc = ((const f32x4*)scale)[c4];
            f32x4 y = v[i] * r * g * (sc + 1.0f) + sh;
            u32x2 w; w.x = cvt_pk_bf16(y[0], y[1]); w.y = cvt_pk_bf16(y[2], y[3]);
            *(u32x2*)(h + (size_t)row * D + c4 * 4) = w;
        }
    }
}

DEVI void phase_final_norm(float* x, const float* gain, int bid, int nb) {
    int tid_ = threadIdx.x; asm volatile("" : "+v"(tid_));
    const int wid = tid_ >> 6, lane = tid_ & 63;
    for (int row = bid * 8 + wid; row < S; row += nb * 8) {
        f32x4* xr = (f32x4*)(x + (size_t)row * D);
        f32x4 v[8]; float ss = 0.f;
#pragma unroll
        for (int i = 0; i < 8; ++i) { v[i] = xr[lane + 64 * i]; ss += v[i][0] * v[i][0] + v[i][1] * v[i][1] + v[i][2] * v[i][2] + v[i][3] * v[i][3]; }
        ss = wave_sum(ss);
        const float r = rsqrtf(ss * (1.0f / D) + 1e-6f);
#pragma unroll
        for (int i = 0; i < 8; ++i) xr[lane + 64 * i] = v[i] * r * ((const f32x4*)gain)[lane + 64 * i];
    }
}

DEVI float logsigmoidf_(float x) { return fminf(x, 0.f) - log1pf(__expf(-fabsf(x))); }

DEVI void gla_pass1(const Params& p, int l, unsigned char* smem, int item) {
    int tid_ = threadIdx.x; asm volatile("" : "+v"(tid_)); size_t wz_ = 0; asm volatile("" : "+s"(wz_)); unsigned char* ws_ = p.ws + wz_;
    const int n = item >> 2, h = item & 3, tok0 = n * 64, tid = tid_;
    float* sB = (float*)smem;
    float* sK = sB + 4096;
    float* sV = sK + 4096;
    float* sA = sV + 8192;
    float* sW = sA + 1024;
    const bf16_t* P = (const bf16_t*)(ws_ + OFF_P1G);
    const float* wa2 = (const float*)p.in[7] + (size_t)l * 16 * 256;
    const float* ba2 = (const float*)p.in[8] + (size_t)l * 256;
    for (int e = tid; e < 1024; e += NT) { sA[e] = bf2f(P[(size_t)(tok0 + (e >> 4)) * 1792 + 1536 + (e & 15)]); sW[e] = wa2[(e >> 6) * 256 + h * 64 + (e & 63)]; }
    __syncthreads();
    for (int e = tid; e < 4096; e += NT) {
        const int t = e >> 6, d = e & 63;
        float x = ba2[h * 64 + d];
#pragma unroll
        for (int r = 0; r < 16; ++r) x += sA[t * 16 + r] * sW[r * 64 + d];
        sB[e] = logsigmoidf_(x) * (1.0f / 16.0f);
    }
    __syncthreads();
    if (tid < 64) { float a = 0.f; for (int t = 0; t < 64; ++t) { a += sB[t * 64 + tid]; sB[t * 64 + tid] = a; } }
    __syncthreads();
    float* Bbuf = (float*)(ws_ + OFF_GLB);
    for (int e = tid; e < 4096; e += NT) {
        const int s = e >> 6, d = e & 63;
        const float b = sB[e], bl = sB[63 * 64 + d];
        sK[e] = bf2f(P[(size_t)(tok0 + s) * 1792 + 256 + h * 64 + d]) * __expf(bl - b);
        Bbuf[(size_t)(tok0 + s) * 256 + h * 64 + d] = b;
    }
    for (int e = tid; e < 8192; e += NT) sV[e] = bf2f(P[(size_t)(tok0 + (e >> 7)) * 1792 + 512 + h * 128 + (e & 127)]);
    if (tid < 64) ((float*)(ws_ + OFF_GLD))[(size_t)item * 64 + tid] = __expf(sB[63 * 64 + tid]);
    __syncthreads();
    {
        const int d = tid >> 3, eg = (tid & 7) * 16;
        f32x4 a0 = {0, 0, 0, 0}, a1 = a0, a2 = a0, a3 = a0;
        for (int s = 0; s < 64; ++s) {
            const float kd = sK[s * 64 + d];
            const f32x4* vp = (const f32x4*)(sV + s * 128 + eg);
            a0 += kd * vp[0]; a1 += kd * vp[1]; a2 += kd * vp[2]; a3 += kd * vp[3];
        }
        f32x4* Lp = (f32x4*)((float*)(ws_ + OFF_GLL) + ((size_t)item * 64 + d) * 128 + eg);
        Lp[0] = a0; Lp[1] = a1; Lp[2] = a2; Lp[3] = a3;
    }
    __syncthreads();
}

DEVI void gla_pass2(const Params& p, int item) {
    int tid_ = threadIdx.x; asm volatile("" : "+v"(tid_)); size_t wz_ = 0; asm volatile("" : "+s"(wz_)); unsigned char* ws_ = p.ws + wz_;
    const int idx = item * NT + tid_;
    const int h = idx >> 13, de = idx & 8191, d = de >> 7;
    float* L = (float*)(ws_ + OFF_GLL); const float* Dc = (const float*)(ws_ + OFF_GLD);
    float st = 0.f;
    for (int n0 = 0; n0 < 256; n0 += 8) {
        float tmp[8], dc[8];
#pragma unroll
        for (int j = 0; j < 8; ++j) { tmp[j] = L[((size_t)((n0 + j) * 4 + h) * 64) * 128 + de]; dc[j] = Dc[((n0 + j) * 4 + h) * 64 + d]; }
#pragma unroll
        for (int j = 0; j < 8; ++j) { L[((size_t)((n0 + j) * 4 + h) * 64) * 128 + de] = st; st = dc[j] * st + tmp[j]; }
    }
}

DEVI void gla_pass3(const Params& p, int l, unsigned char* smem, int item) {
    int tid_ = threadIdx.x; asm volatile("" : "+v"(tid_)); size_t wz_ = 0; asm volatile("" : "+s"(wz_)); unsigned char* ws_ = p.ws + wz_;
    const int n = item >> 2, h = item & 3, tok0 = n * 64, tid = tid_;
    float* sQ = (float*)smem;
    float* sK = sQ + 4096;
    float* sV = sK + 4160;
    float* sS = sV + 8192;
    float* sSc = sS + 8192;
    const bf16_t* P = (const bf16_t*)(ws_ + OFF_P1G);
    const float* Bbuf = (const float*)(ws_ + OFF_GLB);
    for (int e = tid; e < 4096; e += NT) {
        const int t = e >> 6, d = e & 63;
        const float b = Bbuf[(size_t)(tok0 + t) * 256 + h * 64 + d];
        sQ[e] = bf2f(P[(size_t)(tok0 + t) * 1792 + h * 64 + d]) * 0.125f * __expf(b);
        sK[t * 65 + d] = bf2f(P[(size_t)(tok0 + t) * 1792 + 256 + h * 64 + d]) * __expf(-b);
    }
    const float* Lp = (const float*)(ws_ + OFF_GLL) + (size_t)item * 8192;
    for (int e = tid; e < 8192; e += NT) { sV[e] = bf2f(P[(size_t)(tok0 + (e >> 7)) * 1792 + 512 + h * 128 + (e & 127)]); sS[e] = Lp[e]; }
    __syncthreads();
    {
        const int t = tid >> 3, sg = (tid & 7) * 8;
        float a[8];
#pragma unroll
        for (int j = 0; j < 8; ++j) a[j] = 0.f;
        for (int d = 0; d < 64; ++d) {
            const float qv = sQ[t * 64 + d];
#pragma unroll
            for (int j = 0; j < 8; ++j) a[j] += qv * sK[(sg + j) * 65 + d];
        }
#pragma unroll
        for (int j = 0; j < 8; ++j) sSc[t * 64 + sg + j] = (sg + j <= t) ? a[j] : 0.f;
    }
    __syncthreads();
    {
        const int t = tid >> 3, eg = (tid & 7) * 16;
        f32x4 a0 = {0, 0, 0, 0}, a1 = a0, a2 = a0, a3 = a0;
        for (int d = 0; d < 64; ++d) {
            const float qv = sQ[t * 64 + d];
            const f32x4* sp = (const f32x4*)(sS + d * 128 + eg);
            a0 += qv * sp[0]; a1 += qv * sp[1]; a2 += qv * sp[2]; a3 += qv * sp[3];
        }
        for (int s = 0; s < 64; ++s) {
            const float sc = sSc[t * 64 + s];
            const f32x4* vp = (const f32x4*)(sV + s * 128 + eg);
            a0 += sc * vp[0]; a1 += sc * vp[1]; a2 += sc * vp[2]; a3 += sc * vp[3];
        }
        float ss = 0.f;
#pragma unroll
        for (int j = 0; j < 4; ++j) ss += a0[j] * a0[j] + a1[j] * a1[j] + a2[j] * a2[j] + a3[j] * a3[j];
        ss += __shfl_xor(ss, 1); ss += __shfl_xor(ss, 2); ss += __shfl_xor(ss, 4);
        const float r = rsqrtf(ss * (1.0f / 128.0f) + 1e-6f);
        const float* gn = (const float*)p.in[9] + (size_t)l * 128 + eg;
        const bf16_t* gp = P + (size_t)(tok0 + t) * 1792 + 1024 + h * 128 + eg;
        float o[16];
#pragma unroll
        for (int j = 0; j < 4; ++j) { o[j] = a0[j]; o[4 + j] = a1[j]; o[8 + j] = a2[j]; o[12 + j] = a3[j]; }
#pragma unroll
        for (int j = 0; j < 16; ++j) o[j] = o[j] * r * gn[j] * siluf_(bf2f(gp[j]));
        bf16_t* op = (bf16_t*)(ws_ + OFF_OGLA) + (size_t)(tok0 + t) * 512 + h * 128 + eg;
        u32x4 w0, w1;
        w0.x = cvt_pk_bf16(o[0], o[1]); w0.y = cvt_pk_bf16(o[2], o[3]); w0.z = cvt_pk_bf16(o[4], o[5]); w0.w = cvt_pk_bf16(o[6], o[7]);
        w1.x = cvt_pk_bf16(o[8], o[9]); w1.y = cvt_pk_bf16(o[10], o[11]); w1.z = cvt_pk_bf16(o[12], o[13]); w1.w = cvt_pk_bf16(o[14], o[15]);
        *(u32x4*)op = w0; *(u32x4*)(op + 8) = w1;
    }
    __syncthreads();
}

DEVI void rwkv_prep(const Params& p, int l, unsigned char* smem, int item) {
    int tid_ = threadIdx.x; asm volatile("" : "+v"(tid_)); size_t wz_ = 0; asm volatile("" : "+s"(wz_)); unsigned char* ws_ = p.ws + wz_;
    const int tok0 = item * 16, c = tid_, tid = tid_;
    bf16_t* sX = (bf16_t*)smem;
    float* sAcc = (float*)(smem + 16384);
    float* sVx = (float*)(smem + 16384);
    float* sMid = sVx + 512 * 16;
    const bf16_t* P = (const bf16_t*)(ws_ + OFF_P1R);
    const float* mu = (const float*)p.in[10] + (size_t)l * 1984;
    bf16_t lx[14], lxp[14];
#pragma unroll
    for (int i = 0; i < 14; ++i) {
        const int e = tid + i * NT, t = e / 448, j = e % 448, col = 1536 + j, tok = tok0 + t;
        lx[i] = P[(size_t)tok * 2048 + col]; lxp[i] = tok > 0 ? P[(size_t)(tok - 1) * 2048 + col] : (bf16_t)0;
    }
#pragma unroll
    for (int i = 0; i < 14; ++i) {
        const int e = tid + i * NT;
        const int t = e / 448, j = e % 448, col = 1536 + j;
        const float x = bf2f(lx[i]);
        const float xp = bf2f(lxp[i]);
        const float xs = x + (xp - x) * mu[col];
        float v;
        if (j < 96) { const float e2 = __expf(2.0f * xs); v = 1.0f - 2.0f * __builtin_amdgcn_rcpf(e2 + 1.0f); }
        else if (j < 192) v = xs;
        else v = sigmoidf_(xs);
        sX[t * 456 + j] = f2bf(v);
    }
    const float mu_r = mu[c], mu_k = mu[512 + c], mu_v = mu[1024 + c];
    bf16_t xv[17];
    xv[0] = tok0 > 0 ? P[(size_t)(tok0 - 1) * 2048 + 1024 + c] : (bf16_t)0;
#pragma unroll
    for (int t = 0; t < 16; ++t) xv[t + 1] = P[(size_t)(tok0 + t) * 2048 + 1024 + c];
    __syncthreads();
    {
        const int wid = tid >> 6, lane = tid & 63, li = lane & 15, g = lane >> 4;
        const bf16_t* WT = (const bf16_t*)(ws_ + OFF_LORA);
#pragma unroll
        for (int lo = 0; lo < 3; ++lo) {
            const int kb = lo == 0 ? 0 : (lo == 1 ? 96 : 192), nks = lo == 2 ? 8 : 3;
            f32x4 acc[4];
#pragma unroll
            for (int q = 0; q < 4; ++q) acc[q] = (f32x4){0.f, 0.f, 0.f, 0.f};
            for (int ks = 0; ks < nks; ++ks) {
                const bf16x8 af = *(const bf16x8*)(sX + li * 456 + kb + ks * 32 + g * 8);
#pragma unroll
                for (int q = 0; q < 4; ++q) {
                    const bf16x8 bfr = *(const bf16x8*)(WT + (size_t)((wid * 4 + q) * 16 + li) * 448 + kb + ks * 32 + g * 8);
                    acc[q] = __builtin_amdgcn_mfma_f32_16x16x32_bf16(af, bfr, acc[q], 0, 0, 0);
                }
            }
#pragma unroll
            for (int q = 0; q < 4; ++q)
#pragma unroll
                for (int r = 0; r < 4; ++r) sAcc[(lo * 16 + 4 * g + r) * 512 + (wid * 4 + q) * 16 + li] = acc[q][r];
        }
    }
    __syncthreads();
    float wacc[16], aacc[16], gacc[16];
#pragma unroll
    for (int t = 0; t < 16; ++t) { wacc[t] = sAcc[t * 512 + c]; aacc[t] = sAcc[(16 + t) * 512 + c]; gacc[t] = sAcc[(32 + t) * 512 + c]; }
    __syncthreads();
#pragma unroll
    for (int t = 0; t < 16; ++t) { const float x = bf2f(xv[t + 1]), xp = bf2f(xv[t]); sVx[c * 16 + t] = x + (xp - x) * mu_v; }
    __syncthreads();
    float vacc[16];
#pragma unroll
    for (int t = 0; t < 16; ++t) vacc[t] = 0.f;
    if (l > 0) {
        const float* v1 = (const float*)p.in[22];
        const float* v2 = (const float*)p.in[23];
        {
            const int m = tid & 63, cp = tid >> 6;
            float ma[16];
#pragma unroll
            for (int t = 0; t < 16; ++t) ma[t] = 0.f;
#pragma unroll 8
            for (int cc = 0; cc < 64; ++cc) {
                const float w = v1[(cp * 64 + cc) * 64 + m]; const f32x4* lp = (const f32x4*)(sVx + (cp * 64 + cc) * 16);
#pragma unroll
                for (int q = 0; q < 4; ++q) { const f32x4 x = lp[q]; ma[4 * q] += x[0] * w; ma[4 * q + 1] += x[1] * w; ma[4 * q + 2] += x[2] * w; ma[4 * q + 3] += x[3] * w; }
            }
            float* sP = sMid + 64 * 16;
#pragma unroll
            for (int q = 0; q < 4; ++q) *(f32x4*)(sP + (cp * 64 + m) * 16 + 4 * q) = (f32x4){ma[4 * q], ma[4 * q + 1], ma[4 * q + 2], ma[4 * q + 3]};
            __syncthreads();
            for (int e = tid; e < 1024; e += NT) {
                float a = 0.f;
#pragma unroll
                for (int k = 0; k < 8; ++k) a += sP[k * 1024 + e];
                sMid[e] = a;
            }
        }
        __syncthreads();
#pragma unroll 8
        for (int m = 0; m < 64; ++m) {
            const float w = v2[m * 512 + c]; const f32x4* lp = (const f32x4*)(sMid + m * 16);
#pragma unroll
            for (int q = 0; q < 4; ++q) { const f32x4 x = lp[q]; vacc[4 * q] += x[0] * w; vacc[4 * q + 1] += x[1] * w; vacc[4 * q + 2] += x[2] * w; vacc[4 * q + 3] += x[3] * w; }
        }
    }
    const float w0 = ((const float*)p.in[11])[l * 512 + c], a0 = ((const float*)p.in[13])[l * 512 + c];
    const float k_k = ((const float*)p.in[16])[l * 512 + c], k_a = ((const float*)p.in[17])[l * 512 + c];
    const float v0 = l > 0 ? ((const float*)p.in[21])[c] : 0.f;
    bf16_t* R = (bf16_t*)(ws_ + OFF_RWR); bf16_t* Kb = (bf16_t*)(ws_ + OFF_RWK); bf16_t* Vb = (bf16_t*)(ws_ + OFF_RWV);
    bf16_t* Ab = (bf16_t*)(ws_ + OFF_RWA); bf16_t* Bb = (bf16_t*)(ws_ + OFF_RWB); bf16_t* Gb = (bf16_t*)(ws_ + OFF_RWG);
    float* Wb = (float*)(ws_ + OFF_RWW); bf16_t* VF = (bf16_t*)(ws_ + OFF_VF);
    bf16_t xrr[17], xkr[17], vfr[16];
    xrr[0] = tok0 > 0 ? P[(size_t)(tok0 - 1) * 2048 + c] : (bf16_t)0; xkr[0] = tok0 > 0 ? P[(size_t)(tok0 - 1) * 2048 + 512 + c] : (bf16_t)0;
#pragma unroll
    for (int t = 0; t < 16; ++t) { xrr[t + 1] = P[(size_t)(tok0 + t) * 2048 + c]; xkr[t + 1] = P[(size_t)(tok0 + t) * 2048 + 512 + c]; vfr[t] = l > 0 ? VF[(size_t)(tok0 + t) * 512 + c] : (bf16_t)0; }
#pragma unroll
    for (int t = 0; t < 16; ++t) {
        const size_t tok = tok0 + t;
        const float xr = bf2f(xrr[t + 1]), xk = bf2f(xkr[t + 1]), xpr = bf2f(xrr[t]), xpk = bf2f(xkr[t]);
        const float r = xr + (xpr - xr) * mu_r, k = xk + (xpk - xk) * mu_k;
        float v = sVx[c * 16 + t];
        const float z = -(w0 + wacc[t]);
        const float sp = fmaxf(z, 0.f) + __logf(1.0f + __expf(-fabsf(z)));
        const float decay = __expf(-__expf(-sp - 0.5f));
        const float a = sigmoidf_(a0 + aacc[t]);
        if (l == 0) VF[tok * 512 + c] = f2bf(v);
        else { const float vf = bf2f(vfr[t]); v = v + (vf - v) * sigmoidf_(v0 + vacc[t]); }
        float kk = k * k_k;
        const float ss = wave_sum(kk * kk);
        kk = kk * __builtin_amdgcn_rcpf(fmaxf(__builtin_sqrtf(ss), 1e-12f));
        const float km = k * (1.0f + (a - 1.0f) * k_a);
        R[tok * 512 + c] = f2bf(r); Kb[tok * 512 + c] = f2bf(km); Vb[tok * 512 + c] = f2bf(v);
        Ab[tok * 512 + c] = f2bf(-kk); Bb[tok * 512 + c] = f2bf(kk * a); Gb[tok * 512 + c] = f2bf(gacc[t]);
        Wb[tok * 512 + c] = decay;
    }
    __syncthreads();
}

#define SBM do { asm volatile("" ::: "memory"); __builtin_amdgcn_sched_barrier(0); } while (0)
#define RAW_BAR do { asm volatile("s_waitcnt lgkmcnt(0)" ::: "memory"); __builtin_amdgcn_s_barrier(); asm volatile("" ::: "memory"); } while (0)
DEVI void rwkv_scan(const Params& p, unsigned char* smem, int b) {
    int tid_ = threadIdx.x; asm volatile("" : "+v"(tid_)); size_t wz_ = 0; asm volatile("" : "+s"(wz_)); unsigned char* ws_ = p.ws + wz_;
    constexpr int CH = 16, NR = 8, NCH = S / CH;
    constexpr int VEC = NR * 9 * 64, SCL = NR * 4, VVN = NR * 64 * 2, BUF = VEC + SCL + VVN;
    const int head = b >> 2, quarter = b & 3, tid = tid_, wid = tid >> 6, lane = tid & 63;
    float* stg = (float*)smem;
    float* part = stg + 2 * BUF;
    int* sRole = (int*)(part + 2 * CH * 256);
    const bf16_t* R = (const bf16_t*)(ws_ + OFF_RWR); const bf16_t* Kb = (const bf16_t*)(ws_ + OFF_RWK); const bf16_t* Vb = (const bf16_t*)(ws_ + OFF_RWV);
    const bf16_t* Ab = (const bf16_t*)(ws_ + OFF_RWA); const bf16_t* Bb = (const bf16_t*)(ws_ + OFF_RWB);
    const float* Wb = (const float*)(ws_ + OFF_RWW); float* Y = (float*)(ws_ + OFF_RWY);
    if (lane == 0) sRole[wid] = (int)((__builtin_amdgcn_s_getreg(2308)) & 3);
    __syncthreads();
    int role = -1;
    {
        int simd[8];
#pragma unroll
        for (int w = 0; w < 8; ++w) simd[w] = sRole[w];
        unsigned used_simd = 0u, scan_mask = 0u; int nscan = 0;
#pragma unroll
        for (int w = 0; w < 8; ++w) { const unsigned bit = 1u << simd[w]; if (!(used_simd & bit) && nscan < 4) { used_simd |= bit; scan_mask |= 1u << w; ++nscan; } }
#pragma unroll
        for (int w = 0; w < 8; ++w) { if (!((scan_mask >> w) & 1u) && nscan < 4) { scan_mask |= 1u << w; ++nscan; } }
        const int below = __builtin_popcount(scan_mask & ((1u << wid) - 1u));
        role = ((scan_mask >> wid) & 1u) ? below : 4 + (wid - below);
    }
    role = __builtin_amdgcn_readfirstlane(role);
    __syncthreads();
    const bool helper = role >= 4;
    const int lt = (role - 4) * 64 + lane;
    const bool hvec = lt < 128;
    const int hr = (lt >> 4) & 7, hc = lt & 15;
    struct Pre { u32x2 r1, k1, a1, b1, r2, k2, a2, b2; f32x4 w1, w2; };
    auto issue = [&](int chunk, Pre& q) {
        const size_t o1 = (size_t)(chunk * CH + 2 * hr) * 512 + head * 64 + 4 * hc, o2 = o1 + 512;
        if (hvec) {
            q.r1 = *(const u32x2*)(R + o1); q.k1 = *(const u32x2*)(Kb + o1); q.a1 = *(const u32x2*)(Ab + o1); q.b1 = *(const u32x2*)(Bb + o1); q.w1 = *(const f32x4*)(Wb + o1);
            q.r2 = *(const u32x2*)(R + o2); q.k2 = *(const u32x2*)(Kb + o2); q.a2 = *(const u32x2*)(Ab + o2); q.b2 = *(const u32x2*)(Bb + o2); q.w2 = *(const f32x4*)(Wb + o2);
        } else { q.r1 = *(const u32x2*)(Vb + o1); q.r2 = *(const u32x2*)(Vb + o2); }
    };
    auto cv4 = [&](const u32x2& w) { f32x4 f; f[0] = __uint_as_float(w.x << 16); f[1] = __uint_as_float(w.x & 0xFFFF0000u); f[2] = __uint_as_float(w.y << 16); f[3] = __uint_as_float(w.y & 0xFFFF0000u); return f; };
    auto sum4 = [&](const f32x4& x) { return (x[0] + x[1]) + (x[2] + x[3]); };
    auto commit = [&](int bi, const Pre& q) {
        float* base = stg + bi * BUF;
        if (hvec) {
            const f32x4 r1 = cv4(q.r1), k1 = cv4(q.k1), a1 = cv4(q.a1), b1 = cv4(q.b1), r2 = cv4(q.r2), k2 = cv4(q.k2), a2 = cv4(q.a2), b2 = cv4(q.b2), w1 = q.w1, w2 = q.w2;
            float* vp = base + hr * (9 * 64) + 4 * hc;
            *(f32x4*)(vp + 0 * 64) = a1;
            *(f32x4*)(vp + 1 * 64) = w1 * a2;
            *(f32x4*)(vp + 2 * 64) = w1 * r1;
            *(f32x4*)(vp + 3 * 64) = w1 * w2;
            *(f32x4*)(vp + 4 * 64) = b1 * w2;
            *(f32x4*)(vp + 5 * 64) = k1 * w2;
            *(f32x4*)(vp + 6 * 64) = b2;
            *(f32x4*)(vp + 7 * 64) = k2;
            *(f32x4*)(vp + 8 * 64) = r2;
            const float be = row16_sum(sum4(b1 * a2)), ka = row16_sum(sum4(k1 * a2)), rb = row16_sum(sum4(b1 * r1)), rk = row16_sum(sum4(k1 * r1));
            if (hc == 0) *(f32x4*)(base + VEC + hr * 4) = (f32x4){be, ka, rb * (1.0f / 16.0f), rk * (1.0f / 16.0f)};
        } else {
            const f32x4 v1 = cv4(q.r1), v2 = cv4(q.r2);
            float* vv = base + VEC + SCL + (hr * 64 + 4 * hc) * 2;
            *(f32x4*)vv = (f32x4){v1[0], v2[0], v1[1], v2[1]}; *(f32x4*)(vv + 4) = (f32x4){v1[2], v2[2], v1[3], v2[3]};
        }
    };
    auto reduce_store = [&](int chunk) {
        const int t = lt >> 4, k = (lt >> 2) & 3, rr = lt & 3;
        const f32x4* pp = (const f32x4*)(part + ((chunk & 1) * CH + t) * 256 + k * 64 + rr * 16);
        const f32x4 s4 = pp[0] + pp[1] + pp[2] + pp[3];
        Y[(size_t)(chunk * CH + t) * 512 + head * 64 + quarter * 16 + k * 4 + rr] = (s4[0] + s4[1]) + (s4[2] + s4[3]);
    };
    Pre pr0, pr1, pr2, pr3;
    if (helper) { issue(0, pr0); commit(0, pr0); issue(1, pr1); issue(2, pr2); issue(3, pr3); }
    __syncthreads();
    const int row = quarter * 16 + role * 4 + (lane >> 4), cgp = (lane & 15) * 4;
    f32x2 s01 = {0.f, 0.f}, s23 = {0.f, 0.f};
    if (helper) {
        for (int c0 = 0; c0 < NCH; c0 += 4) {
#define RW_HELP(u, PNEXT, PCUR) { const int c = c0 + (u); if (c + 1 < NCH) commit((c + 1) & 1, PNEXT); if (c + 4 < NCH) issue(c + 4, PCUR); if (c > 0) reduce_store(c - 1); RAW_BAR; }
            RW_HELP(0, pr1, pr0) RW_HELP(1, pr2, pr1) RW_HELP(2, pr3, pr2) RW_HELP(3, pr0, pr3)
#undef RW_HELP
        }
    } else for (int chunk = 0; chunk < NCH; ++chunk) {
        {
            const float* bb = stg + (chunk & 1) * BUF;
            float* pw = part + (chunk & 1) * (CH * 256) + role * 64 + lane;
            f32x4 A1, A2, R1, WW, BW, KW, B2, K2, R2, SC; f32x2 VV;
            f32x4 A1n, A2n, R1n, WWn, BWn, KWn, B2n, K2n, R2n, SCn; f32x2 VVn;
            {
                const float* vp = bb + cgp;
                A1n = *(const f32x4*)(vp); A2n = *(const f32x4*)(vp + 64); R1n = *(const f32x4*)(vp + 128); WWn = *(const f32x4*)(vp + 192); BWn = *(const f32x4*)(vp + 256);
                KWn = *(const f32x4*)(vp + 320); B2n = *(const f32x4*)(vp + 384); K2n = *(const f32x4*)(vp + 448); R2n = *(const f32x4*)(vp + 512);
                SCn = *(const f32x4*)(bb + VEC); VVn = *(const f32x2*)(bb + VEC + SCL + row * 2);
            }
#pragma unroll
            for (int rd = 0; rd < NR; ++rd) {
                A1 = A1n; A2 = A2n; R1 = R1n; WW = WWn; BW = BWn; KW = KWn; B2 = B2n; K2 = K2n; R2 = R2n; SC = SCn; VV = VVn;
                const bool pf = (rd + 1 < NR);
                const float* vp = bb + (rd + 1) * (9 * 64) + cgp;
                const float v1 = VV[0], v2 = VV[1];
                const f32x2 p1 = s01 * (f32x2){A1[0], A1[1]} + s23 * (f32x2){A1[2], A1[3]};
                const f32x2 p2 = s01 * (f32x2){A2[0], A2[1]} + s23 * (f32x2){A2[2], A2[3]};
                const f32x2 p3 = s01 * (f32x2){R1[0], R1[1]} + s23 * (f32x2){R1[2], R1[3]};
                float sa1 = p1[0] + p1[1], u2 = p2[0] + p2[1];
                SBM;
                if (pf) { A1n = *(const f32x4*)(vp); A2n = *(const f32x4*)(vp + 64); }
                SBM;
                sa1 += dpp_f<0xB1>(sa1); u2 += dpp_f<0xB1>(u2);
                SBM;
                if (pf) { R1n = *(const f32x4*)(vp + 128); WWn = *(const f32x4*)(vp + 192); }
                f32x2 t01 = s01 * (f32x2){WW[0], WW[1]} + v1 * (f32x2){KW[0], KW[1]};
                SBM;
                sa1 += dpp_f<0x4E>(sa1); u2 += dpp_f<0x4E>(u2);
                SBM;
                if (pf) { BWn = *(const f32x4*)(vp + 256); KWn = *(const f32x4*)(vp + 320); }
                f32x2 t23 = s23 * (f32x2){WW[2], WW[3]} + v1 * (f32x2){KW[2], KW[3]};
                SBM;
                sa1 += dpp_f<0x141>(sa1); u2 += dpp_f<0x141>(u2);
                SBM;
                if (pf) { B2n = *(const f32x4*)(vp + 384); K2n = *(const f32x4*)(vp + 448); }
                t01 += v2 * (f32x2){K2[0], K2[1]}; t23 += v2 * (f32x2){K2[2], K2[3]};
                SBM;
                sa1 += dpp_f<0x140>(sa1); u2 += dpp_f<0x140>(u2);
                SBM;
                if (pf) { R2n = *(const f32x4*)(vp + 512); SCn = *(const f32x4*)(bb + VEC + (rd + 1) * 4); VVn = *(const f32x2*)(bb + VEC + SCL + ((rd + 1) * 64 + row) * 2); }
                const float sa2 = __builtin_fmaf(sa1, SC[0], __builtin_fmaf(v1, SC[1], u2));
                t01 += sa1 * (f32x2){BW[0], BW[1]}; t23 += sa1 * (f32x2){BW[2], BW[3]};
                pw[(2 * rd) * 256] = __builtin_fmaf(sa1, SC[2], __builtin_fmaf(v1, SC[3], p3[0] + p3[1]));
                s01 = t01 + sa2 * (f32x2){B2[0], B2[1]}; s23 = t23 + sa2 * (f32x2){B2[2], B2[3]};
                const f32x2 p4 = s01 * (f32x2){R2[0], R2[1]} + s23 * (f32x2){R2[2], R2[3]};
                pw[(2 * rd + 1) * 256] = p4[0] + p4[1];
            }
        }
        RAW_BAR;
    }
    if (helper) reduce_store(NCH - 1);
    __threadfence();
    __syncthreads();
}
#undef SBM
#undef RAW_BAR

DEVI void rwkv_post(const Params& p, int l, int bid, int nb) {
    int tid_ = threadIdx.x; asm volatile("" : "+v"(tid_)); size_t wz_ = 0; asm volatile("" : "+s"(wz_)); unsigned char* ws_ = p.ws + wz_;
    const int wid = tid_ >> 6, lane = tid_ & 63, c = wid * 64 + lane;
    const bf16_t* R = (const bf16_t*)(ws_ + OFF_RWR); const bf16_t* Kb = (const bf16_t*)(ws_ + OFF_RWK); const bf16_t* Vb = (const bf16_t*)(ws_ + OFF_RWV);
    const bf16_t* Gb = (const bf16_t*)(ws_ + OFF_RWG); const float* Y = (const float*)(ws_ + OFF_RWY);
    bf16_t* O = (bf16_t*)(ws_ + OFF_ORWKV);
    const float rk = ((const float*)p.in[18])[l * 512 + c], lw = ((const float*)p.in[19])[l * 512 + c], lb = ((const float*)p.in[20])[l * 512 + c];
    for (int tok = bid; tok < S; tok += nb) {
        const size_t o = (size_t)tok * 512 + c;
        const float y = Y[o], r = bf2f(R[o]), k = bf2f(Kb[o]), v = bf2f(Vb[o]), g = bf2f(Gb[o]);
        const float mean = wave_sum(y) * (1.0f / 64.0f);
        const float dv = y - mean;
        const float var = wave_sum(dv * dv) * (1.0f / 64.0f);
        const float yn = dv * rsqrtf(var + 64e-5f) * lw + lb;
        const float bonus = wave_sum(r * k * rk) * v;
        O[o] = f2bf((yn + bonus) * g);
    }
}

template <int NQ>
DEVI void attn_compute(const bf16x8 (&kf0)[4], const bf16x8 (&kf1)[4], const bf16x8 (&vf)[8],
                       const bf16x8 (&qf)[NQ][4], const unsigned (&vmask)[NQ], f32x4 (&o)[NQ][8], float (&m)[NQ], float (&l)[NQ]) {
#pragma unroll
    for (int q = 0; q < NQ; ++q) {
        f32x4 s0 = {0.f, 0.f, 0.f, 0.f}, s1 = {0.f, 0.f, 0.f, 0.f};
#pragma unroll
        for (int ks = 0; ks < 4; ++ks) {
            s0 = __builtin_amdgcn_mfma_f32_16x16x32_bf16(kf0[ks], qf[q][ks], s0, 0, 0, 0);
            s1 = __builtin_amdgcn_mfma_f32_16x16x32_bf16(kf1[ks], qf[q][ks], s1, 0, 0, 0);
        }
        float sv[8];
#pragma unroll
        for (int j = 0; j < 4; ++j) { sv[j] = ((vmask[q] >> j) & 1u) ? s0[j] : -1e30f; sv[4 + j] = ((vmask[q] >> (4 + j)) & 1u) ? s1[j] : -1e30f; }
        float cm = sv[0];
#pragma unroll
        for (int j = 1; j < 8; ++j) cm = fmaxf(cm, sv[j]);
        cm = fmaxf(cm, __shfl_xor(cm, 16)); cm = fmaxf(cm, __shfl_xor(cm, 32));
        const float mn = fmaxf(m[q], cm);
        const float alpha = __expf(m[q] - mn);
        m[q] = mn;
        float pr[8]; float ps = 0.f;
#pragma unroll
        for (int j = 0; j < 8; ++j) { pr[j] = __expf(sv[j] - mn); ps += pr[j]; }
        l[q] = l[q] * alpha + ps;
        union { u32x4 u; bf16x8 h; } pb;
        pb.u.x = cvt_pk_bf16(pr[0], pr[1]); pb.u.y = cvt_pk_bf16(pr[2], pr[3]); pb.u.z = cvt_pk_bf16(pr[4], pr[5]); pb.u.w = cvt_pk_bf16(pr[6], pr[7]);
#pragma unroll
        for (int dt = 0; dt < 8; ++dt) { o[q][dt] *= alpha; o[q][dt] = __builtin_amdgcn_mfma_f32_16x16x32_bf16(vf[dt], pb.h, o[q][dt], 0, 0, 0); }
    }
}
template <int NQ>
DEVI void attn_chunk(const bf16_t* k0p, const bf16_t* k1p, const bf16_t* vtp, size_t vt_stride16,
                     const bf16x8 (&qf)[NQ][4], const unsigned (&vmask)[NQ], f32x4 (&o)[NQ][8], float (&m)[NQ], float (&l)[NQ]) {
    bf16x8 kf0[4], kf1[4], vf[8];
#pragma unroll
    for (int ks = 0; ks < 4; ++ks) { kf0[ks] = *(const bf16x8*)(k0p + ks * 32); kf1[ks] = *(const bf16x8*)(k1p + ks * 32); }
#pragma unroll
    for (int dt = 0; dt < 8; ++dt) vf[dt] = *(const bf16x8*)(vtp + (size_t)dt * vt_stride16);
    attn_compute<NQ>(kf0, kf1, vf, qf, vmask, o, m, l);
}

DEVI void vtrans_tile(const Params& p, unsigned char* smem, int a, int ptile) {
    int tid_ = threadIdx.x; asm volatile("" : "+v"(tid_)); size_t wz_ = 0; asm volatile("" : "+s"(wz_)); unsigned char* ws_ = p.ws + wz_;
    const int dil = a < 2 ? 1 : (a < 4 ? 4 : (a < 6 ? 16 : 1));
    const int arr = a < 6 ? 12 + a : 26 + (a - 6);
    const bf16_t* V = (const bf16_t*)(ws_ + OFF_P2) + (size_t)arr * ((size_t)S * 128);
    bf16_t* VT = (bf16_t*)(ws_ + OFF_VT) + (size_t)a * ((size_t)S * 128);
    bf16_t* sT = (bf16_t*)smem;
    const int tid = tid_, p0 = ptile * 64, per = S / dil;
    {
        const int r = tid >> 3, seg = (tid & 7) * 16;
        const int pos = p0 + r, rho = pos / per, mm = pos % per, tok = mm * dil + rho;
        const u32x4 w0 = *(const u32x4*)(V + (size_t)tok * 128 + seg), w1 = *(const u32x4*)(V + (size_t)tok * 128 + seg + 8);
        unsigned* d = (unsigned*)(sT + r * 130 + seg);
        d[0] = w0.x; d[1] = w0.y; d[2] = w0.z; d[3] = w0.w; d[4] = w1.x; d[5] = w1.y; d[6] = w1.z; d[7] = w1.w;
    }
    __syncthreads();
    {
        const int dim = tid >> 2, part = (tid & 3) * 16;
        unsigned w[8];
#pragma unroll
        for (int i = 0; i < 8; ++i) w[i] = (unsigned)sT[(part + 2 * i) * 130 + dim] | ((unsigned)sT[(part + 2 * i + 1) * 130 + dim] << 16);
        u32x4 o0 = {w[0], w[1], w[2], w[3]}, o1 = {w[4], w[5], w[6], w[7]};
        bf16_t* dp = VT + (size_t)dim * S + p0 + part;
        *(u32x4*)dp = o0; *(u32x4*)(dp + 8) = o1;
    }
    __syncthreads();
}

DEVI void moba_kmean(const Params& p, unsigned char* smem, int item) {
    int tid_ = threadIdx.x; asm volatile("" : "+v"(tid_)); size_t wz_ = 0; asm volatile("" : "+s"(wz_)); unsigned char* ws_ = p.ws + wz_;
    const int head = item >> 6, nbk = item & 63, tid = tid_, d = tid & 127, tq = tid >> 7;
    const bf16_t* K = (const bf16_t*)(ws_ + OFF_P2) + (size_t)(22 + head) * ((size_t)S * 128);
    float* red = (float*)smem;
    float a = 0.f;
    for (int i = 0; i < 64; ++i) a += bf2f(K[(size_t)(nbk * 256 + tq * 64 + i) * 128 + d]);
    red[tq * 128 + d] = a;
    __syncthreads();
    if (tid < 128) ((float*)(ws_ + OFF_KM))[(size_t)item * 128 + tid] = (red[tid] + red[128 + tid] + red[256 + tid] + red[384 + tid]) * (1.0f / 256.0f);
    __syncthreads();
}

#define TOP3_INSERT(v, i, v1, v2, v3, i1, i2, i3) do { const float _v = (v); const int _i = (i); \
    const bool _g1 = _v > v1, _g2 = _v > v2, _g3 = _v > v3; \
    const float _n3 = _g2 ? v2 : (_g3 ? _v : v3); const int _m3 = _g2 ? i2 : (_g3 ? _i : i3); \
    const float _n2 = _g1 ? v1 : (_g2 ? _v : v2); const int _m2 = _g1 ? i1 : (_g2 ? _i : i2); \
    const float _n1 = _g1 ? _v : v1; const int _m1 = _g1 ? _i : i1; \
    v1 = _n1; v2 = _n2; v3 = _n3; i1 = _m1; i2 = _m2; i3 = _m3; } while (0)

DEVI void moba_gate(const Params& p, unsigned char* smem, int item) {
    int tid_ = threadIdx.x; asm volatile("" : "+v"(tid_)); size_t wz_ = 0; asm volatile("" : "+s"(wz_)); unsigned char* ws_ = p.ws + wz_;
    const int head = item >> 6, qb = item & 63, cur = qb, tid = tid_;
    unsigned long long* sel = (unsigned long long*)(ws_ + OFF_SEL) + (size_t)head * S + qb * 256;
    unsigned* sQ = (unsigned*)smem;
    float* sKm = (float*)(smem + 256 * 65 * 4);
    const bf16_t* Q = (const bf16_t*)(ws_ + OFF_P2) + (size_t)(18 + head) * ((size_t)S * 128) + (size_t)qb * 256 * 128;
    for (int e = tid; e < 256 * 64; e += NT) sQ[(e >> 6) * 65 + (e & 63)] = ((const unsigned*)Q)[e];
    const float* KM = (const float*)(ws_ + OFF_KM) + (size_t)head * 64 * 128;
    for (int e = tid; e < cur * 128; e += NT) sKm[e] = KM[e];
    __syncthreads();
    const int q = tid >> 1, part = tid & 1;
    float v1 = -INFINITY, v2 = -INFINITY, v3 = -INFINITY; int i1 = -1, i2 = -1, i3 = -1;
    for (int n = part; n < cur; n += 2) {
        float dot = 0.f;
#pragma unroll 4
        for (int w = 0; w < 64; ++w) {
            const unsigned qq = sQ[q * 65 + w];
            dot += __uint_as_float(qq << 16) * sKm[n * 128 + 2 * w] + __uint_as_float(qq & 0xFFFF0000u) * sKm[n * 128 + 2 * w + 1];
        }
        TOP3_INSERT(dot, n, v1, v2, v3, i1, i2, i3);
    }
    const float pv1 = __shfl_xor(v1, 1), pv2 = __shfl_xor(v2, 1), pv3 = __shfl_xor(v3, 1);
    const int pi1 = __shfl_xor(i1, 1), pi2 = __shfl_xor(i2, 1), pi3 = __shfl_xor(i3, 1);
    TOP3_INSERT(pv1, pi1, v1, v2, v3, i1, i2, i3);
    TOP3_INSERT(pv2, pi2, v1, v2, v3, i1, i2, i3);
    TOP3_INSERT(pv3, pi3, v1, v2, v3, i1, i2, i3);
    unsigned long long mk = 0ull;
    if (i1 >= 0) mk |= 1ull << i1;
    if (i2 >= 0) mk |= 1ull << i2;
    if (i3 >= 0) mk |= 1ull << i3;
    if (part == 0) sel[q] = mk;
    __syncthreads();
}

constexpr int MB_KROW = 272, MB_VROW = 144, MB_KBYTES = 64 * MB_KROW, MB_BUF = MB_KBYTES + 128 * MB_VROW;
DEVI void moba_attn(const Params& p, unsigned char* smem, int item) {
    int tid_ = threadIdx.x; asm volatile("" : "+v"(tid_)); size_t wz_ = 0; asm volatile("" : "+s"(wz_)); unsigned char* ws_ = p.ws + wz_;
    const int head = item & 3, qb = 63 - (item >> 2);
    const int tid = tid_, wid = tid >> 6, lane = tid & 63, li = lane & 15, g = lane >> 4;
    LAS unsigned char* lds = (LAS unsigned char*)smem;
    const bf16_t* Q = (const bf16_t*)(ws_ + OFF_P2) + (size_t)(18 + head) * ((size_t)S * 128);
    const bf16_t* K = (const bf16_t*)(ws_ + OFF_P2) + (size_t)(22 + head) * ((size_t)S * 128);
    const bf16_t* VT = (const bf16_t*)(ws_ + OFF_VT) + (size_t)(6 + head) * ((size_t)S * 128);
    const unsigned long long* sel = (const unsigned long long*)(ws_ + OFF_SEL) + (size_t)head * S;
    const int qbase = qb * 256 + wid * 32;
    bf16x8 qf[2][4]; unsigned long long sm[2]; f32x4 o[2][8]; float m[2], l[2];
#pragma unroll
    for (int qt = 0; qt < 2; ++qt) {
        const int qi = qbase + qt * 16 + li;
#pragma unroll
        for (int ks = 0; ks < 4; ++ks) qf[qt][ks] = *(const bf16x8*)(Q + (size_t)qi * 128 + ks * 32 + g * 8);
        sm[qt] = sel[qi]; m[qt] = -1e30f; l[qt] = 0.f;
#pragma unroll
        for (int dt = 0; dt < 8; ++dt) o[qt][dt] = (f32x4){0.f, 0.f, 0.f, 0.f};
    }
    const int krow_s = tid >> 3, kseg = (tid & 7) * 16;
    const int vdim_s = tid >> 2, vpart = (tid & 3) * 16;
    u32x4 rk0, rk1, rv0, rv1;
    auto issue = [&](int st) {
        const bf16_t* kp = K + (size_t)(st * 64 + krow_s) * 128 + kseg;
        rk0 = *(const u32x4*)kp; rk1 = *(const u32x4*)(kp + 8);
        const bf16_t* vp = VT + (size_t)vdim_s * S + st * 64 + vpart;
        rv0 = *(const u32x4*)vp; rv1 = *(const u32x4*)(vp + 8);
    };
    auto commit = [&](int bi) {
        LAS unsigned char* kb = lds + bi * MB_BUF + krow_s * MB_KROW + kseg * 2;
        *(LAS u32x4*)kb = rk0; *(LAS u32x4*)(kb + 16) = rk1;
        LAS unsigned char* vb = lds + bi * MB_BUF + MB_KBYTES + vdim_s * MB_VROW + vpart * 2;
        *(LAS u32x4*)vb = rv0; *(LAS u32x4*)(vb + 16) = rv1;
    };
    const int nst = (qb + 1) * 4;
    issue(0); commit(0);
    __syncthreads();
    const int krow = 8 * (li >> 2) + (li & 3);
    for (int st = 0; st < nst; ++st) {
        if (st + 1 < nst) issue(st + 1);
        const int n = st >> 2;
        LAS unsigned char* kb = lds + (st & 1) * MB_BUF;
        LAS unsigned char* vb = kb + MB_KBYTES;
#pragma unroll
        for (int c = 0; c < 2; ++c) {
            const int c0 = st * 64 + c * 32;
            unsigned vm[2];
            if (n < qb) { vm[0] = ((sm[0] >> n) & 1ull) ? 0xFFu : 0u; vm[1] = ((sm[1] >> n) & 1ull) ? 0xFFu : 0u; }
            else {
#pragma unroll
                for (int qt = 0; qt < 2; ++qt) {
                    const int qpos = qbase + qt * 16 + li; unsigned mk = 0u;
#pragma unroll
                    for (int j = 0; j < 8; ++j) { const int key = c0 + 8 * g + (j & 3) + 4 * (j >> 2); mk |= (key <= qpos) ? (1u << j) : 0u; }
                    vm[qt] = mk;
                }
            }
            if (__ballot((vm[0] | vm[1]) != 0u) != 0ull) {
                bf16x8 kf0[4], kf1[4], vf[8];
#pragma unroll
                for (int ks = 0; ks < 4; ++ks) {
                    kf0[ks] = *(const LAS bf16x8*)(kb + (c * 32 + krow) * MB_KROW + (ks * 32 + g * 8) * 2);
                    kf1[ks] = *(const LAS bf16x8*)(kb + (c * 32 + krow + 4) * MB_KROW + (ks * 32 + g * 8) * 2);
                }
#pragma unroll
                for (int dt = 0; dt < 8; ++dt) vf[dt] = *(const LAS bf16x8*)(vb + (16 * dt + li) * MB_VROW + (c * 32 + 8 * g) * 2);
                attn_compute<2>(kf0, kf1, vf, qf, vm, o, m, l);
            }
        }
        if (st + 1 < nst) commit((st + 1) & 1);
        __syncthreads();
    }
    bf16_t* O = (bf16_t*)(ws_ + OFF_OMOBA);
#pragma unroll
    for (int qt = 0; qt < 2; ++qt) {
        float lt = l[qt]; lt += __shfl_xor(lt, 16); lt += __shfl_xor(lt, 32);
        const float inv = __builtin_amdgcn_rcpf(lt);
        const int qi = qbase + qt * 16 + li;
#pragma unroll
        for (int dt = 0; dt < 8; ++dt) {
            const f32x4 v = o[qt][dt] * inv;
            u32x2 w; w.x = cvt_pk_bf16(v[0], v[1]); w.y = cvt_pk_bf16(v[2], v[3]);
            *(u32x2*)(O + (size_t)qi * 512 + head * 128 + dt * 16 + 4 * g) = w;
        }
    }
}

DEVI void dil_attn(const Params& p, int item) {
    int tid_ = threadIdx.x; asm volatile("" : "+v"(tid_)); size_t wz_ = 0; asm volatile("" : "+s"(wz_)); unsigned char* ws_ = p.ws + wz_;
    const int hp = item & 1, T0 = (item >> 1) * 256;
    const int tid = tid_, wid = tid >> 6, lane = tid & 63, li = lane & 15, g = lane >> 4;
    const int krow = 8 * (li >> 2) + (li & 3);
    bf16_t* O = (bf16_t*)(ws_ + OFF_ODIL);
    for (int rr = 0; rr < 2; ++rr) {
        const int rho16 = 2 * wid + rr;
        const int tq = T0 + rho16 + 16 * li;
        f32x4 o[1][8]; float m[1], l[1];
        m[0] = -1e30f; l[0] = 0.f;
#pragma unroll
        for (int dt = 0; dt < 8; ++dt) o[0][dt] = (f32x4){0.f, 0.f, 0.f, 0.f};
        for (int gi = 0; gi < 3; ++gi) {
            const int dil = gi == 0 ? 1 : (gi == 1 ? 4 : 16);
            const int head = 2 * gi + hp, per = S / dil;
            const bf16_t* Q = (const bf16_t*)(ws_ + OFF_P2) + (size_t)(head) * ((size_t)S * 128);
            const bf16_t* K = (const bf16_t*)(ws_ + OFF_P2) + (size_t)(6 + head) * ((size_t)S * 128);
            const bf16_t* VT = (const bf16_t*)(ws_ + OFF_VT) + (size_t)head * ((size_t)S * 128);
            bf16x8 qf[1][4];
#pragma unroll
            for (int ks = 0; ks < 4; ++ks) qf[0][ks] = *(const bf16x8*)(Q + (size_t)tq * 128 + ks * 32 + g * 8);
            const int rho = rho16 % dil;
            const int qm = tq / dil;
            const int qm0 = (T0 + rho16) / dil, qm15 = (T0 + rho16 + 240) / dil;
            const int lo = qm0 - 128;
            int c0 = (lo >> 5) << 5;
            if (c0 < 0) c0 = (c0 < -32) ? 0 : c0;
            if (lo < 0 && c0 < 0 && c0 + 31 < 0) c0 = 0;
            for (; c0 <= qm15; c0 += 32) {
                unsigned vm[1]; unsigned mk = 0u;
#pragma unroll
                for (int j = 0; j < 8; ++j) { const int kap = c0 + 8 * g + (j & 3) + 4 * (j >> 2); mk |= (kap >= 0 && kap <= qm && qm - kap <= 128) ? (1u << j) : 0u; }
                vm[0] = mk;
                int ka0 = c0 + krow, ka1 = ka0 + 4;
                ka0 = ka0 < 0 ? 0 : (ka0 > per - 1 ? per - 1 : ka0); ka1 = ka1 < 0 ? 0 : (ka1 > per - 1 ? per - 1 : ka1);
                int sg = c0 + 8 * g; sg = sg < 0 ? 0 : (sg > per - 8 ? per - 8 : sg);
                const bf16_t* k0p = K + (size_t)(ka0 * dil + rho) * 128 + g * 8;
                const bf16_t* k1p = K + (size_t)(ka1 * dil + rho) * 128 + g * 8;
                attn_chunk<1>(k0p, k1p, VT + (size_t)li * S + (size_t)rho * per + sg, (size_t)16 * S, qf, vm, o, m, l);
            }
        }
        float lt = l[0]; lt += __shfl_xor(lt, 16); lt += __shfl_xor(lt, 32);
        const float inv = __builtin_amdgcn_rcpf(lt);
#pragma unroll
        for (int dt = 0; dt < 8; ++dt) {
            const f32x4 v = o[0][dt] * inv;
            u32x2 w; w.x = cvt_pk_bf16(v[0], v[1]); w.y = cvt_pk_bf16(v[2], v[3]);
            *(u32x2*)(O + (size_t)tq * 256 + hp * 128 + dt * 16 + 4 * g) = w;
        }
    }
}

DEVI void sub_barrier(unsigned* ctr, unsigned target) {
    __threadfence();
    __syncthreads();
    if (threadIdx.x == 0) {
        __threadfence();
        __hip_atomic_fetch_add(ctr, 1u, __ATOMIC_RELEASE, __HIP_MEMORY_SCOPE_AGENT);
        while (__hip_atomic_load(ctr, __ATOMIC_ACQUIRE, __HIP_MEMORY_SCOPE_AGENT) < target) __builtin_amdgcn_s_sleep(8);
        __threadfence();
    }
    __syncthreads();
}
#ifndef PHASE_MASK
#define PHASE_MASK 0xFFFFFFFFu
#endif
#define PH(k) ((PHASE_MASK >> (k)) & 1u)
#ifndef PROBE_MASK
#define PROBE_MASK 0u
#endif
#define REPS(k) (1 + (int)((PROBE_MASK >> (k)) & 1u))
__global__ void __launch_bounds__(512, 2) fwd_megakernel(Params p) {
    extern __shared__ __attribute__((aligned(16))) unsigned char smem[];
    cg::grid_group grid = cg::this_grid();
    const int bid = blockIdx.x, nb = gridDim.x;
    unsigned char* ws = p.ws;
    const float* mod = (const float*)(ws + OFF_MOD);

    if (bid == 0 && threadIdx.x < 4) ((unsigned*)(ws + OFF_BAR))[threadIdx.x * 64] = 0u;
    if (PH(0)) phase_mod_rope(p, smem, bid, nb);
    __syncthreads();
    for (int rep = 0; rep < REPS(5); ++rep) if (PH(1)) phase_convert(p, 0, smem, bid, nb);
    grid.sync();

    for (int l = 0; l < NL; ++l) {
        const float* ml = mod + l * 12288;
        const float* xin = (l == 0) ? (const float*)p.in[0] : p.out;
        for (int rep = 0; rep < REPS(4); ++rep) if (PH(2)) phase_norm(xin, (const float*)p.in[5] + l * D, ml, ml + 2048, (bf16_t*)(ws + OFF_H), bid, nb);
        for (int rep = 0; rep < REPS(5); ++rep) if (PH(1) && l > 0) phase_convert(p, l, smem, bid, nb);
        grid.sync();
        {
            EpiInProj E; E.G = (bf16_t*)(ws + OFF_G); E.P1G = (bf16_t*)(ws + OFF_P1G); E.P1R = (bf16_t*)(ws + OFF_P1R); E.P2 = (bf16_t*)(ws + OFF_P2);
            E.cosT = (const float*)(ws + OFF_COS); E.sinT = (const float*)(ws + OFF_SIN);
            for (int rep = 0; rep < REPS(0); ++rep) if (PH(3)) run_gemm(smem, (const bf16_t*)(ws + OFF_H), (const bf16_t*)(ws + OFF_WIN), IN_PAD, D, E);
        }
        grid.sync();
        for (int it = bid; it < 1024; it += nb) rwkv_prep(p, l, smem, it);
        grid.sync();
        if (bid < 32) rwkv_scan(p, smem, bid);
        else {
            const int b2 = bid - 32, nb2 = nb - 32;
            unsigned* ctr = (unsigned*)(ws + OFF_BAR) + l * 128;
            for (int it = b2; it < 1024 + 256 + 2560; it += nb2) {
                if (it < 1024) gla_pass1(p, l, smem, it);
                else if (it < 1280) moba_kmean(p, smem, it - 1024);
                else { const int j = it - 1280; vtrans_tile(p, smem, j >> 8, j & 255); }
            }
            sub_barrier(ctr, (unsigned)nb2);
            for (int it = b2; it < 64 + 256; it += nb2) {
                if (it < 64) gla_pass2(p, it);
                else moba_gate(p, smem, it - 64);
            }
            sub_barrier(ctr + 64, (unsigned)nb2);
            for (int it = b2; it < 256 + 128 + 1024; it += nb2) {
                if (it < 256) moba_attn(p, smem, it);
                else if (it < 384) dil_attn(p, it - 256);
                else gla_pass3(p, l, smem, it - 384);
            }
        }
        grid.sync();
        if (PH(14)) rwkv_post(p, l, bid, nb);
        grid.sync();
        {
            EpiBranch E; E.Mg = (bf16_t*)(ws + OFF_MERGED);
            E.Gb = (const bf16_t*)(ws + OFF_G); E.first = 1;
            if (PH(15)) run_gemm(smem, (const bf16_t*)(ws + OFF_OGLA), (const bf16_t*)(ws + OFF_WBA), D, 512, E);
            E.Gb = (const bf16_t*)(ws + OFF_G) + 2048; E.first = 0;
            if (PH(15)) run_gemm(smem, (const bf16_t*)(ws + OFF_ODIL), (const bf16_t*)(ws + OFF_WBB), D, 256, E);
            E.Gb = (const bf16_t*)(ws + OFF_G) + 4096;
            if (PH(15)) run_gemm(smem, (const bf16_t*)(ws + OFF_ORWKV), (const bf16_t*)(ws + OFF_WBC), D, 512, E);
            E.Gb = (const bf16_t*)(ws + OFF_G) + 6144;
            if (PH(15)) run_gemm(smem, (const bf16_t*)(ws + OFF_OMOBA), (const bf16_t*)(ws + OFF_WBD), D, 512, E);
        }
        grid.sync();
        {
            EpiResid E; E.src = xin; E.dst = p.out; E.gate = ml + 4096;
            if (PH(16)) run_gemm(smem, (const bf16_t*)(ws + OFF_MERGED), (const bf16_t*)(ws + OFF_WOUT), D, D, E);
        }
        grid.sync();
        for (int rep = 0; rep < REPS(4); ++rep) if (PH(2)) phase_norm(p.out, (const float*)p.in[29] + l * D, ml + 6144, ml + 8192, (bf16_t*)(ws + OFF_H), bid, nb);
        grid.sync();
        {
            EpiSwiglu E; E.act = (bf16_t*)(ws + OFF_ACT);
            for (int rep = 0; rep < REPS(1); ++rep) if (PH(17)) run_gemm(smem, (const bf16_t*)(ws + OFF_H), (const bf16_t*)(ws + OFF_WF1), 2 * FFN_H, D, E);
        }
        grid.sync();
        {
            EpiResid E; E.src = p.out; E.dst = p.out; E.gate = ml + 10240;
            if (PH(16)) run_gemm(smem, (const bf16_t*)(ws + OFF_ACT), (const bf16_t*)(ws + OFF_WF2), D, FFN_H, E);
        }
        grid.sync();
    }
    if (PH(18)) phase_final_norm(p.out, (const float*)p.in[32], bid, nb);
}

extern "C" void kernel_launch(void* const* d_in, const int* in_sizes, int n_in, void* d_out, int out_size, void* d_ws, size_t ws_size, hipStream_t stream) {
    static int grid_blocks = 0;
    if (grid_blocks == 0) {
        if (n_in != 33 || ws_size < WS_END) { fprintf(stderr, "kernel_launch: unexpected n_in %d or ws_size %zu (< %zu)\n", n_in, ws_size, (size_t)WS_END); grid_blocks = -1; return; }
        int dev = 0, cus = 0, per_cu = 0;
        hipGetDevice(&dev);
        hipDeviceGetAttribute(&cus, hipDeviceAttributeMultiprocessorCount, dev);
        if (hipFuncSetAttribute((const void*)fwd_megakernel, hipFuncAttributeMaxDynamicSharedMemorySize, LDS_BYTES) != hipSuccess) { fprintf(stderr, "kernel_launch: hipFuncSetAttribute failed\n"); grid_blocks = -1; return; }
        hipOccupancyMaxActiveBlocksPerMultiprocessor(&per_cu, (const void*)fwd_megakernel, NT, LDS_BYTES);
        if (per_cu < 1) { fprintf(stderr, "kernel_launch: occupancy query says 0 blocks per CU\n"); per_cu = 1; }
        grid_blocks = cus * 1;
        (void)hipGetLastError();
    }
    if (grid_blocks < 0) return;
    Params p{};
    for (int i = 0; i < 33; ++i) p.in[i] = d_in[i];
    p.out = (float*)d_out; p.ws = (unsigned char*)d_ws;
    void* args[] = {&p};
    hipError_t e = hipLaunchCooperativeKernel((const void*)fwd_megakernel, dim3(grid_blocks), dim3(NT), args, LDS_BYTES, stream);
    if (e != hipSuccess) fprintf(stderr, "cooperative launch failed: %s (grid %d)\n", hipGetErrorString(e), grid_blocks);
}
```
